# Optimizing an MI355X kernel written in HIP

```python
import jax, jax.numpy as jnp
from jax import lax
import numpy as np

D_MODEL = 4096
BATCH = 2
SEQ = 8192
DEPTH = 1

HEAD_DIM = 128
MOBA_HEADS = 16
MOBA_WIDTH = MOBA_HEADS * HEAD_DIM
MOBA_BLOCK = 256
MOBA_TOPK = 3
MOBA_QCHUNK = 32
SGU_CHUNK = 128
SGU_WIDTH = D_MODEL // 2
SGU_GROUPS = 16
SGU_GROUP_DIM = SGU_WIDTH // SGU_GROUPS
N_MEM = 256
XATTN_HEADS = 4
XATTN_WIDTH = XATTN_HEADS * HEAD_DIM
D_FF = -(-8 * D_MODEL // (3 * 256)) * 256
IN_COLS = 3 * MOBA_WIDTH + 2 * SGU_WIDTH + 2 * D_MODEL
RMS_EPS = 1e-6
LN_EPS = 1e-5
ROPE_THETA = 10000.0
NEG_INF = -1e30

kernel_name = 'moba_sgu_gated_hybrid_block'


def rms_norm(x, g):
    xf = x.astype(jnp.float32)
    y = xf * lax.rsqrt(jnp.mean(xf * xf, axis=-1, keepdims=True) + RMS_EPS)
    return (y * g.astype(jnp.float32)).astype(x.dtype)


def layer_norm(x, g, b):
    xf = x.astype(jnp.float32)
    mu = jnp.mean(xf, axis=-1, keepdims=True)
    var = jnp.mean(jnp.square(xf - mu), axis=-1, keepdims=True)
    y = (xf - mu) * lax.rsqrt(var + LN_EPS)
    return (y * g.astype(jnp.float32) + b.astype(jnp.float32)).astype(x.dtype)


def rotary(x, pos):
    dh = x.shape[-1]
    half = dh // 2
    inv_freq = jnp.power(ROPE_THETA, -(jnp.arange(half, dtype=jnp.float32) * 2.0 / dh))
    ang = pos.astype(jnp.float32)[:, None] * inv_freq[None, :]
    cos, sin = jnp.cos(ang), jnp.sin(ang)
    xf = x.astype(jnp.float32)
    x1, x2 = xf[..., :half], xf[..., half:]
    return jnp.concatenate([x1 * cos - x2 * sin, x2 * cos + x1 * sin], axis=-1).astype(x.dtype)


def moba_attention(q, k, v):
    bsz, n_heads, seq, dh = q.shape
    pad = (-seq) % MOBA_BLOCK
    padw = ((0, 0), (0, 0), (0, pad), (0, 0))
    q = jnp.pad(q, padw)
    k = jnp.pad(k, padw)
    v = jnp.pad(v, padw)
    s_pad = seq + pad
    n_blocks = s_pad // MOBA_BLOCK
    top_k = min(MOBA_TOPK, n_blocks)
    n_sel = top_k * MOBA_BLOCK
    kb = k.reshape(bsz, n_heads, n_blocks, MOBA_BLOCK, dh)
    vb = v.reshape(bsz, n_heads, n_blocks, MOBA_BLOCK, dh)
    k_mean = jnp.mean(kb.astype(jnp.float32), axis=3)
    scale = dh ** -0.5
    b_idx = jnp.arange(bsz)[:, None, None, None]
    h_idx = jnp.arange(n_heads)[None, :, None, None]

    def one_chunk(ci):
        start = ci * MOBA_QCHUNK
        cur = start // MOBA_BLOCK
        qc = lax.dynamic_slice_in_dim(q, start, MOBA_QCHUNK, axis=2).astype(jnp.float32)
        gate = jnp.einsum('bhqd,bhnd->bhqn', qc, k_mean)
        gate = jnp.where(jnp.arange(n_blocks) < cur, gate, NEG_INF)
        _, sel = lax.top_k(gate, top_k)
        valid = jnp.arange(top_k) < cur
        k_sel = kb[b_idx, h_idx, sel].astype(jnp.float32)
        v_sel = vb[b_idx, h_idx, sel].astype(jnp.float32)
        s_sel = jnp.einsum('bhqd,bhqnkd->bhqnk', qc, k_sel) * scale
        s_sel = jnp.where(valid[:, None], s_sel, NEG_INF)
        k_own = lax.dynamic_slice_in_dim(k, cur * MOBA_BLOCK, MOBA_BLOCK, axis=2).astype(jnp.float32)
        v_own = lax.dynamic_slice_in_dim(v, cur * MOBA_BLOCK, MOBA_BLOCK, axis=2).astype(jnp.float32)
        s_own = jnp.einsum('bhqd,bhkd->bhqk', qc, k_own) * scale
        q_pos = start + jnp.arange(MOBA_QCHUNK)
        k_pos = cur * MOBA_BLOCK + jnp.arange(MOBA_BLOCK)
        s_own = jnp.where(k_pos[None, :] <= q_pos[:, None], s_own, NEG_INF)
        scores = jnp.concatenate([s_sel.reshape(bsz, n_heads, MOBA_QCHUNK, n_sel), s_own], axis=-1)
        p = jax.nn.softmax(scores, axis=-1)
        p_sel = p[..., :n_sel].reshape(bsz, n_heads, MOBA_QCHUNK, top_k, MOBA_BLOCK)
        out = (jnp.einsum('bhqnk,bhqnkd->bhqd', p_sel, v_sel)
               + jnp.einsum('bhqk,bhkd->bhqd', p[..., n_sel:], v_own))
        return out.astype(v.dtype)

    outs = lax.map(one_chunk, jnp.arange(s_pad // MOBA_QCHUNK))
    out = jnp.transpose(outs, (1, 2, 0, 3, 4)).reshape(bsz, n_heads, s_pad, dh)
    return out[:, :, :seq]


def spatial_gating(u, v, ln_g, ln_b, w_s, b_s):
    bsz, seq, _ = v.shape
    v = layer_norm(v, ln_g, ln_b)
    vc = v.reshape(bsz, seq // SGU_CHUNK, SGU_CHUNK, SGU_GROUPS, SGU_GROUP_DIM)
    causal = jnp.tril(jnp.ones((SGU_CHUNK, SGU_CHUNK), dtype=w_s.dtype))
    w = w_s * causal[None]
    mixed = jnp.einsum('gts,bcsgd->bctgd', w, vc) + jnp.transpose(b_s)[None, None, :, :, None]
    return u * mixed.reshape(bsz, seq, SGU_WIDTH)


def hybrid_mixer(h, w_in, sgu_ln_g, sgu_ln_b, w_sgu, b_sgu, w_branch_a, w_branch_b, w_out):
    bsz, seq, _ = h.shape
    z = h @ w_in
    cuts = np.cumsum([MOBA_WIDTH, MOBA_WIDTH, MOBA_WIDTH, SGU_WIDTH, SGU_WIDTH, D_MODEL]).tolist()
    q, k, v, u, vs, g_a, g_b = jnp.split(z, cuts, axis=-1)

    def heads(t):
        return jnp.transpose(t.reshape(bsz, seq, MOBA_HEADS, HEAD_DIM), (0, 2, 1, 3))

    pos = jnp.arange(seq)
    o_a = moba_attention(rotary(heads(q), pos), rotary(heads(k), pos), heads(v))
    o_a = jnp.transpose(o_a, (0, 2, 1, 3)).reshape(bsz, seq, MOBA_WIDTH)
    o_b = spatial_gating(jax.nn.gelu(u), jax.nn.gelu(vs), sgu_ln_g, sgu_ln_b, w_sgu, b_sgu)
    merged = jax.nn.sigmoid(g_a) * (o_a @ w_branch_a) + jax.nn.sigmoid(g_b) * (o_b @ w_branch_b)
    return merged @ w_out


def memory_cross_attention(h, mem_n, w_xq, w_xkv, w_xo):
    bsz, seq, _ = h.shape
    n_mem = mem_n.shape[1]
    q = (h @ w_xq).reshape(bsz, seq, XATTN_HEADS, HEAD_DIM)
    k, v = jnp.split(mem_n @ w_xkv, 2, axis=-1)
    k = k.reshape(bsz, n_mem, XATTN_HEADS, HEAD_DIM)
    v = v.reshape(bsz, n_mem, XATTN_HEADS, HEAD_DIM)
    s = jnp.einsum('bshd,bmhd->bhsm', q, k).astype(jnp.float32) * (HEAD_DIM ** -0.5)
    p = jax.nn.softmax(s, axis=-1).astype(v.dtype)
    o = jnp.einsum('bhsm,bmhd->bshd', p, v).reshape(bsz, seq, XATTN_WIDTH)
    return o @ w_xo


def swiglu(h, w_gate, w_up, w_down):
    return (jax.nn.silu(h @ w_gate) * (h @ w_up)) @ w_down


def setup_inputs(seed: int = 0) -> dict:
    key = jax.random.key(seed)
    ks = jax.random.split(key, 24)
    f32 = jnp.float32

    def nrm(k, shape, scale):
        return jax.random.normal(k, shape, f32) * scale

    def gain(k, shape):
        return 1.0 + 0.05 * jax.random.normal(k, shape, f32)

    L = DEPTH
    return {
        'x': nrm(ks[0], (BATCH, SEQ, D_MODEL), 1.0),
        'mem': nrm(ks[1], (BATCH, N_MEM, D_MODEL), 1.0),
        'norm_mix_g': gain(ks[2], (L, D_MODEL)),
        'w_in': nrm(ks[3], (L, D_MODEL, IN_COLS), D_MODEL ** -0.5),
        'sgu_ln_g': gain(ks[4], (L, SGU_WIDTH)),
        'sgu_ln_b': nrm(ks[5], (L, SGU_WIDTH), 0.02),
        'w_sgu': nrm(ks[6], (L, SGU_GROUPS, SGU_CHUNK, SGU_CHUNK), SGU_CHUNK ** -0.5),
        'b_sgu': gain(ks[7], (L, SGU_GROUPS, SGU_CHUNK)),
        'w_branch_a': nrm(ks[8], (L, MOBA_WIDTH, D_MODEL), MOBA_WIDTH ** -0.5),
        'w_branch_b': nrm(ks[9], (L, SGU_WIDTH, D_MODEL), SGU_WIDTH ** -0.5),
        'w_out': nrm(ks[10], (L, D_MODEL, D_MODEL), D_MODEL ** -0.5),
        'norm_xattn_g': gain(ks[11], (L, D_MODEL)),
        'norm_mem_g': gain(ks[12], (L, D_MODEL)),
        'w_xq': nrm(ks[13], (L, D_MODEL, XATTN_WIDTH), D_MODEL ** -0.5),
        'w_xkv': nrm(ks[14], (L, D_MODEL, 2 * XATTN_WIDTH), D_MODEL ** -0.5),
        'w_xo': nrm(ks[15], (L, XATTN_WIDTH, D_MODEL), XATTN_WIDTH ** -0.5),
        'norm_ffn_g': gain(ks[16], (L, D_MODEL)),
        'w_ff_gate': nrm(ks[17], (L, D_MODEL, D_FF), D_MODEL ** -0.5),
        'w_ff_up': nrm(ks[18], (L, D_MODEL, D_FF), D_MODEL ** -0.5),
        'w_ff_down': nrm(ks[19], (L, D_FF, D_MODEL), D_FF ** -0.5),
        'norm_final_g': gain(ks[20], (D_MODEL,)),
    }


def reference(x, mem, norm_mix_g, w_in, sgu_ln_g, sgu_ln_b, w_sgu, b_sgu, w_branch_a,
              w_branch_b, w_out, norm_xattn_g, norm_mem_g, w_xq, w_xkv, w_xo, norm_ffn_g,
              w_ff_gate, w_ff_up, w_ff_down, norm_final_g):
    for l in range(DEPTH):
        h = rms_norm(x, norm_mix_g[l])
        x = x + hybrid_mixer(h, w_in[l], sgu_ln_g[l], sgu_ln_b[l], w_sgu[l], b_sgu[l],
                             w_branch_a[l], w_branch_b[l], w_out[l])
        h = rms_norm(x, norm_xattn_g[l])
        mem_n = rms_norm(mem, norm_mem_g[l])
        x = x + memory_cross_attention(h, mem_n, w_xq[l], w_xkv[l], w_xo[l])
        h = rms_norm(x, norm_ffn_g[l])
        x = x + swiglu(h, w_ff_gate[l], w_ff_up[l], w_ff_down[l])
    return rms_norm(x, norm_final_g)
```

```cpp
#include <hip/hip_runtime.h>
#include <cstdio>
#include <cstdint>

#ifndef MK_REP
#define MK_REP 0
#endif
#ifndef MK_REPN
#define MK_REPN 1
#endif
#ifndef MK_PER_PHASE
#define MK_PER_PHASE 0
#endif

#define GAS __attribute__((address_space(1)))
#define LAS __attribute__((address_space(3)))
typedef unsigned short bf16_t;
typedef short bf16x8 __attribute__((ext_vector_type(8)));
typedef short s16x4 __attribute__((ext_vector_type(4)));
typedef float f32x2 __attribute__((ext_vector_type(2)));
typedef float f32x4 __attribute__((ext_vector_type(4)));
typedef float f32x16 __attribute__((ext_vector_type(16)));
typedef unsigned u32x2 __attribute__((ext_vector_type(2)));
typedef unsigned u32x4 __attribute__((ext_vector_type(4)));

constexpr int BATCH = 2, SEQ = 8192, M = BATCH * SEQ, DM = 4096, HD = 128, NH = 16, AW = 2048, SW = 2048, NIN = 18432, DFF = 11008, NMEM = 256, XH = 4, XW = 512;
constexpr int NGRP = 16, SCH = 128;
constexpr float RMS_EPS = 1e-6f, LN_EPS = 1e-5f;

typedef __bf16 bf16x2_t __attribute__((ext_vector_type(2)));
__device__ __forceinline__ unsigned cvt_pk_bf16(float lo, float hi) { f32x2 v = {lo, hi}; bf16x2_t b = __builtin_convertvector(v, bf16x2_t); return __builtin_bit_cast(unsigned, b); }
__device__ __forceinline__ u32x4 pack8f(f32x4 a, f32x4 b) { u32x4 w; w.x = cvt_pk_bf16(a[0], a[1]); w.y = cvt_pk_bf16(a[2], a[3]); w.z = cvt_pk_bf16(b[0], b[1]); w.w = cvt_pk_bf16(b[2], b[3]); return w; }
__device__ __forceinline__ float bflo(unsigned w) { return __builtin_bit_cast(float, w << 16); }
__device__ __forceinline__ float bfhi(unsigned w) { return __builtin_bit_cast(float, w & 0xffff0000u); }
__device__ __forceinline__ void unpack8(u32x4 w, f32x4& a, f32x4& b) { a = (f32x4){bflo(w.x), bfhi(w.x), bflo(w.y), bfhi(w.y)}; b = (f32x4){bflo(w.z), bfhi(w.z), bflo(w.w), bfhi(w.w)}; }
typedef int i32x4v __attribute__((ext_vector_type(4)));
typedef int i32x8v __attribute__((ext_vector_type(8)));
__device__ __forceinline__ unsigned pk4_fp8(float a, float b, float c, float d) { unsigned w = 0; w = __builtin_amdgcn_cvt_pk_fp8_f32(a, b, w, false); w = __builtin_amdgcn_cvt_pk_fp8_f32(c, d, w, true); return w; }
constexpr float X8_SCALE = 16.f, W8_SCALE = 1024.f, ACC8_SCALE = 1.f / (16.f * 1024.f), OA8_SCALE = 32.f, ACCA_SCALE = 1.f / (32.f * 1024.f);
typedef unsigned long long ssq_t;
constexpr float SSQ_SCALE = 16777216.f;
__device__ __forceinline__ float rs_of(const ssq_t* p, int row) { return __builtin_amdgcn_rsqf((float)p[row] * (1.f / (SSQ_SCALE * 4096.f)) + 1e-6f); }
__device__ __forceinline__ float sigmoidf_(float v) { return __builtin_amdgcn_rcpf(1.f + __builtin_amdgcn_exp2f(-1.4426950408889634f * v)); }
__device__ __forceinline__ float gelu_tanh(float v) { const float y = 0.7978845608028654f * (v + 0.044715f * v * v * v); return v * __builtin_amdgcn_rcpf(1.f + __builtin_amdgcn_exp2f(-2.8853900817779268f * y)); }
__device__ __forceinline__ f32x4 gelu4(f32x4 v) { return (f32x4){gelu_tanh(v[0]), gelu_tanh(v[1]), gelu_tanh(v[2]), gelu_tanh(v[3])}; }
__device__ __forceinline__ f32x4 sigm4(f32x4 v) { return (f32x4){sigmoidf_(v[0]), sigmoidf_(v[1]), sigmoidf_(v[2]), sigmoidf_(v[3])}; }

namespace pg8 {
constexpr int BM = 256, BK = 64, HALF = 128, HTB = HALF * BK * 2, STAGE_BYTES = 8 * HTB, NXCD = 8, WGM = 8;
__host__ __device__ __forceinline__ int lds_byte(int r, int c) { const int st = (r >> 4) * 2 + (c >> 5), rr = r & 15, cc = c & 31, ob = rr * 64 + cc * 2; return st * 1024 + (ob ^ (((ob >> 9) & 1) << 5)); }
__host__ __device__ __forceinline__ void stage_rc(int b, int& R, int& C) { const int st = b / 1024, sb = b % 1024, swz = sb ^ (((sb >> 9) & 1) << 5); R = (st >> 1) * 16 + swz / 64; C = (st & 1) * 32 + (swz % 64) / 2; }
__host__ __device__ __forceinline__ int perm32(int rho) { const int n = rho >> 4, i = rho & 15; return 8 * (i >> 2) + 4 * n + (i & 3); }
struct Unit { int pm, pn, ko; };
struct Gemm { const bf16_t* A; const bf16_t* Bt; int M, N, K, ld; };
struct StaticOrder {
    int nM, nN, nwg, G, c, wgm;
    __host__ __device__ void init(int M_, int N_, int G_, int c_, int wgm_ = WGM) { nM = M_ / BM; nN = N_ / BM; nwg = nM * nN; G = G_; c = c_; wgm = wgm_; }
    __host__ __device__ __forceinline__ bool next(int i, Unit& u) const {
        const long L = (long)i * G + c; if (L >= nwg) return false;
        int wgid = (int)L; { const int q = nwg / NXCD, r = nwg % NXCD, xcd = wgid % NXCD, off = wgid / NXCD; wgid = (xcd < r ? xcd * (q + 1) : r * (q + 1) + (xcd - r) * q) + off; }
        const int nig = wgm * nN, gid = wgid / nig, fm = gid * wgm, gsz = (nM - fm) < wgm ? (nM - fm) : wgm;
        u.pm = fm + ((wgid % nig) % gsz); u.pn = (wgid % nig) / gsz; u.ko = 0; return true;
    }
    __device__ __forceinline__ void a_ready(const Unit&) const {}
    __device__ __forceinline__ void done(const Unit&) const {}
};

struct MemKVOrder {
    int c;
    __device__ bool next(int i, Unit& u) const { if (i > 0 || c >= 64) return false; u.pm = c & 1; u.pn = (c >> 1) & 3; u.ko = (c >> 3) * 512; return true; }
    __device__ __forceinline__ void a_ready(const Unit&) const {}
    __device__ __forceinline__ void done(const Unit&) const {}
};

template <int MODE> struct EpiIn {
    static constexpr bool PERM = true, AFTER_DRAIN = false;
    const ssq_t* ssq; const float* rc; const float* rsn; bf16_t *Q, *K, *V, *U, *VS; unsigned char *SA, *SB; float* kmpart; unsigned long long* lnstat;
    __device__ __forceinline__ bool keep(const Unit&) const { return false; }
    __device__ __forceinline__ void operator()(f32x4 (&acc)[2][2][4][2], const Unit& un, int wr, int wc, int fr, int fq) const {
        asm volatile("" : "+v"(fr), "+v"(fq));
        const int rowb = un.pm * BM + wr * 64 + fr, pn = MODE ? (un.pn < 24 ? un.pn : un.pn + 16) : un.pn + 24;
        float rsc[2][4];
#pragma unroll
        for (int ai = 0; ai < 2; ++ai)
#pragma unroll
            for (int m = 0; m < 4; ++m) rsc[ai][m] = rs_of(ssq, rowb + ai * HALF + m * 16) * (MODE ? ACC8_SCALE : 1.f);
        if (MODE == 1 && pn < 16) {
            bf16_t* dst = pn < 8 ? Q : K; const int head = (pn & 7) * 2 + (wc >> 1), dd0 = 32 * (wc & 1) + 8 * fq;
            f32x4 cs[4] = {};
            f32x4 tc[2][2][2], ts[2][2][2];
#pragma unroll
            for (int mm = 0; mm < 2; ++mm) { const int pos = (rowb + mm * 16) & (SEQ - 1);
                tc[0][mm][0] = *(const f32x4*)(rc + pos * 64 + dd0); tc[0][mm][1] = *(const f32x4*)(rc + pos * 64 + dd0 + 4); ts[0][mm][0] = *(const f32x4*)(rsn + pos * 64 + dd0); ts[0][mm][1] = *(const f32x4*)(rsn + pos * 64 + dd0 + 4); }
#pragma unroll
            for (int am = 0; am < 4; ++am) {
                const int ai = am >> 1, m0 = (am & 1) * 2, bf = am & 1;
                u32x4 ow[2][2];
#pragma unroll
                for (int mm = 0; mm < 2; ++mm) { const int m = m0 + mm; const float r = rsc[ai][m];
                    const f32x4 c0 = tc[bf][mm][0], c1 = tc[bf][mm][1], s0 = ts[bf][mm][0], s1 = ts[bf][mm][1];
                    const f32x4 x1a = acc[ai][0][m][0] * r, x1b = acc[ai][0][m][1] * r, x2a = acc[ai][1][m][0] * r, x2b = acc[ai][1][m][1] * r;
                    const f32x4 o1a = x1a * c0 - x2a * s0, o1b = x1b * c1 - x2b * s1, o2a = x2a * c0 + x1a * s0, o2b = x2b * c1 + x1b * s1;
                    cs[0] += o1a; cs[1] += o1b; cs[2] += o2a; cs[3] += o2b;
                    ow[mm][0] = pack8f(o1a, o1b); ow[mm][1] = pack8f(o2a, o2b); }
                if (am < 3) { const int an = am + 1, ai2 = an >> 1, m2 = (an & 1) * 2;
#pragma unroll
                    for (int mm = 0; mm < 2; ++mm) { const int pos = (rowb + ai2 * HALF + (m2 + mm) * 16) & (SEQ - 1);
                        tc[bf ^ 1][mm][0] = *(const f32x4*)(rc + pos * 64 + dd0); tc[bf ^ 1][mm][1] = *(const f32x4*)(rc + pos * 64 + dd0 + 4); ts[bf ^ 1][mm][0] = *(const f32x4*)(rsn + pos * 64 + dd0); ts[bf ^ 1][mm][1] = *(const f32x4*)(rsn + pos * 64 + dd0 + 4); } }
#pragma unroll
                for (int mm = 0; mm < 2; ++mm) { const int row = rowb + ai * HALF + (m0 + mm) * 16;
                    bf16_t* p = dst + (size_t)row * AW + head * HD + dd0;
                    *(u32x4*)p = ow[mm][0];
                    *(u32x4*)(p + 64) = ow[mm][1]; } }
            if (pn >= 8) {
#pragma unroll
                for (int q = 0; q < 4; ++q)
#pragma unroll
                    for (int j = 0; j < 4; ++j) { float v = cs[q][j]; v += __shfl_xor(v, 1); v += __shfl_xor(v, 2); v += __shfl_xor(v, 4); v += __shfl_xor(v, 8); cs[q][j] = v; }
                if (fr == 0) { float* kp = kmpart + (((size_t)un.pm * NH + head) * 2 + wr) * HD + dd0;
                    *(f32x4*)kp = cs[0]; *(f32x4*)(kp + 4) = cs[1]; *(f32x4*)(kp + 64) = cs[2]; *(f32x4*)(kp + 68) = cs[3]; } }
        } else if (MODE == 1 && pn < 24) {
            const int col0 = (pn - 16) * BM + wc * 32 + 8 * fq;
#pragma unroll
            for (int ai = 0; ai < 2; ++ai)
#pragma unroll
                for (int m = 0; m < 4; ++m) { const int row = rowb + ai * HALF + m * 16; const float r = rsc[ai][m];
#pragma unroll
                    for (int bj = 0; bj < 2; ++bj) *(u32x4*)(V + (size_t)row * AW + col0 + bj * HALF) = pack8f(acc[ai][bj][m][0] * r, acc[ai][bj][m][1] * r); }
        } else if (MODE == 0 && pn < 40) {
            bf16_t* dst = pn < 32 ? U : VS; const int col0 = ((pn - 24) & 7) * BM + wc * 32 + 8 * fq;
#pragma unroll
            for (int ai = 0; ai < 2; ++ai)
#pragma unroll
                for (int m = 0; m < 4; ++m) { const int row = rowb + ai * HALF + m * 16; const float r = rsc[ai][m];
                    float s1 = 0.f, s2 = 0.f;
#pragma unroll
                    for (int bj = 0; bj < 2; ++bj) { const f32x4 g0 = gelu4(acc[ai][bj][m][0] * r), g1 = gelu4(acc[ai][bj][m][1] * r);
                        *(u32x4*)(dst + (size_t)row * SW + col0 + bj * HALF) = pack8f(g0, g1);
                        s1 += (g0[0] + g0[1]) + (g0[2] + g0[3]) + (g1[0] + g1[1]) + (g1[2] + g1[3]);
                        s2 += (g0[0] * g0[0] + g0[1] * g0[1]) + (g0[2] * g0[2] + g0[3] * g0[3]) + (g1[0] * g1[0] + g1[1] * g1[1]) + (g1[2] * g1[2] + g1[3] * g1[3]); }
                    if (pn >= 32) {
                        s1 += __shfl_xor(s1, 16); s1 += __shfl_xor(s1, 32); s2 += __shfl_xor(s2, 16); s2 += __shfl_xor(s2, 32);
                        if (fq == 0) { atomicAdd(lnstat + 2 * row, (unsigned long long)(long long)__builtin_rintf(s1 * SSQ_SCALE)); atomicAdd(lnstat + 2 * row + 1, (unsigned long long)(long long)__builtin_rintf(s2 * SSQ_SCALE)); } } }
        } else if (MODE == 1) {
            unsigned char* dst = (pn < 56 ? SA : SB) + ((size_t)(un.pm * 16 + ((pn - 40) & 15)) * 8) * 8192 + (size_t)(wr * 4 + wc) * 1024 + (fq * 16 + fr) * 16;
#pragma unroll
            for (int ai = 0; ai < 2; ++ai)
#pragma unroll
                for (int m = 0; m < 4; ++m) { const float r = rsc[ai][m]; u32x4 w;
#pragma unroll
                    for (int bj = 0; bj < 2; ++bj) { const f32x4 s0 = sigm4(acc[ai][bj][m][0] * r) * 255.f + 0.5f, s1 = sigm4(acc[ai][bj][m][1] * r) * 255.f + 0.5f;
                        const unsigned lo = (unsigned)s0[0] | ((unsigned)s0[1] << 8) | ((unsigned)s0[2] << 16) | ((unsigned)s0[3] << 24), hi_ = (unsigned)s1[0] | ((unsigned)s1[1] << 8) | ((unsigned)s1[2] << 16) | ((unsigned)s1[3] << 24);
                        if (bj == 0) { w.x = lo; w.y = hi_; } else { w.z = lo; w.w = hi_; } }
                    *(u32x4*)(dst + (size_t)(ai * 4 + m) * 8192) = w; }
        }
    }
};
struct EpiPart {
    static constexpr bool PERM = true, AFTER_DRAIN = false;
    float* P;
    __device__ __forceinline__ bool keep(const Unit&) const { return false; }
    __device__ __forceinline__ void operator()(f32x4 (&acc)[2][2][4][2], const Unit& un, int wr, int wc, int fr, int fq) const {
        const int rowb = un.pm * BM + wr * 64 + fr, col0 = un.pn * BM + wc * 32 + 8 * fq; float* base = P + (size_t)(un.ko >> 9) * (BATCH * NMEM * 2 * XW);
#pragma unroll
        for (int ai = 0; ai < 2; ++ai)
#pragma unroll
            for (int m = 0; m < 4; ++m)
#pragma unroll
                for (int bj = 0; bj < 2; ++bj) { float* p = base + (size_t)(rowb + ai * HALF + m * 16) * (2 * XW) + col0 + bj * HALF; *(f32x4*)p = acc[ai][bj][m][0]; *(f32x4*)(p + 4) = acc[ai][bj][m][1]; }
    }
};
struct EpiScale {
    static constexpr bool PERM = true, AFTER_DRAIN = false;
    const ssq_t* ssq; bf16_t* O; int ldc;
    __device__ __forceinline__ bool keep(const Unit&) const { return false; }
    __device__ __forceinline__ void operator()(f32x4 (&acc)[2][2][4][2], const Unit& un, int wr, int wc, int fr, int fq) const {
        const int rowb = un.pm * BM + wr * 64 + fr, col0 = un.pn * BM + wc * 32 + 8 * fq;
        float rsc[2][4];
#pragma unroll
        for (int ai = 0; ai < 2; ++ai)
#pragma unroll
            for (int m = 0; m < 4; ++m) rsc[ai][m] = ssq ? rs_of(ssq, rowb + ai * HALF + m * 16) : 1.f;
#pragma unroll
        for (int ai = 0; ai < 2; ++ai)
#pragma unroll
            for (int m = 0; m < 4; ++m) { const int row = rowb + ai * HALF + m * 16; const float r = rsc[ai][m];
#pragma unroll
                for (int bj = 0; bj < 2; ++bj) *(u32x4*)(O + (size_t)row * ldc + col0 + bj * HALF) = pack8f(acc[ai][bj][m][0] * r, acc[ai][bj][m][1] * r); }
    }
};
template <int BR> struct EpiBranch {
    static constexpr bool PERM = true, AFTER_DRAIN = false;
    const unsigned char* S8; bf16_t* O;
    __device__ __forceinline__ bool keep(const Unit&) const { return false; }
    static __device__ __forceinline__ f32x4 ub4(unsigned w) { return (f32x4){(float)(w & 255u), (float)((w >> 8) & 255u), (float)((w >> 16) & 255u), (float)(w >> 24)}; }
    __device__ __forceinline__ void operator()(f32x4 (&acc)[2][2][4][2], const Unit& un, int wr, int wc, int fr, int fq) const {
        asm volatile("" : "+v"(fr), "+v"(fq));
        const int rowb = un.pm * BM + wr * 64 + fr, col0 = un.pn * BM + wc * 32 + 8 * fq;
        const size_t goff = ((size_t)(un.pm * 16 + un.pn) * 8) * 8192 + (size_t)(wr * 4 + wc) * 1024 + (fq * 16 + fr) * 16;
        constexpr float SC = (BR == 0 ? ACCA_SCALE : 1.f) * (1.f / 255.f);
        u32x4 wgs[2][4], pw[2][4][2];
#pragma unroll
        for (int m = 0; m < 4; ++m) { wgs[0][m] = *(const u32x4*)(S8 + goff + (size_t)m * 8192);
            if (BR == 1) {
#pragma unroll
                for (int bj = 0; bj < 2; ++bj) pw[0][m][bj] = *(const u32x4*)(O + (size_t)(rowb + m * 16) * DM + col0 + bj * HALF); } }
#pragma unroll
        for (int ai = 0; ai < 2; ++ai) {
            u32x4 ow[4][2];
#pragma unroll
            for (int m = 0; m < 4; ++m) { const u32x4 wg = wgs[ai][m];
#pragma unroll
                for (int bj = 0; bj < 2; ++bj) { f32x4 v0 = ub4(bj ? wg.z : wg.x) * SC * acc[ai][bj][m][0], v1 = ub4(bj ? wg.w : wg.y) * SC * acc[ai][bj][m][1];
                    if (BR == 1) { f32x4 p0, p1; unpack8(pw[ai][m][bj], p0, p1); v0 += p0; v1 += p1; }
                    ow[m][bj] = pack8f(v0, v1); } }
            if (ai == 0) {
#pragma unroll
                for (int m = 0; m < 4; ++m) { wgs[1][m] = *(const u32x4*)(S8 + goff + (size_t)(4 + m) * 8192);
                    if (BR == 1) {
#pragma unroll
                        for (int bj = 0; bj < 2; ++bj) pw[1][m][bj] = *(const u32x4*)(O + (size_t)(rowb + HALF + m * 16) * DM + col0 + bj * HALF); } } }
#pragma unroll
            for (int m = 0; m < 4; ++m) { const size_t off = (size_t)(rowb + ai * HALF + m * 16) * DM + col0;
#pragma unroll
                for (int bj = 0; bj < 2; ++bj) *(u32x4*)(O + off + bj * HALF) = ow[m][bj]; } }
    }
};
struct EpiResid {
    static constexpr bool PERM = true, AFTER_DRAIN = false;
    const float* basef; const bf16_t* baseb; bf16_t* xb; ssq_t* ssq;
    __device__ __forceinline__ bool keep(const Unit&) const { return false; }
    __device__ __forceinline__ void operator()(f32x4 (&acc)[2][2][4][2], const Unit& un, int wr, int wc, int fr, int fq) const {
        const int rowb = un.pm * BM + wr * 64 + fr, col0 = un.pn * BM + wc * 32 + 8 * fq;
        u32x4 bw[2][4][2];
#pragma unroll
        for (int m = 0; m < 4; ++m)
#pragma unroll
            for (int bj = 0; bj < 2; ++bj) bw[0][m][bj] = *(const u32x4*)(baseb + (size_t)(rowb + m * 16) * DM + col0 + bj * HALF);
#pragma unroll
        for (int ai = 0; ai < 2; ++ai) {
            u32x4 ow[4][2]; float ssv[4];
#pragma unroll
            for (int m = 0; m < 4; ++m) { float ss = 0.f;
#pragma unroll
                for (int bj = 0; bj < 2; ++bj) { f32x4 b0, b1; unpack8(bw[ai][m][bj], b0, b1);
                    const f32x4 v0 = acc[ai][bj][m][0] + b0, v1 = acc[ai][bj][m][1] + b1;
                    ow[m][bj] = pack8f(v0, v1);
                    ss += (v0[0] * v0[0] + v0[1] * v0[1]) + (v0[2] * v0[2] + v0[3] * v0[3]) + (v1[0] * v1[0] + v1[1] * v1[1]) + (v1[2] * v1[2] + v1[3] * v1[3]); }
                ss += __shfl_xor(ss, 16); ss += __shfl_xor(ss, 32); ssv[m] = ss; }
            if (ai == 0) {
#pragma unroll
                for (int m = 0; m < 4; ++m)
#pragma unroll
                    for (int bj = 0; bj < 2; ++bj) bw[1][m][bj] = *(const u32x4*)(baseb + (size_t)(rowb + HALF + m * 16) * DM + col0 + bj * HALF); }
#pragma unroll
            for (int m = 0; m < 4; ++m) { const int row = rowb + ai * HALF + m * 16; const size_t off = (size_t)row * DM + col0;
#pragma unroll
                for (int bj = 0; bj < 2; ++bj) *(u32x4*)(xb + off + bj * HALF) = ow[m][bj];
                if (fq == 0) atomicAdd(ssq + row, (ssq_t)(ssv[m] * SSQ_SCALE + 0.5f)); } }
    }
};
struct EpiGU {
    static constexpr bool PERM = true, AFTER_DRAIN = false;
    const ssq_t* ssq; bf16_t* O;
    __device__ __forceinline__ bool keep(const Unit&) const { return false; }
    __device__ __forceinline__ void operator()(f32x4 (&acc)[2][2][4][2], const Unit& un, int wr, int wc, int fr, int fq) const {
        const int rowb = un.pm * BM + wr * 64 + fr, col0 = un.pn * HALF + wc * 32 + 8 * fq;
        float rsc[2][4];
#pragma unroll
        for (int ai = 0; ai < 2; ++ai)
#pragma unroll
            for (int m = 0; m < 4; ++m) rsc[ai][m] = rs_of(ssq, rowb + ai * HALF + m * 16);
#pragma unroll
        for (int ai = 0; ai < 2; ++ai)
#pragma unroll
            for (int m = 0; m < 4; ++m) { const int row = rowb + ai * HALF + m * 16; const float r = rsc[ai][m];
                f32x4 o[2];
#pragma unroll
                for (int n = 0; n < 2; ++n) { const f32x4 g = acc[ai][0][m][n] * r, u = acc[ai][1][m][n] * r;
#pragma unroll
                    for (int j = 0; j < 4; ++j) o[n][j] = g[j] * sigmoidf_(g[j]) * u[j]; }
                *(u32x4*)(O + (size_t)row * DFF + col0) = pack8f(o[0], o[1]); }
    }
};

template <bool F8> struct Frag { bf16x8 k[2]; };
template <> struct Frag<true> { i32x8v v; };
template <class Epi, class Sched, bool ALIGN_EPI = false, bool SP2 = false, bool F8 = false>
__device__ __forceinline__ void gemm_phase(LAS unsigned char* lds, const Gemm g, const Sched& S, const Epi& E) {
    int tid = threadIdx.x; asm volatile("" : "+v"(tid));
    const int wid = __builtin_amdgcn_readfirstlane(tid >> 6), lane = tid & 63, wr = wid >> 2, wc = wid & 3, fr = lane & 15, fq = lane >> 4;
    const int K = g.K, nt = K / BK, ld = g.ld;
    unsigned voffA[2], voffB[2];
#pragma unroll
    for (int i = 0; i < 2; ++i) { int R, C; stage_rc(tid * 16 + i * 8192, R, C); const int Rb = Epi::PERM ? ((R & ~31) + perm32(R & 31)) : R;
        voffA[i] = (unsigned)(R * ld + C) * 2u; voffB[i] = (unsigned)(Rb * ld + C) * 2u; }
    const size_t kstep = (size_t)(BK * 2);
    const size_t hstep = (size_t)HALF * ld * 2;
    const size_t tstep = 2 * hstep;
    const unsigned ldsw = (unsigned)wid * 1024u;
    const int aoff = lds_byte(wr * 64 + fr, fq * 8), boff = lds_byte(wc * 32 + fr, fq * 8);
#define PG8_SA(b, h) (((b) * 2 + (h)) * HTB)
#define PG8_SB(b, h) ((4 + (b) * 2 + (h)) * HTB)
#define PG8_STAGE(bufoff, gbase, voff) do { _Pragma("unroll") for (int _i = 0; _i < 2; ++_i) \
        __builtin_amdgcn_global_load_lds((const unsigned*)((const char*)(gbase) + (voff)[_i]), (LAS unsigned*)(lds + (bufoff) + ldsw + _i * 8192), 16, 0, 0); } while (0)
#define PG8_LDF(dst, addr) do { if constexpr (F8) { dst.v.lo = *(const LAS i32x4v*)(addr); dst.v.hi = *(const LAS i32x4v*)((addr) + 1024); } else { dst.k[0] = *(const LAS bf16x8*)(addr); dst.k[1] = *(const LAS bf16x8*)((addr) + 1024); } } while (0)
#define PG8_LDA(dst, b, h) do { _Pragma("unroll") for (int m = 0; m < 4; ++m) PG8_LDF(dst[m], lds + PG8_SA(b, h) + aoff + m * 2048); } while (0)
#define PG8_LDB(dst, b, h) do { _Pragma("unroll") for (int n = 0; n < 2; ++n) PG8_LDF(dst[n], lds + PG8_SB(b, h) + boff + n * 2048); } while (0)
#define PG8_MMA(ai, bj, At, Bt) do { __builtin_amdgcn_s_setprio(1); _Pragma("unroll") for (int m = 0; m < 4; ++m) _Pragma("unroll") for (int n = 0; n < 2; ++n) { \
        if constexpr (F8) asm volatile("v_mfma_f32_16x16x128_f8f6f4 %0, %1, %2, %0" : "+v"(acc[ai][bj][m][n]) : "v"(Bt[n].v), "v"(At[m].v));     \
        else { _Pragma("unroll") for (int k = 0; k < 2; ++k) acc[ai][bj][m][n] = __builtin_amdgcn_mfma_f32_16x16x32_bf16(Bt[n].k[k], At[m].k[k], acc[ai][bj][m][n], 0, 0, 0); } } \
        __builtin_amdgcn_s_setprio(0); } while (0)
#define PG8_WAIT_V(n) asm volatile("s_waitcnt vmcnt(" #n ")" ::: "memory")
#define PG8_WAIT_L(n) asm volatile("s_waitcnt lgkmcnt(" #n ")" ::: "memory")
#define PG8_BAR __builtin_amdgcn_s_barrier()
#define PG8_SCHED __builtin_amdgcn_sched_barrier(0)
    Unit cur, nxt; int ui = 0;
    if (!S.next(0, cur)) return;
    f32x4 acc[2][2][4][2];
#pragma unroll
    for (int a = 0; a < 2; ++a)
#pragma unroll
        for (int b = 0; b < 2; ++b)
#pragma unroll
            for (int m = 0; m < 4; ++m)
#pragma unroll
                for (int n = 0; n < 2; ++n) acc[a][b][m][n] = (f32x4){0.f, 0.f, 0.f, 0.f};
    Frag<F8> At[4], B0[2], B1[2];
    const char* cA = (const char*)g.A + (size_t)cur.pm * tstep + (size_t)cur.ko * 2; const char* cB = (const char*)g.Bt + (size_t)cur.pn * tstep + (size_t)cur.ko * 2;
    S.a_ready(cur);
    if constexpr (SP2) {
        PG8_STAGE(PG8_SB(0, 0), cB, voffB); PG8_STAGE(PG8_SB(0, 1), cB + hstep, voffB); PG8_STAGE(PG8_SA(0, 0), cA, voffA); PG8_STAGE(PG8_SA(0, 1), cA + hstep, voffA);
        if (wr == 1) PG8_BAR;
        PG8_WAIT_V(2); PG8_BAR;
        PG8_STAGE(PG8_SB(1, 0), cB + kstep, voffB); PG8_STAGE(PG8_SA(1, 0), cA + kstep, voffA); PG8_STAGE(PG8_SB(1, 1), cB + hstep + kstep, voffB);
        PG8_WAIT_V(6); PG8_BAR;
    } else {
        PG8_STAGE(PG8_SB(0, 0), cB, voffB); PG8_STAGE(PG8_SA(0, 0), cA, voffA); PG8_STAGE(PG8_SB(0, 1), cB + hstep, voffB); PG8_STAGE(PG8_SA(0, 1), cA + hstep, voffA);
        if (wr == 1) PG8_BAR;
        PG8_WAIT_V(4); PG8_BAR;
        PG8_STAGE(PG8_SB(1, 0), cB + kstep, voffB); PG8_STAGE(PG8_SA(1, 0), cA + kstep, voffA); PG8_STAGE(PG8_SB(1, 1), cB + hstep + kstep, voffB);
        PG8_WAIT_V(6); PG8_BAR;
    }
    for (;;) {
        const bool has_next = S.next(ui + 1, nxt);
        const char* nA = has_next ? (const char*)g.A + (size_t)nxt.pm * tstep + (size_t)nxt.ko * 2 : cA; const char* nB = has_next ? (const char*)g.Bt + (size_t)nxt.pn * tstep + (size_t)nxt.ko * 2 : cB;
        for (int t = 0; t < nt; t += 2) {
            const bool last = (t == nt - 2);
            const char* a1 = cA + (size_t)(t + 1) * kstep;
            const char* a2 = last ? nA : cA + (size_t)(t + 2) * kstep; const char* b2 = last ? nB : cB + (size_t)(t + 2) * kstep;
            const char* a3 = a2 + kstep; const char* b3 = b2 + kstep;
            if (last && has_next) S.a_ready(nxt);
            if constexpr (SP2) {
            PG8_LDB(B0, 0, 0); PG8_LDB(B1, 0, 1); PG8_SCHED; PG8_LDA(At, 0, 0); PG8_STAGE(PG8_SA(1, 1), a1 + hstep, voffA);
            PG8_WAIT_V(8); PG8_WAIT_L(0); PG8_BAR; PG8_MMA(0, 0, At, B0); PG8_MMA(0, 1, At, B1); PG8_BAR; PG8_SCHED;
            PG8_LDA(At, 0, 1); PG8_STAGE(PG8_SB(0, 0), b2, voffB); PG8_STAGE(PG8_SB(0, 1), b2 + hstep, voffB); PG8_STAGE(PG8_SA(0, 0), a2, voffA);
            PG8_WAIT_V(8); PG8_WAIT_L(0); PG8_BAR; PG8_MMA(1, 0, At, B0); PG8_MMA(1, 1, At, B1); PG8_BAR; PG8_SCHED;
            PG8_LDB(B0, 1, 0); PG8_LDB(B1, 1, 1); PG8_SCHED; PG8_LDA(At, 1, 0); PG8_STAGE(PG8_SA(0, 1), a2 + hstep, voffA);
            PG8_WAIT_V(8); PG8_WAIT_L(0); PG8_BAR; PG8_MMA(0, 0, At, B0); PG8_MMA(0, 1, At, B1); PG8_BAR; PG8_SCHED;
            PG8_LDA(At, 1, 1); PG8_STAGE(PG8_SB(1, 0), b3, voffB); PG8_STAGE(PG8_SB(1, 1), b3 + hstep, voffB); PG8_STAGE(PG8_SA(1, 0), a3, voffA);
            PG8_WAIT_V(8); PG8_WAIT_L(0); PG8_BAR; PG8_MMA(1, 0, At, B0); PG8_MMA(1, 1, At, B1); PG8_BAR; PG8_SCHED;
            } else {
            PG8_LDB(B0, 0, 0); PG8_SCHED; PG8_LDA(At, 0, 0); PG8_STAGE(PG8_SA(1, 1), a1 + hstep, voffA);
            PG8_WAIT_L(8); PG8_BAR; PG8_WAIT_L(0); PG8_MMA(0, 0, At, B0); PG8_BAR; PG8_SCHED;
            PG8_LDB(B1, 0, 1); PG8_STAGE(PG8_SB(0, 0), b2, voffB);
            PG8_BAR; PG8_WAIT_L(0); PG8_MMA(0, 1, At, B1); PG8_BAR;
            PG8_LDA(At, 0, 1); PG8_STAGE(PG8_SA(0, 0), a2, voffA);
            PG8_BAR; PG8_WAIT_L(0); PG8_MMA(1, 0, At, B0); PG8_BAR; PG8_SCHED;
            PG8_STAGE(PG8_SB(0, 1), b2 + hstep, voffB);
            PG8_WAIT_V(6); PG8_BAR; PG8_MMA(1, 1, At, B1); PG8_BAR;
            PG8_LDB(B0, 1, 0); PG8_SCHED; PG8_LDA(At, 1, 0); PG8_STAGE(PG8_SA(0, 1), a2 + hstep, voffA);
            PG8_WAIT_L(8); PG8_BAR; PG8_WAIT_L(0); PG8_MMA(0, 0, At, B0); PG8_BAR; PG8_SCHED;
            PG8_LDB(B1, 1, 1); PG8_STAGE(PG8_SB(1, 0), b3, voffB);
            PG8_BAR; PG8_WAIT_L(0); PG8_MMA(0, 1, At, B1); PG8_BAR;
            PG8_LDA(At, 1, 1); PG8_STAGE(PG8_SA(1, 0), a3, voffA);
            PG8_BAR; PG8_WAIT_L(0); PG8_MMA(1, 0, At, B0); PG8_BAR; PG8_SCHED;
            PG8_STAGE(PG8_SB(1, 1), b3 + hstep, voffB);
            PG8_WAIT_V(6); PG8_BAR; PG8_MMA(1, 1, At, B1); PG8_BAR;
            }
        }
        if constexpr (ALIGN_EPI) { if (wr == 0) PG8_BAR; }
        if constexpr (F8) asm volatile("s_nop 15\n\ts_nop 15" ::: "memory");
        E(acc, cur, wr, wc, fr, fq); S.done(cur);
        if (!has_next) break;
        if (!E.keep(cur)) {
#pragma unroll
        for (int a = 0; a < 2; ++a)
#pragma unroll
            for (int b = 0; b < 2; ++b)
#pragma unroll
                for (int m = 0; m < 4; ++m)
#pragma unroll
                    for (int n = 0; n < 2; ++n) acc[a][b][m][n] = (f32x4){0.f, 0.f, 0.f, 0.f};
        }
        cur = nxt; cA = nA; cB = nB; ++ui;
        if constexpr (ALIGN_EPI) { if (wr == 1) PG8_BAR; }
    }
    PG8_WAIT_V(0);
    if constexpr (!ALIGN_EPI) { if (wr == 0) PG8_BAR; }
    PG8_BAR;
#undef PG8_SA
#undef PG8_SB
#undef PG8_STAGE
#undef PG8_LDA
#undef PG8_LDB
#undef PG8_MMA
#undef PG8_WAIT_V
#undef PG8_WAIT_L
#undef PG8_BAR
#undef PG8_SCHED
}
}

namespace att {
constexpr int D = 128, NW = 8, QBLK = 32, KVBLK = 64, QB = NW * QBLK;
constexpr int SHM_V = KVBLK * D * 2, SHM_K = KVBLK * D * 2;
constexpr int LDS_BYTES = 2 * SHM_V + 2 * SHM_K + NW * 64 * 4;
constexpr float SCALE = 0.08838834764831845f, THR = 8.f;
#define KSWZ(row, colB) ((row) * 256 + ((colB) ^ (((row) & 7) << 4)))
#define SBAR() __builtin_amdgcn_sched_barrier(0)
__device__ __forceinline__ int v_st(int k, int c) { const int kk = (k & ~0xC) | ((k & 4) << 1) | ((k & 8) >> 1); return ((kk >> 3) * 4 + (c >> 5)) * 512 + ((kk & 7) * 32 + (c & 31)) * 2; }
__device__ __forceinline__ int v_rd_base(int lane) { return ((lane & 3) << 3) | (((lane >> 2) & 3) << 6) | (((lane >> 4) & 1) << 5) | (((lane >> 5) & 1) << 8); }
constexpr int v_rd_off(int d0, int ks, int half) { return d0 * 512 + ks * 4096 + half * 2048; }
__device__ __forceinline__ int crow(int r, int hi) { return (r & 3) + 8 * (r >> 2) + 4 * hi; }
__device__ __forceinline__ unsigned cvtpk(float lo, float hi) { return cvt_pk_bf16(lo, hi); }
__device__ __forceinline__ bf16x8 load8(const bf16_t* p) { return *reinterpret_cast<const bf16x8*>(p); }
__device__ __forceinline__ void mask_tile(f32x16& p0, f32x16& p1, int dq) {
    const float NEG = -__builtin_inff();
#pragma unroll
    for (int r = 0; r < 16; ++r) {
        const int c = (r & 3) + 8 * (r >> 2);
        if (dq - c < 0) p0[r] = NEG;
        if (dq - c - 32 < 0) p1[r] = NEG;
    }
}
__device__ __forceinline__ void partialSM(f32x16& p0, f32x16& p1, float& m_reg, float& mn, float& alpha, bool ract) {
    float pmax = p0[0];
#pragma unroll
    for (int r = 1; r < 16; ++r) pmax = fmaxf(pmax, p0[r]);
#pragma unroll
    for (int r = 0; r < 16; ++r) pmax = fmaxf(pmax, p1[r]);
    { auto rr = __builtin_amdgcn_permlane32_swap(__float_as_uint(pmax), __float_as_uint(pmax), false, false);
      pmax = fmaxf(__uint_as_float(rr[0]), __uint_as_float(rr[1])); }
    pmax = ract ? pmax : -__builtin_inff();
    constexpr float C2 = 1.4426950408889634f * SCALE;
    if (__builtin_expect(__all((pmax - m_reg) * SCALE <= THR), 1)) { mn = m_reg; alpha = 1.f; }
    else { mn = fmaxf(m_reg, pmax); alpha = __builtin_amdgcn_exp2f((m_reg - mn) * C2); m_reg = mn; }
    const float mnL = ract ? -mn * C2 : -__builtin_inff();
#pragma unroll
    for (int r = 0; r < 16; ++r) p0[r] = fmaf(p0[r], C2, mnL);
#pragma unroll
    for (int r = 0; r < 16; ++r) p1[r] = fmaf(p1[r], C2, mnL);
#pragma unroll
    for (int r = 0; r < 16; ++r) p0[r] = __builtin_amdgcn_exp2f(p0[r]);
}
__device__ __forceinline__ void finishSM(f32x16& p0, f32x16& p1, float alpha, float& l_reg, bf16x8& pa0, bf16x8& pa1, bf16x8& pa2, bf16x8& pa3) {
#pragma unroll
    for (int r = 0; r < 16; ++r) p1[r] = __builtin_amdgcn_exp2f(p1[r]);
    float ps = 0;
#pragma unroll
    for (int r = 0; r < 16; ++r) ps += p0[r];
#pragma unroll
    for (int r = 0; r < 16; ++r) ps += p1[r];
    { auto rr = __builtin_amdgcn_permlane32_swap(__float_as_uint(ps), __float_as_uint(ps), false, false);
      ps = __uint_as_float(rr[0]) + __uint_as_float(rr[1]); }
    l_reg = l_reg * alpha + ps;
#define PK4(P, B_, OUT) do { unsigned a0 = cvtpk(P[B_+0], P[B_+1]), a1 = cvtpk(P[B_+2], P[B_+3]);                          \
        unsigned b0 = cvtpk(P[B_+4], P[B_+5]), b1 = cvtpk(P[B_+6], P[B_+7]);                                             \
        auto r0 = __builtin_amdgcn_permlane32_swap(a0, b0, false, false); auto r1 = __builtin_amdgcn_permlane32_swap(a1, b1, false, false); \
        u32x4 w = {r0[0], r1[0], r0[1], r1[1]}; OUT = *reinterpret_cast<bf16x8*>(&w); } while (0)
    PK4(p0, 0, pa0); PK4(p0, 8, pa1); PK4(p1, 0, pa2); PK4(p1, 8, pa3);
#undef PK4
}
template <int KB>
__device__ __forceinline__ void qkt(f32x16& p0, f32x16& p1, const char* K_lds, int r32, int hi, const bf16x8* qr) {
    p0 = f32x16{}; p1 = f32x16{};
    const char* kb[4];
#pragma unroll
    for (int dd = 0; dd < 4; ++dd) kb[dd] = K_lds + KB * SHM_K + KSWZ(r32, (dd * 16 + hi * 8) * 2);
#pragma unroll
    for (int d0 = 0; d0 < 8; ++d0) { const char* a = kb[d0 & 3] + (d0 >> 2) * 128;
        bf16x8 b0 = *reinterpret_cast<const bf16x8*>(a);
        bf16x8 b1 = *reinterpret_cast<const bf16x8*>(a + 32 * 256);
        p0 = __builtin_amdgcn_mfma_f32_32x32x16_bf16(b0, qr[d0], p0, 0, 0, 0);
        p1 = __builtin_amdgcn_mfma_f32_32x32x16_bf16(b1, qr[d0], p1, 0, 0, 0); }
}
template <int VOFF>
__device__ __forceinline__ void pv_tile(f32x16* o, int vb0, bf16x8 pa0, bf16x8 pa1, bf16x8 pa2, bf16x8 pa3) {
#define TRRD(dst, off) asm volatile("ds_read_b64_tr_b16 %0, %1 offset:%2" : "=&v"(dst) : "v"(vb0), "i"(off) : "memory")
#define PV_D0(d0) do { s16x4 l0, l1, l2, l3, h0, h1, h2, h3; constexpr int b_ = VOFF + v_rd_off(d0, 0, 0); \
        TRRD(l0, b_); TRRD(h0, b_ + 2048); TRRD(l1, b_ + 4096); TRRD(h1, b_ + 6144); TRRD(l2, b_ + 8192); TRRD(h2, b_ + 10240); TRRD(l3, b_ + 12288); TRRD(h3, b_ + 14336); \
        asm volatile("s_waitcnt lgkmcnt(0)" ::: "memory"); SBAR();   \
        o[d0] = __builtin_amdgcn_mfma_f32_32x32x16_bf16(pa0, (bf16x8){l0[0], l0[1], l0[2], l0[3], h0[0], h0[1], h0[2], h0[3]}, o[d0], 0, 0, 0);   \
        o[d0] = __builtin_amdgcn_mfma_f32_32x32x16_bf16(pa1, (bf16x8){l1[0], l1[1], l1[2], l1[3], h1[0], h1[1], h1[2], h1[3]}, o[d0], 0, 0, 0);   \
        o[d0] = __builtin_amdgcn_mfma_f32_32x32x16_bf16(pa2, (bf16x8){l2[0], l2[1], l2[2], l2[3], h2[0], h2[1], h2[2], h2[3]}, o[d0], 0, 0, 0);   \
        o[d0] = __builtin_amdgcn_mfma_f32_32x32x16_bf16(pa3, (bf16x8){l3[0], l3[1], l3[2], l3[3], h3[0], h3[1], h3[2], h3[3]}, o[d0], 0, 0, 0); } while (0)
    PV_D0(0); PV_D0(1); PV_D0(2); PV_D0(3);
#undef PV_D0
#undef TRRD
}
template <int VOFF>
__device__ __forceinline__ void pv_tile_T(f32x16* o, int vb0, bf16x8 pa0, bf16x8 pa1, bf16x8 pa2, bf16x8 pa3) {
#define TRRD(dst, off) asm volatile("ds_read_b64_tr_b16 %0, %1 offset:%2" : "=&v"(dst) : "v"(vb0), "i"(off) : "memory")
#define PV_D0(d0) do { s16x4 l0, l1, l2, l3, h0, h1, h2, h3; constexpr int b_ = VOFF + v_rd_off(d0, 0, 0); \
        TRRD(l0, b_); TRRD(h0, b_ + 2048); TRRD(l1, b_ + 4096); TRRD(h1, b_ + 6144); TRRD(l2, b_ + 8192); TRRD(h2, b_ + 10240); TRRD(l3, b_ + 12288); TRRD(h3, b_ + 14336); \
        asm volatile("s_waitcnt lgkmcnt(0)" ::: "memory"); SBAR();   \
        o[d0] = __builtin_amdgcn_mfma_f32_32x32x16_bf16((bf16x8){l0[0], l0[1], l0[2], l0[3], h0[0], h0[1], h0[2], h0[3]}, pa0, o[d0], 0, 0, 0);   \
        o[d0] = __builtin_amdgcn_mfma_f32_32x32x16_bf16((bf16x8){l1[0], l1[1], l1[2], l1[3], h1[0], h1[1], h1[2], h1[3]}, pa1, o[d0], 0, 0, 0);   \
        o[d0] = __builtin_amdgcn_mfma_f32_32x32x16_bf16((bf16x8){l2[0], l2[1], l2[2], l2[3], h2[0], h2[1], h2[2], h2[3]}, pa2, o[d0], 0, 0, 0);   \
        o[d0] = __builtin_amdgcn_mfma_f32_32x32x16_bf16((bf16x8){l3[0], l3[1], l3[2], l3[3], h3[0], h3[1], h3[2], h3[3]}, pa3, o[d0], 0, 0, 0); } while (0)
    PV_D0(0); PV_D0(1); PV_D0(2); PV_D0(3);
#undef PV_D0
#undef TRRD
}
struct BlockRef { const bf16_t* Q; const bf16_t* K; const bf16_t* V; bf16_t* O; int P0; int jlo; const unsigned* sel; float* lse; };
struct Seam { bf16x8 qr[8]; bf16x8 st_v0, st_v1, st_k0, st_k1; };
#define ROW(p, k0, rr) ((p) + (size_t)((k0) + (rr)) * KP + sc)
#define VMW() asm volatile("s_waitcnt vmcnt(0)" ::: "memory")
#define VMWN(n) asm volatile("s_waitcnt vmcnt(%0)" :: "i"(n) : "memory")
#define SLOAD_H(Kp, Vp, k0) do { S.st_v0 = load8(ROW(Vp, k0, sr)); S.st_v1 = load8(ROW(Vp, k0, 32 + sr));              \
                         S.st_k0 = load8(ROW(Kp, k0, sr)); S.st_k1 = load8(ROW(Kp, k0, 32 + sr)); } while (0)
#define SWRITE_HK(bf) do { *(bf16x8*)(K_lds + (bf) * SHM_K + kws) = S.st_k0; *(bf16x8*)(K_lds + (bf) * SHM_K + kws + 32 * 256) = S.st_k1; } while (0)
#define SWRITE_HV(bf) do { *(bf16x8*)(V_lds + (bf) * SHM_V + vst0) = S.st_v0; *(bf16x8*)(V_lds + (bf) * SHM_V + vst1) = S.st_v1; } while (0)
#define SWRITE_H(bf) do { SWRITE_HV(bf); SWRITE_HK(bf); } while (0)
template <int QP, int KP>
__device__ __forceinline__ void prime(const BlockRef& cur, char* lds, Seam& S) {
    int tid = threadIdx.x; asm volatile("" : "+v"(tid)); const int wid = __builtin_amdgcn_readfirstlane(tid >> 6), lane = tid & 63, r32 = lane & 31, hi = lane >> 5;
    const int sr = tid >> 4, sc = (tid & 15) * 8, kws = KSWZ(sr, sc * 2); char* K_lds = lds + 2 * SHM_V;
#pragma unroll
    for (int d0 = 0; d0 < 8; ++d0) S.qr[d0] = load8(cur.Q + (size_t)(wid * QBLK + r32) * QP + d0 * 16 + hi * 8);
    SLOAD_H(cur.K, cur.V, cur.jlo * KVBLK); VMW(); SWRITE_HK(0);
    __syncthreads();
}
template <int QP, int KP, int OP, bool OLDS = false>
__device__ __forceinline__ void block(const BlockRef& cur, const BlockRef& nxt, int skv, char* lds, Seam& S) {
    int tid = threadIdx.x; asm volatile("" : "+v"(tid)); const int wid = __builtin_amdgcn_readfirstlane(tid >> 6), lane = tid & 63, r32 = lane & 31, hi = lane >> 5;
    int j_hi = (cur.P0 + QB - 1) / KVBLK + 1; if (j_hi > skv / KVBLK) j_hi = skv / KVBLK;
    const int j_lo = cur.jlo, NT = j_hi - j_lo;
    const int qlo = cur.P0 + wid * QBLK, qm = qlo + r32 - 4 * hi;
    char* V_lds = lds; char* K_lds = lds + 2 * SHM_V;
    float* ws = (float*)(lds + 2 * SHM_V + 2 * SHM_K) + wid * 64; float* li_l = ws, * al_l = ws + 32;
    float m_reg = -1e30f, l_reg = 0; f32x16 o[4] = {};
    const int sr = tid >> 4, sc = (tid & 15) * 8, vst0 = v_st(sr, sc), vst1 = v_st(32 + sr, sc), kws = KSWZ(sr, sc * 2);
    const int vb0 = (int)(uintptr_t)V_lds + v_rd_base(lane);
    const bf16_t* Kh = cur.K; const bf16_t* Vh = cur.V;
    const unsigned selw = cur.sel ? cur.sel[qlo + r32] : 0xffffffffu;
#define RESC(a) do { if (__any((a) < 1.f)) { if (hi == 0) al_l[r32] = (a); asm volatile("s_waitcnt lgkmcnt(0)" ::: "memory");              \
                     for (int d_ = 0; d_ < 4; ++d_) for (int r = 0; r < 16; ++r) o[d_][r] *= al_l[crow(r, hi)]; } } while (0)
#define KBASE(t) ((j_lo + (t)) * KVBLK)
#define RACT(t) (((selw >> ((KBASE(t) >> 8) & 31)) & 1u) != 0u)
#define MASKT(P0_, P1_, t) do { const int kb_ = KBASE(t); if (kb_ + KVBLK - 1 > qlo) mask_tile(P0_, P1_, qm - kb_); } while (0)
    constexpr int NQL = 8;
#define SEAM_K0() do { VMWN(NQL); SWRITE_HK(0); SBAR(); } while (0)
    f32x16 pA0, pA1, pB0, pB1; float mnA, mnB, alA, alB; bf16x8 pa0, pa1, pa2, pa3;
    SWRITE_HV(0); SBAR();
    if (NT > 1) { SLOAD_H(Kh, Vh, KBASE(1)); }
    SBAR(); qkt<0>(pA0, pA1, K_lds, r32, hi, S.qr);
    MASKT(pA0, pA1, 0); partialSM(pA0, pA1, m_reg, mnA, alA, RACT(0));
    if (NT > 1) { VMW(); SWRITE_H(1); }
    __syncthreads();
#define HALF_STEP(PX0, PX1, mnX, alX, PY0, PY1, alY, t, KB, VB, SB) do {                                                      \
        SBAR(); qkt<KB>(PX0, PX1, K_lds, r32, hi, S.qr);                                             \
        finishSM(PY0, PY1, alY, l_reg, pa0, pa1, pa2, pa3); SBAR();                                                           \
        if ((t) + 1 < NT) { SLOAD_H(Kh, Vh, KBASE((t) + 1)); SBAR(); }                                               \
        pv_tile<VB * SHM_V>(o, vb0, pa0, pa1, pa2, pa3); MASKT(PX0, PX1, (t)); partialSM(PX0, PX1, m_reg, mnX, alX, RACT(t));                                        \
        __syncthreads();                                                                                                      \
        if ((t) + 1 < NT) { VMW(); SWRITE_H(SB); }                                                                          \
        RESC(alX); __syncthreads(); } while (0)
    for (int t = 1; t + 1 < NT; t += 2) {
        HALF_STEP(pB0, pB1, mnB, alB, pA0, pA1, alA, t, 1, 0, 0);
        HALF_STEP(pA0, pA1, mnA, alA, pB0, pB1, alB, t + 1, 0, 1, 1);
    }
    const bool even = (NT & 1) == 0;
    if (even) { SBAR(); qkt<1>(pB0, pB1, K_lds, r32, hi, S.qr); SBAR(); }
    SLOAD_H(nxt.K, nxt.V, nxt.jlo * KVBLK); SBAR();
#pragma unroll
    for (int d0 = 0; d0 < 8; ++d0) S.qr[d0] = load8(nxt.Q + (size_t)(wid * QBLK + r32) * QP + d0 * 16 + hi * 8);
    SBAR();
    finishSM(pA0, pA1, alA, l_reg, pa0, pa1, pa2, pa3); SBAR();
    pv_tile<0>(o, vb0, pa0, pa1, pa2, pa3);
    if (even) { MASKT(pB0, pB1, NT - 1); partialSM(pB0, pB1, m_reg, mnB, alB, RACT(NT - 1)); __syncthreads(); RESC(alB);
        finishSM(pB0, pB1, alB, l_reg, pa0, pa1, pa2, pa3); SBAR(); pv_tile<SHM_V>(o, vb0, pa0, pa1, pa2, pa3); }
    SBAR(); SEAM_K0();
    if (hi == 0) li_l[r32] = l_reg; asm volatile("s_waitcnt lgkmcnt(0)" ::: "memory");
    if constexpr (OLDS) { int lo_ = (threadIdx.x >> 6) * QBLK + (threadIdx.x & 31); asm volatile("" : "+v"(lo_));
        if (hi == 0) ((float*)(lds + 133120))[lo_] = m_reg * (1.4426950408889634f * SCALE) + __builtin_amdgcn_logf(l_reg); }
    else { if (cur.lse && hi == 0) cur.lse[wid * QBLK + r32] = m_reg * (1.4426950408889634f * SCALE) + __builtin_amdgcn_logf(l_reg); }
    float rli[16];
#pragma unroll
    for (int r = 0; r < 16; ++r) rli[r] = __builtin_amdgcn_rcpf(li_l[crow(r, hi)]);
    int wq_ = (threadIdx.x >> 6) * QBLK; if constexpr (OLDS) asm volatile("" : "+v"(wq_));
    bf16_t* Ow = OLDS ? (bf16_t*)(lds + 67584) + (size_t)wq_ * OP : cur.O + (size_t)(wid * QBLK) * OP;
#pragma unroll
    for (int r = 0; r < 16; ++r) { const int orow = crow(r, hi);
#pragma unroll
        for (int d0 = 0; d0 < 4; ++d0) { const float v = o[d0][r] * rli[r];
            const float vn = __shfl_xor(v, 1);
            if ((r32 & 1) == 0) *(unsigned*)(Ow + (size_t)orow * OP + d0 * 32 + r32) = cvtpk(v, vn); } }
    __syncthreads();
#undef RESC
#undef KBASE
#undef RACT
#undef MASKT
#undef SEAM_K0
#undef HALF_STEP
}
__device__ __forceinline__ void gather_load_kv(const bf16_t* Kn, const bf16_t* Vn, char* lds) {
    int tid = threadIdx.x; asm volatile("" : "+v"(tid)); const int sr = tid >> 4, sc = (tid & 15) * 8; char* V_lds = lds; char* K_lds = lds + 4 * SHM_V;
    bf16x8 kk[8], vv[8];
#pragma unroll
    for (int i = 0; i < 8; ++i) { kk[i] = load8(Kn + (size_t)(sr + 32 * i) * AW + sc); vv[i] = load8(Vn + (size_t)(sr + 32 * i) * AW + sc); }
#pragma unroll
    for (int i = 0; i < 8; ++i) { const int t = i >> 1, rr = sr + 32 * (i & 1);
        *(bf16x8*)(K_lds + t * SHM_K + KSWZ(rr, sc * 2)) = kk[i]; *(bf16x8*)(V_lds + t * SHM_V + v_st(rr, sc)) = vv[i]; }
}
__device__ __forceinline__ void gather_run(const bf16_t* Qh, const unsigned short* list, int c_lo, int c_hi, int cnt, bf16_t* P01, bf16_t* P2, float* LSE, size_t rowbase, char* lds) {
    int tid = threadIdx.x; asm volatile("" : "+v"(tid)); const int wid = __builtin_amdgcn_readfirstlane(tid >> 6), lane = tid & 63, r32 = lane & 31, hi = lane >> 5;
    char* V_lds = lds; char* K_lds = lds + 4 * SHM_V;
    const int vb0 = (int)(uintptr_t)V_lds + v_rd_base(lane);
    bf16x8 qr[8], qn[8]; unsigned ent = 0xFFFFu, entn = 0xFFFFu; bool has = false, hasn = false;
#define GLOAD(C_, ENT, QR, HAS) do { const int ew_ = (C_) * 256 + wid * 32; HAS = ew_ < cnt; if (HAS) { const int e_ = ew_ + r32; const bool v_ = e_ < cnt; \
        ENT = v_ ? (unsigned)list[e_] : 0xFFFFu; const int sq_ = v_ ? (int)(ENT & 8191u) : (int)((unsigned)list[ew_] & 8191u); \
        _Pragma("unroll") for (int d0 = 0; d0 < 8; ++d0) QR[d0] = load8(Qh + (size_t)sq_ * AW + d0 * 16 + hi * 8); } } while (0)
    GLOAD(c_lo, ent, qr, has);
    for (int c = c_lo; c < c_hi; ++c) {
        hasn = false; if (c + 1 < c_hi) GLOAD(c + 1, entn, qn, hasn);
        if (has) {
            float m_reg = -1e30f, l_reg = 0; f32x16 o[4] = {};
            f32x16 pA0, pA1, pB0, pB1; float mnA, mnB, alA, alB; bf16x8 pa0, pa1, pa2, pa3;
#define GRESC(a) do { if (__any((a) < 1.f)) { _Pragma("unroll") for (int d_ = 0; d_ < 4; ++d_) o[d_] *= (a); } } while (0)
            SBAR(); qkt<0>(pA0, pA1, K_lds, r32, hi, qr); partialSM(pA0, pA1, m_reg, mnA, alA, true);
            SBAR(); qkt<1>(pB0, pB1, K_lds, r32, hi, qr); finishSM(pA0, pA1, alA, l_reg, pa0, pa1, pa2, pa3); SBAR(); pv_tile_T<0 * SHM_V>(o, vb0, pa0, pa1, pa2, pa3); partialSM(pB0, pB1, m_reg, mnB, alB, true); GRESC(alB);
            SBAR(); qkt<2>(pA0, pA1, K_lds, r32, hi, qr); finishSM(pB0, pB1, alB, l_reg, pa0, pa1, pa2, pa3); SBAR(); pv_tile_T<1 * SHM_V>(o, vb0, pa0, pa1, pa2, pa3); partialSM(pA0, pA1, m_reg, mnA, alA, true); GRESC(alA);
            SBAR(); qkt<3>(pB0, pB1, K_lds, r32, hi, qr); finishSM(pA0, pA1, alA, l_reg, pa0, pa1, pa2, pa3); SBAR(); pv_tile_T<2 * SHM_V>(o, vb0, pa0, pa1, pa2, pa3); partialSM(pB0, pB1, m_reg, mnB, alB, true); GRESC(alB);
            SBAR(); finishSM(pB0, pB1, alB, l_reg, pa0, pa1, pa2, pa3); SBAR(); pv_tile_T<3 * SHM_V>(o, vb0, pa0, pa1, pa2, pa3);
#undef GRESC
            if (ent != 0xFFFFu) { const unsigned sl = ent >> 13; const size_t row = rowbase + (ent & 8191u);
                if (hi == 0) LSE[(size_t)sl * (BATCH * NH * SEQ) + row] = m_reg * (1.4426950408889634f * SCALE) + __builtin_amdgcn_logf(l_reg);
                const float rl = __builtin_amdgcn_rcpf(l_reg);
                bf16_t* dst = (sl < 2u ? P01 + (size_t)sl * ((size_t)BATCH * NH * SEQ * D) : P2) + row * D + 4 * hi;
#pragma unroll
                for (int d0 = 0; d0 < 4; ++d0)
#pragma unroll
                    for (int g = 0; g < 4; ++g) { u32x2 w; w.x = cvtpk(o[d0][4 * g] * rl, o[d0][4 * g + 1] * rl); w.y = cvtpk(o[d0][4 * g + 2] * rl, o[d0][4 * g + 3] * rl);
                        *(u32x2*)(dst + d0 * 32 + 8 * g) = w; } }
        }
        has = hasn; ent = entn;
#pragma unroll
        for (int d0 = 0; d0 < 8; ++d0) qr[d0] = qn[d0];
    }
#undef GLOAD
}
#undef ROW
#undef VMW
#undef VMWN
#undef SLOAD_H
#undef SWRITE_HK
#undef SWRITE_HV
#undef SWRITE_H
}

constexpr int NWAVES = 8;
constexpr int N_PHASES = 15;
constexpr size_t MiB = 1u << 20;
constexpr size_t WS_CTL = 0, CTL_ZERO_BYTES = 1 * MiB;
constexpr size_t WS_KM = 1 * MiB, WS_SEL = 2 * MiB, WS_ROPE_C = 3 * MiB, WS_ROPE_S = 5 * MiB, WS_WSGU = 7 * MiB, WS_MEMKV = 8 * MiB, WS_MEMN = 9 * MiB;
constexpr size_t WS_WIN = 16 * MiB, WS_PCAT = 160 * MiB, WS_WOUT = 192 * MiB, WS_WXQ = 224 * MiB, WS_WXKV = 228 * MiB, WS_WXO = 236 * MiB, WS_WGU = 240 * MiB, WS_WDN = 412 * MiB;
constexpr size_t WS_XB = 498 * MiB;
constexpr size_t WS_Q = 626 * MiB, WS_U = 690 * MiB, WS_K = 754 * MiB, WS_V = 818 * MiB, WS_VS = 882 * MiB, WS_SA = 946 * MiB, WS_SB = 1074 * MiB, WS_END = 1202 * MiB;
constexpr size_t WS_MERGED = WS_K;
constexpr size_t WS_QX = WS_VS, WS_OX = WS_VS + 16 * MiB;
constexpr size_t WS_ACT = WS_Q;
static_assert(WS_WDN + (size_t)DM * DFF * 2 <= WS_XB && WS_WGU + (size_t)2 * DFF * DM * 2 <= WS_WDN && WS_ACT + (size_t)M * DFF * 2 <= WS_SB, "ws map");
constexpr int CW_TMO = 0;
constexpr int CW_BAR = 4096;
constexpr int CW_LCNT = 16384, CW_PCNT2 = 24576;
constexpr size_t CTL_SSQ = 256 * 1024;
constexpr int RING_BYTES = 131072, LDS_BYTES = 147456, LDSCTL_OFF = LDS_BYTES - 1024, MISC_OFF = LDSCTL_OFF + 320;
constexpr int OT_OFF = 67584, OTL_OFF = OT_OFF + 65536;

#define RLX_AGENT __ATOMIC_RELAXED, __HIP_MEMORY_SCOPE_AGENT
#define LDS_WAIT() asm volatile("s_waitcnt lgkmcnt(0)" ::: "memory")
#define VM_WAIT() asm volatile("s_waitcnt vmcnt(0)" ::: "memory")
__device__ __forceinline__ unsigned f2bf(float f) { unsigned u = __builtin_bit_cast(unsigned, f); return (u + 0x7fffu + ((u >> 16) & 1u)) >> 16; }
__device__ __forceinline__ unsigned pk2(float lo, float hi) { return f2bf(lo) | (f2bf(hi) << 16); }

#define XB_TMO      128
#define XB_XCNT(j)  (256  + 64 * (j))
#define XB_XSUB(j)  (1280 + 64 * (j))
#define XB_XGEN(j)  (2304 + 64 * (j))
#define XB_TOP      3328
#define XB_TOPGEN   3392
#define XCD_BAR_WORDS 3456
#define XB_SPIN_CAP (1u << 18)
__device__ __forceinline__ unsigned xb_ld(unsigned* p)              { return __hip_atomic_load(p, __ATOMIC_RELAXED, __HIP_MEMORY_SCOPE_AGENT); }
__device__ __forceinline__ unsigned xb_add(unsigned* p, unsigned v) { return __hip_atomic_fetch_add(p, v, __ATOMIC_RELAXED, __HIP_MEMORY_SCOPE_AGENT); }
__device__ __forceinline__ unsigned xb_xcc_id() { return (unsigned)__builtin_amdgcn_s_getreg((3 << 11) | 20) & 0xFu; }
#define XB_SPIN(cond, bar) do { unsigned _sp = 0; while (cond) { __builtin_amdgcn_s_sleep(1); \
    if ((++_sp & 255u) == 0u) { if (xb_ld(&(bar)[XB_TMO])) break; if (_sp > XB_SPIN_CAP) { atomicAdd(&(bar)[XB_TMO], 1u); break; } } } } while (0)
struct XcdBarrier { unsigned* bar; unsigned x; volatile LAS unsigned* st; };
__device__ __forceinline__ XcdBarrier xcd_barrier_post(unsigned* bar, volatile LAS unsigned* st) {
    XcdBarrier b; b.bar = bar; b.x = xb_xcc_id(); b.st = st;
    if (threadIdx.x == 0) (void)xb_add(&bar[XB_XCNT(b.x)], 1u);
    return b;
}
__device__ __forceinline__ void xcd_barrier_complete(unsigned* bar, unsigned x, unsigned& nloc, unsigned& nx) {
    const unsigned G = gridDim.x * gridDim.y * gridDim.z;
    unsigned sum, cnt, mine, sp = 0u;
    for (;;) {
        sum = 0u; cnt = 0u; mine = 0u;
#pragma unroll
        for (unsigned j = 0; j < 16; ++j) { const unsigned c = xb_ld(&bar[XB_XCNT(j)]); sum += c; cnt += (c > 0u) ? 1u : 0u; mine = (j == x) ? c : mine; }
        if (sum == G) break;
        __builtin_amdgcn_s_sleep(1);
        if ((++sp & 255u) == 0u) { if (xb_ld(&bar[XB_TMO])) break; if (sp > XB_SPIN_CAP) { atomicAdd(&bar[XB_TMO], 1u); break; } }
    }
    nloc = mine > 0u ? mine : 1u; nx = cnt > 0u ? cnt : 1u;
}
__device__ __forceinline__ void xcd_barrier(const XcdBarrier& b) {
    asm volatile("s_waitcnt vmcnt(0)" ::: "memory");
    __syncthreads();
    if (threadIdx.x == 0) {
        unsigned* bar = b.bar;
        __builtin_amdgcn_s_waitcnt(0);
        unsigned nloc = b.st[0], nx = b.st[1];
        if (nloc == 0u) { xcd_barrier_complete(bar, b.x, nloc, nx); b.st[0] = nloc; b.st[1] = nx; }
        const unsigned old = xb_add(&bar[XB_XSUB(b.x)], 1u);
        const unsigned gen = old / nloc;
        if (old + 1u == (gen + 1u) * nloc) {
            __builtin_amdgcn_fence(__ATOMIC_RELEASE, "agent");
            asm volatile("s_waitcnt vmcnt(0)" ::: "memory");
            const unsigned og = xb_add(&bar[XB_TOP], 1u);
            const unsigned tg = og / nx;
            if (og + 1u == (tg + 1u) * nx) xb_add(&bar[XB_TOPGEN], 1u);
            else XB_SPIN(xb_ld(&bar[XB_TOPGEN]) == tg, bar);
            __builtin_amdgcn_fence(__ATOMIC_ACQUIRE, "agent");
            xb_add(&bar[XB_XGEN(b.x)], 1u);
            asm volatile("s_waitcnt vmcnt(0)" ::: "memory");
        } else {
            XB_SPIN(xb_ld(&bar[XB_XGEN(b.x)]) == gen, bar);
            __builtin_amdgcn_fence(__ATOMIC_ACQUIRE, "agent");
            asm volatile("s_waitcnt vmcnt(0)" ::: "memory");
        }
    }
    __syncthreads();
}

__device__ __forceinline__ float wave_sum(float v) {
#pragma unroll
    for (int o = 1; o < 64; o <<= 1) v += __shfl_xor(v, o);
    return v;
}
__device__ __forceinline__ void tr_item64(const float* __restrict__ W, int K, int N, int k0, int n0, bf16_t* WT, int drow0, const float* __restrict__ gain, LAS unsigned* scr, int lane) {
    const float* src = W + (size_t)k0 * N + n0 + lane;
    float v[64];
#pragma unroll
    for (int r = 0; r < 64; ++r) v[r] = src[(size_t)r * N];
    if (gain) {
#pragma unroll
        for (int r = 0; r < 64; ++r) v[r] *= gain[k0 + r]; }
#pragma unroll
    for (int i = 0; i < 32; ++i) scr[i * 65 + lane] = cvt_pk_bf16(v[2 * i], v[2 * i + 1]);
    LDS_WAIT(); asm volatile("" ::: "memory");
    const int c = lane & 7;
#pragma unroll
    for (int jj = 0; jj < 8; ++jj) { const int n = (lane >> 3) + 8 * jj; const LAS unsigned* sp = scr + (4 * c) * 65 + n;
        u32x4 o; o.x = sp[0]; o.y = sp[65]; o.z = sp[130]; o.w = sp[195];
        *(GAS u32x4*)(WT + (size_t)(drow0 + n) * K + k0 + 8 * c) = o; }
    LDS_WAIT(); asm volatile("" ::: "memory");
}
struct TrItem { const float* W; bf16_t* WT; const float* gain; int K, N, k0, n0, kind, rowbase; };
__device__ __forceinline__ void tr_issue(const TrItem& it, f32x4 (&v)[8], int wave, int lane) {
    const float* src = it.W + (size_t)(it.k0 + 8 * wave) * it.N + it.n0 + 4 * lane;
#pragma unroll
    for (int r = 0; r < 8; ++r) v[r] = __builtin_nontemporal_load((const f32x4*)(src + (size_t)r * it.N));
}
__device__ __forceinline__ void tr_stage(const TrItem& it, const f32x4 (&v)[8], LAS unsigned* T, int wave, int lane) {
    if (it.kind >= 4) {
        float g[8];
#pragma unroll
        for (int r = 0; r < 8; ++r) g[r] = (it.gain ? it.gain[it.k0 + 8 * wave + r] : 1.f) * W8_SCALE;
#pragma unroll
        for (int j = 0; j < 4; ++j) { T[(4 * lane + j) * 17 + 2 * wave] = pk4_fp8(v[0][j] * g[0], v[1][j] * g[1], v[2][j] * g[2], v[3][j] * g[3]);
            T[(4 * lane + j) * 17 + 2 * wave + 1] = pk4_fp8(v[4][j] * g[4], v[5][j] * g[5], v[6][j] * g[6], v[7][j] * g[7]); }
        return; }
#pragma unroll
    for (int rp = 0; rp < 4; ++rp) { float g0 = 1.f, g1 = 1.f; if (it.gain) { g0 = it.gain[it.k0 + 8 * wave + 2 * rp]; g1 = it.gain[it.k0 + 8 * wave + 2 * rp + 1]; }
#pragma unroll
        for (int j = 0; j < 4; ++j) T[(4 * lane + j) * 33 + 4 * wave + rp] = cvt_pk_bf16(v[2 * rp][j] * g0, v[2 * rp + 1][j] * g1); }
}
__device__ __forceinline__ void tr_readout(const TrItem& it, const LAS unsigned* T, int tid) {
    if (it.kind >= 4) {
#pragma unroll
        for (int i = 0; i < 2; ++i) { const int q = tid + 512 * i, nl = q >> 2, c = q & 3, n = it.n0 + nl; int drow = it.rowbase + n;
            if (it.kind == 5) { const int t = n >> 8, l8 = n & 255; drow = t * 256 + 128 * ((l8 >> 6) & 1) + 64 * (l8 >> 7) + (l8 & 63); }
            const LAS unsigned* sp = T + nl * 17 + 4 * c; u32x4 o; o.x = sp[0]; o.y = sp[1]; o.z = sp[2]; o.w = sp[3];
            *(GAS u32x4*)((unsigned char*)it.WT + (size_t)drow * it.K + it.k0 + 16 * c) = o; }
        return; }
#pragma unroll
    for (int i = 0; i < 4; ++i) { const int q = tid + 512 * i, nl = q >> 3, c = q & 7, n = it.n0 + nl; int drow = it.rowbase + n;
        if (it.kind == 1) { if (n < 4096) { const int t = n >> 8, l8 = n & 255; drow = t * 256 + 128 * ((l8 >> 6) & 1) + 64 * (l8 >> 7) + (l8 & 63); } }
        else if (it.kind >= 2) drow = (n >> 7) * 256 + (it.kind == 3 ? 128 : 0) + (n & 127);
        const LAS unsigned* sp = T + nl * 33 + 4 * c; u32x4 o; o.x = sp[0]; o.y = sp[1]; o.z = sp[2]; o.w = sp[3];
        *(GAS u32x4*)(it.WT + (size_t)drow * it.K + it.k0 + 8 * c) = o; }
}
__device__ __forceinline__ float row_to_bf16(const float* xrow, bf16_t* orow, const float* gain, int lane, unsigned char* o8 = nullptr) {
    const GAS f32x4* xr = (const GAS f32x4*)xrow + lane;
    f32x4 v[16]; float s = 0.f;
#pragma unroll
    for (int j = 0; j < 16; ++j) { v[j] = __builtin_nontemporal_load(xr + 64 * j); s += (v[j].x * v[j].x + v[j].y * v[j].y) + (v[j].z * v[j].z + v[j].w * v[j].w); }
    s = wave_sum(s);
    const float r = gain ? __builtin_amdgcn_rsqf(s * (1.f / DM) + RMS_EPS) : 1.f;
    GAS u32x2* o8b = (GAS u32x2*)orow + lane;
#pragma unroll
    for (int j = 0; j < 16; ++j) { f32x4 g = gain ? ((const GAS f32x4*)gain)[lane + 64 * j] * r : (f32x4){1.f, 1.f, 1.f, 1.f}; f32x4 w = v[j] * g;
        u32x2 o; o.x = cvt_pk_bf16(w.x, w.y); o.y = cvt_pk_bf16(w.z, w.w); o8b[64 * j] = o;
        if (o8) ((GAS unsigned*)o8)[lane + 64 * j] = pk4_fp8(w.x * X8_SCALE, w.y * X8_SCALE, w.z * X8_SCALE, w.w * X8_SCALE); }
    return s;
}
__device__ const float INV_FREQ[64] = {1.f, 0.865964353f, 0.749894261f, 0.649381638f, 0.562341332f, 0.486967534f, 0.421696514f, 0.365174115f, 0.316227764f, 0.273841977f, 0.237137377f, 0.2053525f, 0.177827939f, 0.153992653f, 0.133352131f, 0.115478203f, 0.100000001f, 0.0865964293f, 0.0749894157f, 0.0649381652f, 0.0562341325f, 0.0486967526f, 0.0421696529f, 0.0365174115f, 0.0316227749f, 0.0273841973f, 0.0237137377f, 0.0205352511f, 0.0177827943f, 0.0153992651f, 0.0133352149f, 0.0115478206f, 0.00999999978f, 0.00865964312f, 0.00749894185f, 0.00649381615f, 0.00562341325f, 0.00486967526f, 0.00421696482f, 0.00365174119f, 0.00316227763f, 0.00273841969f, 0.00237137359f, 0.00205352483f, 0.00177827943f, 0.00153992651f, 0.00133352145f, 0.0011547819f, 0.00100000005f, 0.000865964335f, 0.000749894243f, 0.000649381662f, 0.000562341302f, 0.000486967532f, 0.000421696517f, 0.000365174143f, 0.000316227757f, 0.000273841957f, 0.00023713737f, 0.00020535251f, 0.00017782794f, 0.000153992645f, 0.00013335215f, 0.0001154782f};
__device__ __forceinline__ void rope_entry(int pos, int i, float& c, float& s) {
    const float af = (float)pos * INV_FREQ[i];
    const double x = (double)af, k = __builtin_rint(x * 0.63661977236758134308);
    double r = __builtin_fma(-k, 1.57079632673412561417e+00, x); r = __builtin_fma(-k, 6.07710050650619224932e-11, r);
    const double z = r * r;
    double sp = 1.0 / 1307674368000.0; sp = sp * z - 1.0 / 6227020800.0; sp = sp * z + 1.0 / 39916800.0; sp = sp * z - 1.0 / 362880.0; sp = sp * z + 1.0 / 5040.0; sp = sp * z - 1.0 / 120.0; sp = sp * z + 1.0 / 6.0;
    const double sn = r - r * z * sp;
    double cp = 1.0 / 20922789888000.0; cp = cp * z - 1.0 / 87178291200.0; cp = cp * z + 1.0 / 479001600.0; cp = cp * z - 1.0 / 3628800.0; cp = cp * z + 1.0 / 40320.0; cp = cp * z - 1.0 / 720.0; cp = cp * z + 1.0 / 24.0;
    const double cs = 1.0 - 0.5 * z + z * z * cp;
    const int q = (int)k & 3;
    const double so = (q & 1) ? cs : sn, co = (q & 1) ? sn : cs;
    s = (float)((q & 2) ? -so : so); c = (float)(((q + 1) & 2) ? -co : co);
}

__device__ __forceinline__ void sgu_unit(int unit, const bf16_t* __restrict__ VS, const unsigned long long* __restrict__ LNS, const bf16_t* U, bf16_t* OB, const bf16_t* __restrict__ Wt, const float* __restrict__ lng, const float* __restrict__ lnb,
                                         const float* __restrict__ bs, char* lds, int tid, int wid, int lane) {
    const int half = unit & 1, bc = unit >> 1, t0 = bc * SCH, r32 = lane & 31, hi = lane >> 5;
    float* stats = (float*)(lds + 65536);
    if (tid < SCH) { const float m1 = (float)(long long)LNS[2 * (t0 + tid)] * (1.f / (SSQ_SCALE * SW)), m2 = (float)(long long)LNS[2 * (t0 + tid) + 1] * (1.f / (SSQ_SCALE * SW));
        stats[2 * tid] = m1; stats[2 * tid + 1] = __builtin_amdgcn_rsqf(fmaxf(m2 - m1 * m1, 0.f) + LN_EPS); }
    __syncthreads();
    for (int gp = 0; gp < 4; ++gp) {
        const int g0 = half * 8 + gp * 2;
        { const int dc = tid & 15, s0 = tid >> 4; u32x4 vr[8];
#pragma unroll
            for (int i = 0; i < 8; ++i) vr[i] = *(const u32x4*)(VS + (size_t)(t0 + s0 + 32 * (i & 3)) * SW + (g0 + (i >> 2)) * 128 + dc * 8);
#pragma unroll
            for (int gi = 0; gi < 2; ++gi) { const int col = (g0 + gi) * 128 + dc * 8;
                const f32x4 ga = *(const f32x4*)(lng + col), gb = *(const f32x4*)(lng + col + 4), ba = *(const f32x4*)(lnb + col), bb = *(const f32x4*)(lnb + col + 4);
#pragma unroll
                for (int k = 0; k < 4; ++k) { const int s = s0 + 32 * k; f32x4 x0, x1; unpack8(vr[gi * 4 + k], x0, x1);
                    const float mean = stats[2 * s], rstd = stats[2 * s + 1];
                    x0 = (x0 - mean) * rstd * ga + ba; x1 = (x1 - mean) * rstd * gb + bb;
                    *(u32x4*)(lds + gi * 32768 + (s >> 6) * 16384 + att::v_st(s & 63, dc * 8)) = pack8f(x0, x1); } } }
        __syncthreads();
        const int grp = wid >> 2, tt = wid & 3, g = g0 + grp;
        f32x16 o[4] = {};
        const int vb0 = (int)(uintptr_t)lds + grp * 32768 + att::v_rd_base(lane);
        const bf16_t* wp = Wt + ((size_t)g * SCH + tt * 32 + r32) * SCH + hi * 8;
        { const bf16x8 pa0 = att::load8(wp), pa1 = att::load8(wp + 16), pa2 = att::load8(wp + 32), pa3 = att::load8(wp + 48); att::pv_tile<0>(o, vb0, pa0, pa1, pa2, pa3); }
        if (tt >= 2) { const bf16x8 pa0 = att::load8(wp + 64), pa1 = att::load8(wp + 80), pa2 = att::load8(wp + 96), pa3 = att::load8(wp + 112); att::pv_tile<16384>(o, vb0, pa0, pa1, pa2, pa3); }
#pragma unroll
        for (int rh = 0; rh < 2; ++rh) {
            unsigned short up[8][4]; float bias[8];
#pragma unroll
            for (int r = 0; r < 8; ++r) { const int t = tt * 32 + att::crow(rh * 8 + r, hi); bias[r] = bs[g * SCH + t];
#pragma unroll
                for (int d0 = 0; d0 < 4; ++d0) up[r][d0] = U[(size_t)(t0 + t) * SW + g * 128 + d0 * 32 + r32]; }
#pragma unroll
            for (int r = 0; r < 8; ++r) { const int t = tt * 32 + att::crow(rh * 8 + r, hi);
#pragma unroll
                for (int d0 = 0; d0 < 4; ++d0) { const size_t idx = (size_t)(t0 + t) * SW + g * 128 + d0 * 32 + r32;
                    const float uv = __builtin_bit_cast(float, (unsigned)up[r][d0] << 16), v = uv * (o[d0][rh * 8 + r] + bias[r]), vn = __shfl_xor(v, 1);
                    if ((r32 & 1) == 0) *(unsigned*)(OB + idx) = att::cvtpk(v, vn); } } }
        __syncthreads();
    }
}
__device__ __forceinline__ att::BlockRef own_ref(int unit, const bf16_t* Qb, const bf16_t* Kb, const bf16_t* Vb, bf16_t* Ob, float* lse3) {
    const int bh = unit >> 5, cur = unit & 31, b = bh >> 4, h = bh & 15;
    att::BlockRef r; r.Q = Qb + ((size_t)(b * SEQ + cur * 256)) * AW + h * HD; r.O = Ob + ((size_t)(b * SEQ + cur * 256)) * AW + h * HD; r.K = Kb + (size_t)(b * SEQ) * AW + h * HD; r.V = Vb + (size_t)(b * SEQ) * AW + h * HD;
    r.P0 = cur * 256; r.jlo = 4 * cur; r.sel = nullptr; r.lse = lse3 + (size_t)bh * SEQ + cur * 256; return r;
}
__device__ __forceinline__ att::BlockRef xattn_ref(int unit, const bf16_t* QX, const bf16_t* KV, bf16_t* OX) {
    const int b = unit >> 7, hx = (unit >> 5) & 3, qb = unit & 31;
    att::BlockRef r; r.Q = QX + ((size_t)(b * SEQ + qb * 256)) * XW + hx * HD; r.O = OX + ((size_t)(b * SEQ + qb * 256)) * XW + hx * HD;
    r.K = KV + (size_t)(b * NMEM) * (2 * XW) + hx * HD; r.V = r.K + XW; r.P0 = 256; r.jlo = 0; r.sel = nullptr; r.lse = nullptr; return r;
}

struct Args { const float* in[21]; float* out; unsigned char* ws; int ph_lo, ph_hi; };
#define ctl ((unsigned*)((unsigned*)(ws + WS_CTL)))
#define ssq1 ((ssq_t*)((ssq_t*)(ws + CTL_SSQ)))
#define ssq2 ((ssq_t*)(ssq1 + M))
#define ssq3 ((ssq_t*)(ssq2 + M))
#define ssq4 ((ssq_t*)(ssq3 + M))
#define x_in ((const float*)(args.in[0]))
#define mem_in ((const float*)(args.in[1]))
#define g_mix ((const float*)(args.in[2]))
#define w_in ((const float*)(args.in[3]))
#define ln_g ((const float*)(args.in[4]))
#define ln_b ((const float*)(args.in[5]))
#define w_sgu ((const float*)(args.in[6]))
#define b_sgu ((const float*)(args.in[7]))
#define w_pa ((const float*)(args.in[8]))
#define w_pb ((const float*)(args.in[9]))
#define w_out ((const float*)(args.in[10]))
#define g_xat ((const float*)(args.in[11]))
#define g_mem ((const float*)(args.in[12]))
#define w_xq ((const float*)(args.in[13]))
#define w_xkv ((const float*)(args.in[14]))
#define w_xo ((const float*)(args.in[15]))
#define g_ffn ((const float*)(args.in[16]))
#define w_gate ((const float*)(args.in[17]))
#define w_up ((const float*)(args.in[18]))
#define w_down ((const float*)(args.in[19]))
#define g_fin ((const float*)(args.in[20]))
#define out_f ((float*)(args.out))
#define kmpart ((float*)((float*)(ws + WS_KM)))
#define LSE3 ((float*)((float*)(ws + WS_SEL)))
#define LSE ((float*)((float*)(ws + 13 * MiB)))
#define lcnt ((unsigned*)(ctl + CW_LCNT))
#define lists ((unsigned short*)((unsigned short*)(ws + WS_WIN + 128 * MiB)))
#define P01 ((bf16_t*)((bf16_t*)(ws + WS_WIN)))
#define P2 ((bf16_t*)((bf16_t*)(ws + WS_VS)))
#define rope_c ((float*)((float*)(ws + WS_ROPE_C)))
#define rope_s ((float*)((float*)(ws + WS_ROPE_S)))
#define kvpart ((float*)((float*)(ws + WS_SA + 64 * MiB)))
#define wsgu_t ((bf16_t*)((bf16_t*)(ws + WS_WSGU)))
#define memkv ((bf16_t*)((bf16_t*)(ws + WS_MEMKV)))
#define memn ((bf16_t*)((bf16_t*)(ws + WS_MEMN)))
#define Win_t ((bf16_t*)((bf16_t*)(ws + WS_WIN)))
#define Win8 ((unsigned char*)(ws + WS_WIN + 64 * MiB))
#define lnstat ((unsigned long long*)(ws + 768 * 1024))
#define XB8 ((unsigned char*)(ws + WS_SB + 64 * MiB))
#define OA8 ((unsigned char*)(ws + WS_SB + 64 * MiB))
#define Pcat_t ((bf16_t*)((bf16_t*)(ws + WS_PCAT)))
#define Wout_t ((bf16_t*)((bf16_t*)(ws + WS_WOUT)))
#define Wxq_t ((bf16_t*)((bf16_t*)(ws + WS_WXQ)))
#define Wxkv_t ((bf16_t*)((bf16_t*)(ws + WS_WXKV)))
#define Wxo_t ((bf16_t*)((bf16_t*)(ws + WS_WXO)))
#define Wgu_t ((bf16_t*)((bf16_t*)(ws + WS_WGU)))
#define Wdn_t ((bf16_t*)((bf16_t*)(ws + WS_WDN)))
#define XB ((bf16_t*)((bf16_t*)(ws + WS_XB)))
#define OA ((bf16_t*)((bf16_t*)(ws + WS_Q)))
#define OB ((bf16_t*)((bf16_t*)(ws + WS_U)))
#define Qb ((bf16_t*)((bf16_t*)(ws + WS_Q)))
#define Ub ((bf16_t*)((bf16_t*)(ws + WS_U)))
#define Kb ((bf16_t*)((bf16_t*)(ws + WS_K)))
#define Vb ((bf16_t*)((bf16_t*)(ws + WS_V)))
#define VSb ((bf16_t*)((bf16_t*)(ws + WS_VS)))
#define SAb ((unsigned char*)((unsigned char*)(ws + WS_SA)))
#define SBb ((unsigned char*)((unsigned char*)(ws + WS_SB)))
#define MG ((bf16_t*)((bf16_t*)(ws + WS_MERGED)))
#define QX ((bf16_t*)((bf16_t*)(ws + WS_QX)))
#define OX ((bf16_t*)((bf16_t*)(ws + WS_OX)))
#define ACT ((bf16_t*)((bf16_t*)(ws + WS_ACT)))
__global__ void __launch_bounds__(NWAVES * 64, 2) mk_fwd(Args args) {
    extern __shared__ __attribute__((aligned(16))) unsigned char lds[];
    LAS unsigned char* ldsl = (LAS unsigned char*)lds;
    const int tid = threadIdx.x, lane = tid & 63, wave = __builtin_amdgcn_readfirstlane(tid >> 6), G = gridDim.x, B = blockIdx.x;
    unsigned char* ws = args.ws;

    for (int u = tid; u < (LDS_BYTES - LDSCTL_OFF) / 4; u += NWAVES * 64) ((LAS unsigned*)(ldsl + LDSCTL_OFF))[u] = 0u;
    __syncthreads();
    volatile LAS unsigned* MISC = (volatile LAS unsigned*)(ldsl + MISC_OFF);
    const XcdBarrier bar = xcd_barrier_post(ctl + CW_BAR, MISC + 8);
#define GRID_BAR() xcd_barrier(bar)
    const int lo = args.ph_lo, hi_ = args.ph_hi;
#define IN(k) (lo <= (k) && (k) < hi_)
#define BOTH(k) (IN(k) && IN((k) + 1))
    const int gw = B * NWAVES + wave, NGW = G * NWAVES;

            constexpr int J_IN = (DM / 64) * (NIN / 256), J_PA = (AW / 64) * (DM / 256), J_PB = J_PA, J_WO = (DM / 64) * (DM / 256), J_XQ = (DM / 64) * (XW / 256), J_XKV = (DM / 64) * (2 * XW / 256),
                          J_XO = (XW / 64) * (DM / 256), J_G = (DM / 64) * (DFF / 256), J_U = J_G, J_D = (DFF / 64) * (DM / 256);
            constexpr int NJ = J_IN + J_PA + J_PB + J_WO + J_XQ + J_XKV + J_XO + J_G + J_U + J_D, J_FFN0 = NJ - J_G - J_U - J_D, J_DN0 = NJ - J_D;
#define TR_DECODE(IT, idx) do { int r = (idx); TrItem& t_ = (IT); \
            if (r < J_IN) { const int n0_ = (r % (NIN / 256)) * 256, k0_ = (r / (NIN / 256)) * 64; \
                if (n0_ < 4096) t_ = TrItem{w_in, (bf16_t*)Win8, g_mix, DM, NIN, k0_, n0_, 5, 0}; else if (n0_ < 6144) t_ = TrItem{w_in, (bf16_t*)Win8, g_mix, DM, NIN, k0_, n0_, 4, 0}; \
                else if (n0_ < 10240) t_ = TrItem{w_in, Win_t, g_mix, DM, NIN, k0_, n0_, 0, -6144}; else t_ = TrItem{w_in, (bf16_t*)Win8, g_mix, DM, NIN, k0_, n0_, 4, -4096}; break; } r -= J_IN; \
            if (r < J_PA) { t_ = TrItem{w_pa, Pcat_t, nullptr, AW, DM, (r / (DM / 256)) * 64, (r % (DM / 256)) * 256, 4, 0}; break; } r -= J_PA;     \
            if (r < J_PB) { t_ = TrItem{w_pb, Pcat_t, nullptr, SW, DM, (r / (DM / 256)) * 64, (r % (DM / 256)) * 256, 0, DM}; break; } r -= J_PB; \
            if (r < J_WO) { t_ = TrItem{w_out, Wout_t, nullptr, DM, DM, (r / (DM / 256)) * 64, (r % (DM / 256)) * 256, 0, 0}; break; } r -= J_WO; \
            if (r < J_XQ) { t_ = TrItem{w_xq, Wxq_t, g_xat, DM, XW, (r / (XW / 256)) * 64, (r % (XW / 256)) * 256, 0, 0}; break; } r -= J_XQ; \
            if (r < J_XKV) { t_ = TrItem{w_xkv, Wxkv_t, nullptr, DM, 2 * XW, (r / (2 * XW / 256)) * 64, (r % (2 * XW / 256)) * 256, 0, 0}; break; } r -= J_XKV; \
            if (r < J_XO) { t_ = TrItem{w_xo, Wxo_t, nullptr, XW, DM, (r / (DM / 256)) * 64, (r % (DM / 256)) * 256, 0, 0}; break; } r -= J_XO; \
            if (r < J_G) { t_ = TrItem{w_gate, Wgu_t, g_ffn, DM, DFF, (r / (DFF / 256)) * 64, (r % (DFF / 256)) * 256, 2, 0}; break; } r -= J_G; \
            if (r < J_U) { t_ = TrItem{w_up, Wgu_t, g_ffn, DM, DFF, (r / (DFF / 256)) * 64, (r % (DFF / 256)) * 256, 3, 0}; break; } r -= J_U; \
            t_ = TrItem{w_down, Wdn_t, nullptr, DFF, DM, (r / (DM / 256)) * 64, (r % (DM / 256)) * 256, 0, 0}; } while (0)
#define TR_HALF(IT, V, TOFF, AHEAD, HI) { LAS unsigned* T = (LAS unsigned*)(ldsl + (TOFF)); \
                tr_stage(IT, V, T, wave, lane_); \
                const bool more_ = idx + (AHEAD) < (HI); \
                if (more_) { TR_DECODE(nn_, idx + (AHEAD)); tr_issue(nn_, V, wave, lane_); } \
                __syncthreads(); \
                tr_readout(IT, T, tid); \
                if (more_) IT = nn_; }
#define TR_LOOP(LO, HI, RANK, NBLK) do { f32x4 va_[8], vb_[8]; TrItem ia_, ib_, nn_; int idx = (LO) + (RANK); int lane_ = threadIdx.x & 63; asm volatile("" : "+v"(lane_));     \
            if (idx < (HI)) { TR_DECODE(ia_, idx); tr_issue(ia_, va_, wave, lane_); } \
            if (idx + (NBLK) < (HI)) { TR_DECODE(ib_, idx + (NBLK)); tr_issue(ib_, vb_, wave, lane_); } \
            for (; idx < (HI); idx += 2 * (NBLK)) { \
                TR_HALF(ia_, va_, 0, 2 * (NBLK), HI) \
                if (idx + (NBLK) >= (HI)) break; \
                TR_HALF(ib_, vb_, 34816, 3 * (NBLK), HI) } \
            __syncthreads(); } while (0)
    if (IN(0)) { for (int rep_ = 0; rep_ <= ((MK_REP >> 0) & 1) * MK_REPN; ++rep_) { if (rep_) GRID_BAR();
        TR_LOOP(0, J_FFN0, B, G);
        for (int m = gw; m < M; m += NGW) { const float s = row_to_bf16(x_in + (size_t)m * DM, XB + (size_t)m * DM, nullptr, lane, XB8 + (size_t)m * DM); if (lane == 0) ssq1[m] = (ssq_t)(s * SSQ_SCALE + 0.5f); }
        for (int m = gw; m < BATCH * NMEM; m += NGW) (void)row_to_bf16(mem_in + (size_t)m * DM, memn + (size_t)m * DM, g_mem, lane);
        for (int e = B * 512 + tid; e < SEQ * 64; e += G * 512) { float c, s; rope_entry(e >> 6, e & 63, c, s); rope_c[e] = c; rope_s[e] = s; }
        for (int e = B * 512 + tid; e < NGRP * SCH * SCH; e += G * 512) { const int t = (e >> 7) & 127, s = e & 127; wsgu_t[e] = (bf16_t)(s <= t ? f2bf(w_sgu[e]) : 0u); }
        } if (BOTH(0)) GRID_BAR();
    }
    if (IN(1)) { for (int rep_ = 0; rep_ <= ((MK_REP >> 1) & 1) * MK_REPN; ++rep_) { if (rep_) GRID_BAR();
        { pg8::Gemm g{XB, Win_t, M, 4096, DM, DM}; pg8::StaticOrder S; S.init(M, 4096, G, B, 4);
          pg8::EpiIn<0> E{ssq1, rope_c, rope_s, Qb, Kb, Vb, Ub, VSb, SAb, SBb, kmpart, lnstat};
          pg8::gemm_phase<pg8::EpiIn<0>, pg8::StaticOrder, true, true, false>(ldsl, g, S, E); }
        { pg8::Gemm g{(const bf16_t*)XB8, (const bf16_t*)Win8, M, 14336, DM / 2, DM / 2}; pg8::StaticOrder S; S.init(M, 14336, G, B);
          pg8::EpiIn<1> E{ssq1, rope_c, rope_s, Qb, Kb, Vb, Ub, VSb, SAb, SBb, kmpart, lnstat};
          pg8::gemm_phase<pg8::EpiIn<1>, pg8::StaticOrder, true, true, true>(ldsl, g, S, E); }
        } if (BOTH(1)) GRID_BAR();
    }
    if (IN(3)) { for (int rep_ = 0; rep_ <= ((MK_REP >> 3) & 1) * MK_REPN; ++rep_) { if (rep_) GRID_BAR();
        if (B < 64 && G >= 128) {
            pg8::Gemm g{memn, Wxkv_t, BATCH * NMEM, 2 * XW, 512, DM}; pg8::MemKVOrder S{B};
            pg8::EpiPart E{kvpart};
            pg8::gemm_phase<pg8::EpiPart, pg8::MemKVOrder, true, true>(ldsl, g, S, E);
        }
        for (int j = B, rd = 0; j < 512; j += G, ++rd) { const int bh = j >> 4; int cc = j & 15; if (rd & 1) cc = 15 - cc;
            const int s = cc * 512 + tid, cur = __builtin_amdgcn_readfirstlane(s >> 8), b = bh >> 4, h = bh & 15;
            LAS float* kml = (LAS float*)ldsl;
            __syncthreads();
            { const int e8 = tid * 8, n_ = e8 >> 7, d_ = e8 & 127; const float* p0_ = kmpart + ((((size_t)(b * 32 + n_)) * NH + h) * 2) * HD + d_;
              const f32x4 a0 = *(const f32x4*)p0_, a1 = *(const f32x4*)(p0_ + 4), b0 = *(const f32x4*)(p0_ + HD), b1 = *(const f32x4*)(p0_ + HD + 4);
              *(LAS f32x4*)(kml + e8) = (a0 + b0) * (1.f / 256.f); *(LAS f32x4*)(kml + e8 + 4) = (a1 + b1) * (1.f / 256.f); }
            __syncthreads();
            int i0 = 0, i1 = 1, i2 = 2;
            if (cur > 3) {
                f32x4 qf[32]; const bf16_t* qp = Qb + (size_t)(b * SEQ + s) * AW + h * HD;
#pragma unroll
                for (int i = 0; i < 16; ++i) unpack8(*(const u32x4*)(qp + 8 * i), qf[2 * i], qf[2 * i + 1]);
                float v0 = -__builtin_inff(), v1 = v0, v2 = v0;
                for (int n = 0; n < cur; ++n) { const LAS float* kp = kml + n * HD; f32x4 dv = {0.f, 0.f, 0.f, 0.f};
#pragma unroll
                    for (int i = 0; i < 32; ++i) dv += qf[i] * *(const LAS f32x4*)(kp + 4 * i);
                    const float d0 = dv[0] + dv[2], d1 = dv[1] + dv[3];
                    const float gsc = d0 + d1;
                    if (gsc > v2) { if (gsc > v1) { v2 = v1; i2 = i1; if (gsc > v0) { v1 = v0; i1 = i0; v0 = gsc; i0 = n; } else { v1 = gsc; i1 = n; } } else { v2 = gsc; i2 = n; } } }
            }
            const int nv = cur < 3 ? cur : 3;
            LAS int* lc = (LAS int*)(ldsl + 137216); LAS int* gb = lc + 32;
            if (tid < 32) lc[tid] = 0;
            __syncthreads();
            int lp0 = 0, lp1 = 0, lp2 = 0;
            if (nv > 0) lp0 = __hip_atomic_fetch_add(lc + i0, 1, __ATOMIC_RELAXED, __HIP_MEMORY_SCOPE_WORKGROUP);
            if (nv > 1) lp1 = __hip_atomic_fetch_add(lc + i1, 1, __ATOMIC_RELAXED, __HIP_MEMORY_SCOPE_WORKGROUP);
            if (nv > 2) lp2 = __hip_atomic_fetch_add(lc + i2, 1, __ATOMIC_RELAXED, __HIP_MEMORY_SCOPE_WORKGROUP);
            __syncthreads();
            if (tid < 32) { const int c_ = lc[tid]; gb[tid] = c_ > 0 ? (int)atomicAdd((rep_ ? ctl + CW_PCNT2 : lcnt) + bh * 32 + tid, (unsigned)c_) : 0; }
            __syncthreads();
            unsigned short* lists_ = rep_ ? (unsigned short*)(ws + WS_SA + 80 * MiB) : lists;
            if (nv > 0) lists_[(size_t)(bh * 32 + i0) * 8192 + gb[i0] + lp0] = (unsigned short)s;
            if (nv > 1) lists_[(size_t)(bh * 32 + i1) * 8192 + gb[i1] + lp1] = (unsigned short)(s | (1 << 13));
            if (nv > 2) lists_[(size_t)(bh * 32 + i2) * 8192 + gb[i2] + lp2] = (unsigned short)(s | (2 << 13));
            __syncthreads();
        }

        for (int u = B; u < 2 * (M / SCH); u += G) sgu_unit(u, VSb, lnstat, Ub, rep_ ? (bf16_t*)(ws + WS_SB + 64 * MiB) : OB, wsgu_t, ln_g, ln_b, b_sgu, (char*)lds, tid, wave, lane);
        } if (BOTH(3)) GRID_BAR();
    }
    if (IN(4)) { for (int rep_ = 0; rep_ <= ((MK_REP >> 4) & 1) * MK_REPN; ++rep_) { if (rep_) GRID_BAR();
        {
            int* pre = (int*)((char*)lds + 137216); int* wtot = pre + 1028;
            { const int c0_ = (int)((lcnt[2 * tid] + 255u) >> 8), c1_ = (int)((lcnt[2 * tid + 1] + 255u) >> 8), a_ = 4 * c0_ + 3 * (c0_ > 0), b_ = 4 * c1_ + 3 * (c1_ > 0); int v = a_ + b_;
#pragma unroll
              for (int o_ = 1; o_ < 64; o_ <<= 1) { const int t2 = __shfl_up(v, o_); if (lane >= o_) v += t2; }
              if (lane == 63) wtot[wave] = v;
              __syncthreads();
              int off = 0; for (int w_ = 0; w_ < wave; ++w_) off += wtot[w_];
              v += off; pre[2 * tid] = v - a_ - b_; pre[2 * tid + 1] = v - b_; if (tid == 511) pre[1024] = v;
              __syncthreads(); }
            const int T = pre[1024]; const int glo = (int)((long)B * T / G), ghi = (int)((long)(B + 1) * T / G);
            for (int pass_ = 0; pass_ <= ((MK_REP >> 23) & 1); ++pass_) {
            int li = 0;
            for (int g_ = glo; g_ < ghi;) {
                while (pre[li + 1] <= g_) ++li;
                const int nch = (pre[li + 1] - pre[li] - 3) >> 2, rend = pre[li + 1] < ghi ? pre[li + 1] : ghi;
                int c_lo = (g_ - pre[li] - 3 + 3) >> 2; if (g_ - pre[li] - 3 < 0) c_lo = 0; int c_hi = (rend - pre[li] - 3 + 3) >> 2; if (rend - pre[li] - 3 < 0) c_hi = 0; if (c_hi > nch) c_hi = nch;
                g_ = rend;
                if (c_hi <= c_lo) continue;
                const int cntl = (int)lcnt[li], bh = li >> 5, n = li & 31, b = bh >> 4, h = bh & 15; (void)nch;
                __syncthreads();
                att::gather_load_kv(Kb + (size_t)(b * SEQ + n * 256) * AW + h * HD, Vb + (size_t)(b * SEQ + n * 256) * AW + h * HD, (char*)lds);
                __syncthreads();
                att::gather_run(Qb + (size_t)(b * SEQ) * AW + h * HD, lists + (size_t)li * 8192, c_lo, c_hi, cntl, P01, P2, LSE, (size_t)bh * SEQ, (char*)lds);
            } }
        }
        } if (BOTH(4)) GRID_BAR();
    }
    if (IN(5)) { for (int rep_ = 0; rep_ <= ((MK_REP >> 5) & 1) * MK_REPN; ++rep_) { if (rep_) GRID_BAR();
        for (int e = B * 512 + tid; e < BATCH * NMEM * 2 * XW / 4; e += G * 512) { f32x4 a = ((const f32x4*)kvpart)[e];
#pragma unroll
            for (int k = 1; k < 8; ++k) a += ((const f32x4*)kvpart)[e + k * (BATCH * NMEM * 2 * XW / 4)];
            u32x2 o; o.x = cvt_pk_bf16(a[0], a[1]); o.y = cvt_pk_bf16(a[2], a[3]); ((u32x2*)memkv)[e] = o; }
        if (B < BATCH * NH * 32) {
            att::Seam S; int unit = B;
            att::BlockRef cur = own_ref(unit, Qb, Kb, Vb, OA, LSE3); att::prime<AW, AW>(cur, (char*)lds, S);
            for (;;) { const int nunit = unit + G; const bool last = nunit >= BATCH * NH * 32;
                const att::BlockRef nxt = last ? cur : own_ref(nunit, Qb, Kb, Vb, OA, LSE3);
                att::block<AW, AW, HD, true>(cur, nxt, SEQ, (char*)lds, S);
                {
                    const int bh = unit >> 5, cq = unit & 31, nv = cq < 3 ? cq : 3, b = bh >> 4, h = bh & 15;
                    const bf16_t* Ot = (const bf16_t*)((char*)lds + OT_OFF); const float* Ol = (const float*)((char*)lds + OTL_OFF);
                    int tid_c = threadIdx.x; asm volatile("" : "+v"(tid_c));
#pragma unroll 2
                    for (int i = 0; i < 8; ++i) { const int it = tid_c + 512 * i, rr = it >> 4, c = it & 15; const size_t row = (size_t)bh * SEQ + cq * 256 + rr;
                        const float l3 = Ol[rr]; float lj[3]; float lmax = l3;
#pragma unroll
                        for (int j = 0; j < 3; ++j) { lj[j] = j < nv ? LSE[(size_t)j * (BATCH * NH * SEQ) + row] : -__builtin_inff(); lmax = fmaxf(lmax, lj[j]); }
                        const float w3 = __builtin_amdgcn_exp2f(l3 - lmax); float wsum = w3;
                        f32x4 a0, a1; unpack8(*(const u32x4*)(Ot + rr * HD + c * 8), a0, a1); a0 *= w3; a1 *= w3;
#pragma unroll
                        for (int j = 0; j < 3; ++j) if (j < nv) { const float wj = __builtin_amdgcn_exp2f(lj[j] - lmax); wsum += wj;
                            const bf16_t* pp = (j < 2 ? P01 + (size_t)j * ((size_t)BATCH * NH * SEQ * HD) : P2) + row * HD + c * 8;
                            f32x4 p0_, p1_; unpack8(*(const u32x4*)pp, p0_, p1_); a0 += p0_ * wj; a1 += p1_ * wj; }
                        const float rw = __builtin_amdgcn_rcpf(wsum);
                        a0 *= rw * OA8_SCALE; a1 *= rw * OA8_SCALE; u32x2 w8; w8.x = pk4_fp8(a0[0], a0[1], a0[2], a0[3]); w8.y = pk4_fp8(a1[0], a1[1], a1[2], a1[3]);
                        *(u32x2*)(OA8 + (size_t)(b * SEQ + cq * 256 + rr) * AW + h * HD + c * 8) = w8; }
                }
                if (last) break;
                cur = nxt; unit = nunit; }
        }
        } if (BOTH(5)) GRID_BAR();
    }
    if (IN(7)) { for (int rep_ = 0; rep_ <= ((MK_REP >> 7) & 1) * MK_REPN; ++rep_) { if (rep_) GRID_BAR();
        { pg8::Gemm g{(const bf16_t*)OA8, Pcat_t, M, DM, AW / 2, AW / 2}; pg8::StaticOrder S; S.init(M, DM, G, B, 4);
          pg8::EpiBranch<0> E{SAb, MG};
          pg8::gemm_phase<pg8::EpiBranch<0>, pg8::StaticOrder, true, true, true>(ldsl, g, S, E); }
        { pg8::Gemm g{OB, Pcat_t + (size_t)DM * AW, M, DM, AW, AW}; pg8::StaticOrder S; S.init(M, DM, G, B, 4);
          pg8::EpiBranch<1> E{SBb, MG};
          pg8::gemm_phase<pg8::EpiBranch<1>, pg8::StaticOrder, true, true, false>(ldsl, g, S, E); }
        } if (BOTH(7)) GRID_BAR();
    }
    if (IN(8)) { for (int rep_ = 0; rep_ <= ((MK_REP >> 8) & 1) * MK_REPN; ++rep_) { if (rep_) GRID_BAR();
        pg8::Gemm g{MG, Wout_t, M, DM, DM, DM}; pg8::StaticOrder S; S.init(M, DM, G, B, 4);
        pg8::EpiResid E{nullptr, XB, rep_ ? (bf16_t*)(ws + WS_SB) : XB, rep_ ? (ssq_t*)(ws + 13 * MiB) : ssq2};
        pg8::gemm_phase<pg8::EpiResid, pg8::StaticOrder, true, true>(ldsl, g, S, E);
        } if (BOTH(8)) GRID_BAR();
    }
    if (IN(9)) { for (int rep_ = 0; rep_ <= ((MK_REP >> 9) & 1) * MK_REPN; ++rep_) { if (rep_) GRID_BAR();
        pg8::Gemm g{XB, Wxq_t, M, XW, DM, DM}; pg8::StaticOrder S; S.init(M, XW, G, B);
        pg8::EpiScale E{ssq2, QX, XW};
        pg8::gemm_phase<pg8::EpiScale, pg8::StaticOrder, true, true>(ldsl, g, S, E);
        { pg8::Unit uq;
          if (G == 256 && S.next(0, uq)) {
            att::Seam AS; const int ub = (uq.pm >> 5) * 128 + (uq.pn * 2) * 32 + (uq.pm & 31);
            att::BlockRef cur = xattn_ref(ub, QX, memkv, OX); att::prime<XW, 2 * XW>(cur, (char*)lds, AS);
#pragma nounroll
            for (int k_ = 0; k_ < 2; ++k_) { const att::BlockRef nxt = xattn_ref(ub + 32, QX, memkv, OX);
                att::block<XW, 2 * XW, XW>(cur, nxt, NMEM, (char*)lds, AS); cur = nxt; } } }
        { constexpr int NXQ = (M / 256) * (XW / 256);
          if (G > NXQ) { if (B >= NXQ) TR_LOOP(J_FFN0, J_DN0, B - NXQ, G - NXQ); } else TR_LOOP(J_FFN0, J_DN0, B, G); }
        } if (BOTH(9)) GRID_BAR();
    }
    if (IN(11)) { for (int rep_ = 0; rep_ <= ((MK_REP >> 11) & 1) * MK_REPN; ++rep_) { if (rep_) GRID_BAR();
        pg8::Gemm g{OX, Wxo_t, M, DM, XW, XW}; pg8::StaticOrder S; S.init(M, DM, G, B, 4);
        pg8::EpiResid E{nullptr, XB, rep_ ? (bf16_t*)(ws + WS_SB) : XB, rep_ ? (ssq_t*)(ws + 13 * MiB) : ssq3};
        pg8::gemm_phase<pg8::EpiResid, pg8::StaticOrder, true, true>(ldsl, g, S, E);
        } if (BOTH(11)) GRID_BAR();
    }
    if (IN(12)) { for (int rep_ = 0; rep_ <= ((MK_REP >> 12) & 1) * MK_REPN; ++rep_) { if (rep_) GRID_BAR();
        pg8::Gemm g{XB, Wgu_t, M, 2 * DFF, DM, DM}; pg8::StaticOrder S; S.init(M, 2 * DFF, G, B);
        pg8::EpiGU E{ssq3, ACT};
        pg8::gemm_phase<pg8::EpiGU, pg8::StaticOrder, true, true>(ldsl, g, S, E);
        { const int rem = ((M / 256) * (2 * DFF / 256)) % G;
          if (rem != 0) { if (B >= rem) TR_LOOP(J_DN0, NJ, B - rem, G - rem); } else TR_LOOP(J_DN0, NJ, B, G); }
        } if (BOTH(12)) GRID_BAR();
    }
    if (IN(13)) { for (int rep_ = 0; rep_ <= ((MK_REP >> 13) & 1) * MK_REPN; ++rep_) { if (rep_) GRID_BAR();
        pg8::Gemm g{ACT, Wdn_t, M, DM, DFF, DFF};
        pg8::EpiResid E{nullptr, XB, rep_ ? (bf16_t*)(ws + WS_SB) : XB, rep_ ? (ssq_t*)(ws + 13 * MiB) : ssq4};
        pg8::StaticOrder S; S.init(M, DM, G, B, 4); pg8::gemm_phase<pg8::EpiResid, pg8::StaticOrder, true, true>(ldsl, g, S, E);
        } if (BOTH(13)) GRID_BAR();
    }
    if (IN(14)) { for (int rep_ = 0; rep_ <= ((MK_REP >> 14) & 1) * MK_REPN; ++rep_) { if (rep_) GRID_BAR();
        int lane_ = threadIdx.x & 63; asm volatile("" : "+v"(lane_));
        for (int m = (int)blockIdx.x * NWAVES + (int)(threadIdx.x >> 6); m < M; m += NGW) { const float r = rs_of(ssq4, m); GAS f32x4* p = (GAS f32x4*)(out_f + (size_t)m * DM) + 2 * lane_; const GAS u32x4* xp = (const GAS u32x4*)(XB + (size_t)m * DM) + lane_;
#pragma unroll
            for (int j = 0; j < 8; ++j) { f32x4 a0, a1; unpack8(xp[64 * j], a0, a1); const GAS f32x4* gp = (const GAS f32x4*)g_fin + 2 * lane_ + 128 * j;
                p[128 * j] = a0 * gp[0] * r; p[128 * j + 1] = a1 * gp[1] * r; } }
    } }
#undef IN
#undef BOTH
}

#undef ctl
#undef ssq1
#undef ssq2
#undef ssq3
#undef ssq4
#undef x_in
#undef mem_in
#undef g_mix
#undef w_in
#undef ln_g
#undef ln_b
#undef w_sgu
#undef b_sgu
#undef w_pa
#undef w_pb
#undef w_out
#undef g_xat
#undef g_mem
#undef w_xq
#undef w_xkv
#undef w_xo
#undef g_ffn
#undef w_gate
#undef w_up
#undef w_down
#undef g_fin
#undef out_f
#undef kmpart
#undef LSE3
#undef LSE
#undef lcnt
#undef lists
#undef P01
#undef P2
#undef rope_c
#undef rope_s
#undef kvpart
#undef wsgu_t
#undef memkv
#undef memn
#undef Win_t
#undef Pcat_t
#undef Wout_t
#undef Wxq_t
#undef Wxkv_t
#undef Wxo_t
#undef Wgu_t
#undef Wdn_t
#undef XB
#undef OA
#undef OB
#undef Qb
#undef Ub
#undef Kb
#undef Vb
#undef VSb
#undef SAb
#undef SBb
#undef MG
#undef QX
#undef OX
#undef ACT
extern "C" void kernel_launch(void* const* d_in, const int* in_sizes, int n_in, void* d_out, int out_size, void* d_ws, size_t ws_size, hipStream_t stream) {
    static int grid = 0;
    if (grid == 0) {
        if (n_in != 21 || in_sizes[0] != M * DM || out_size != M * DM || ws_size < WS_END) { fprintf(stderr, "kernel_launch: unexpected shapes / workspace (n_in %d, ws %zu < %zu); nothing launched\n", n_in, ws_size, (size_t)WS_END); grid = -1; return; }
        int dev = 0, cus = 0, per_cu = 0;
        if (hipGetDevice(&dev) != hipSuccess || hipDeviceGetAttribute(&cus, hipDeviceAttributeMultiprocessorCount, dev) != hipSuccess) { grid = -1; return; }
        if (hipFuncSetAttribute((const void*)mk_fwd, hipFuncAttributeMaxDynamicSharedMemorySize, LDS_BYTES) != hipSuccess) { fprintf(stderr, "kernel_launch: hipFuncSetAttribute failed\n"); grid = -1; return; }
        if (hipOccupancyMaxActiveBlocksPerMultiprocessor(&per_cu, (const void*)mk_fwd, NWAVES * 64, LDS_BYTES) != hipSuccess || per_cu < 1) { fprintf(stderr, "kernel_launch: occupancy query reports %d workgroups per CU\n", per_cu); }
        (void)hipGetLastError();
        if (cus < 256) { fprintf(stderr, "kernel_launch: this kernel's phase program is dealt over exactly 256 workgroups, one per CU; the device has %d CUs; nothing launched\n", cus); grid = -1; return; }
        grid = 256;
    }
    if (grid < 0) return;
    (void)hipMemsetAsync((char*)d_ws + WS_CTL, 0, CTL_ZERO_BYTES, stream);
    Args a{};
    for (int i = 0; i < 21; ++i) a.in[i] = (const float*)d_in[i];
    a.out = (float*)d_out; a.ws = (unsigned char*)d_ws;
#if MK_PER_PHASE
    for (int p = 0; p < N_PHASES; ++p) { a.ph_lo = p; a.ph_hi = p + 1; hipLaunchKernelGGL(mk_fwd, dim3(grid), dim3(NWAVES * 64), LDS_BYTES, stream, a); }
#else
    a.ph_lo = 0; a.ph_hi = N_PHASES; hipLaunchKernelGGL(mk_fwd, dim3(grid), dim3(NWAVES * 64), LDS_BYTES, stream, a);
#endif
}
```

```cpp
#include <hip/hip_runtime.h>
#include <cstdio>
#include <cstdint>

#ifndef MK_REP
#define MK_REP 0
#endif
#ifndef MK_REPN
#define MK_REPN 1
#endif
#ifndef MK_PER_PHASE
#define MK_PER_PHASE 0
#endif

#define GAS __attribute__((address_space(1)))
#define LAS __attribute__((address_space(3)))
typedef unsigned short bf16_t;
typedef short bf16x8 __attribute__((ext_vector_type(8)));
typedef short s16x4 __attribute__((ext_vector_type(4)));
typedef float f32x2 __attribute__((ext_vector_type(2)));
typedef float f32x4 __attribute__((ext_vector_type(4)));
typedef float f32x16 __attribute__((ext_vector_type(16)));
typedef unsigned u32x2 __attribute__((ext_vector_type(2)));
typedef unsigned u32x4 __attribute__((ext_vector_type(4)));

constexpr int BATCH = 2, SEQ = 8192, M = BATCH * SEQ, DM = 4096, HD = 128, NH = 16, AW = 2048, SW = 2048, NIN = 18432, DFF = 11008, NMEM = 256, XH = 4, XW = 512;
constexpr int NGRP = 16, SCH = 128;
constexpr float RMS_EPS = 1e-6f, LN_EPS = 1e-5f;

typedef __bf16 bf16x2_t __attribute__((ext_vector_type(2)));
__device__ __forceinline__ unsigned cvt_pk_bf16(float lo, float hi) { f32x2 v = {lo, hi}; bf16x2_t b = __builtin_convertvector(v, bf16x2_t); return __builtin_bit_cast(unsigned, b); }
__device__ __forceinline__ u32x4 pack8f(f32x4 a, f32x4 b) { u32x4 w; w.x = cvt_pk_bf16(a[0], a[1]); w.y = cvt_pk_bf16(a[2], a[3]); w.z = cvt_pk_bf16(b[0], b[1]); w.w = cvt_pk_bf16(b[2], b[3]); return w; }
__device__ __forceinline__ float bflo(unsigned w) { return __builtin_bit_cast(float, w << 16); }
__device__ __forceinline__ float bfhi(unsigned w) { return __builtin_bit_cast(float, w & 0xffff0000u); }
__device__ __forceinline__ void unpack8(u32x4 w, f32x4& a, f32x4& b) { a = (f32x4){bflo(w.x), bfhi(w.x), bflo(w.y), bfhi(w.y)}; b = (f32x4){bflo(w.z), bfhi(w.z), bflo(w.w), bfhi(w.w)}; }
typedef int i32x4v __attribute__((ext_vector_type(4)));
typedef int i32x8v __attribute__((ext_vector_type(8)));
__device__ __forceinline__ unsigned pk4_fp8(float a, float b, float c, float d) { unsigned w = 0; w = __builtin_amdgcn_cvt_pk_fp8_f32(a, b, w, false); w = __builtin_amdgcn_cvt_pk_fp8_f32(c, d, w, true); return w; }
constexpr float X8_SCALE = 16.f, W8_SCALE = 1024.f, ACC8_SCALE = 1.f / (16.f * 1024.f), OA8_SCALE = 32.f, ACCA_SCALE = 1.f / (32.f * 1024.f);
typedef unsigned long long ssq_t;
constexpr float SSQ_SCALE = 16777216.f;
__device__ __forceinline__ float rs_of(const ssq_t* p, int row) { return __builtin_amdgcn_rsqf((float)p[row] * (1.f / (SSQ_SCALE * 4096.f)) + 1e-6f); }
__device__ __forceinline__ float sigmoidf_(float v) { return __builtin_amdgcn_rcpf(1.f + __builtin_amdgcn_exp2f(-1.4426950408889634f * v)); }
__device__ __forceinline__ float gelu_tanh(float v) { const float y = 0.7978845608028654f * (v + 0.044715f * v * v * v); return v * __builtin_amdgcn_rcpf(1.f + __builtin_amdgcn_exp2f(-2.8853900817779268f * y)); }
__device__ __forceinline__ f32x4 gelu4(f32x4 v) { return (f32x4){gelu_tanh(v[0]), gelu_tanh(v[1]), gelu_tanh(v[2]), gelu_tanh(v[3])}; }
__device__ __forceinline__ f32x4 sigm4(f32x4 v) { return (f32x4){sigmoidf_(v[0]), sigmoidf_(v[1]), sigmoidf_(v[2]), sigmoidf_(v[3])}; }

namespace pg8 {
constexpr int BM = 256, BK = 64, HALF = 128, HTB = HALF * BK * 2, STAGE_BYTES = 8 * HTB, NXCD = 8, WGM = 8;
__host__ __device__ __forceinline__ int lds_byte(int r, int c) { const int st = (r >> 4) * 2 + (c >> 5), rr = r & 15, cc = c & 31, ob = rr * 64 + cc * 2; return st * 1024 + (ob ^ (((ob >> 9) & 1) << 5)); }
__host__ __device__ __forceinline__ void stage_rc(int b, int& R, int& C) { const int st = b / 1024, sb = b % 1024, swz = sb ^ (((sb >> 9) & 1) << 5); R = (st >> 1) * 16 + swz / 64; C = (st & 1) * 32 + (swz % 64) / 2; }
__host__ __device__ __forceinline__ int perm32(int rho) { const int n = rho >> 4, i = rho & 15; return 8 * (i >> 2) + 4 * n + (i & 3); }
struct Unit { int pm, pn, ko; };
struct Gemm { const bf16_t* A; const bf16_t* Bt; int M, N, K, ld; };
struct StaticOrder {
    int nM, nN, nwg, G, c, wgm;
    __host__ __device__ void init(int M_, int N_, int G_, int c_, int wgm_ = WGM) { nM = M_ / BM; nN = N_ / BM; nwg = nM * nN; G = G_; c = c_; wgm = wgm_; }
    __host__ __device__ __forceinline__ bool next(int i, Unit& u) const {
        const long L = (long)i * G + c; if (L >= nwg) return false;
        int wgid = (int)L; { const int q = nwg / NXCD, r = nwg % NXCD, xcd = wgid % NXCD, off = wgid / NXCD; wgid = (xcd < r ? xcd * (q + 1) : r * (q + 1) + (xcd - r) * q) + off; }
        const int nig = wgm * nN, gid = wgid / nig, fm = gid * wgm, gsz = (nM - fm) < wgm ? (nM - fm) : wgm;
        u.pm = fm + ((wgid % nig) % gsz); u.pn = (wgid % nig) / gsz; u.ko = 0; return true;
    }
    __device__ __forceinline__ void a_ready(const Unit&) const {}
    __device__ __forceinline__ void done(const Unit&) const {}
};

struct MemKVOrder {
    int c;
    __device__ bool next(int i, Unit& u) const { if (i > 0 || c >= 64) return false; u.pm = c & 1; u.pn = (c >> 1) & 3; u.ko = (c >> 3) * 512; return true; }
    __device__ __forceinline__ void a_ready(const Unit&) const {}
    __device__ __forceinline__ void done(const Unit&) const {}
};

template <int MODE> struct EpiIn {
    static constexpr bool PERM = true, AFTER_DRAIN = false;
    const ssq_t* ssq; const float* rc; const float* rsn; bf16_t *Q, *K, *V, *U, *VS; unsigned char *SA, *SB; float* kmpart; unsigned long long* lnstat;
    __device__ __forceinline__ bool keep(const Unit&) const { return false; }
    __device__ __forceinline__ void operator()(f32x4 (&acc)[2][2][4][2], const Unit& un, int wr, int wc, int fr, int fq) const {
        asm volatile("" : "+v"(fr), "+v"(fq));
        const int rowb = un.pm * BM + wr * 64 + fr, pn = MODE ? (un.pn < 24 ? un.pn : un.pn + 16) : un.pn + 24;
        float rsc[2][4];
#pragma unroll
        for (int ai = 0; ai < 2; ++ai)
#pragma unroll
            for (int m = 0; m < 4; ++m) rsc[ai][m] = rs_of(ssq, rowb + ai * HALF + m * 16) * (MODE ? ACC8_SCALE : 1.f);
        if (MODE == 1 && pn < 16) {
            bf16_t* dst = pn < 8 ? Q : K; const int head = (pn & 7) * 2 + (wc >> 1), dd0 = 32 * (wc & 1) + 8 * fq;
            f32x4 cs[4] = {};
            f32x4 tc[2][2][2], ts[2][2][2];
#pragma unroll
            for (int mm = 0; mm < 2; ++mm) { const int pos = (rowb + mm * 16) & (SEQ - 1);
                tc[0][mm][0] = *(const f32x4*)(rc + pos * 64 + dd0); tc[0][mm][1] = *(const f32x4*)(rc + pos * 64 + dd0 + 4); ts[0][mm][0] = *(const f32x4*)(rsn + pos * 64 + dd0); ts[0][mm][1] = *(const f32x4*)(rsn + pos * 64 + dd0 + 4); }
#pragma unroll
            for (int am = 0; am < 4; ++am) {
                const int ai = am >> 1, m0 = (am & 1) * 2, bf = am & 1;
                u32x4 ow[2][2];
#pragma unroll
                for (int mm = 0; mm < 2; ++mm) { const int m = m0 + mm; const float r = rsc[ai][m];
                    const f32x4 c0 = tc[bf][mm][0], c1 = tc[bf][mm][1], s0 = ts[bf][mm][0], s1 = ts[bf][mm][1];
                    const f32x4 x1a = acc[ai][0][m][0] * r, x1b = acc[ai][0][m][1] * r, x2a = acc[ai][1][m][0] * r, x2b = acc[ai][1][m][1] * r;
                    const f32x4 o1a = x1a * c0 - x2a * s0, o1b = x1b * c1 - x2b * s1, o2a = x2a * c0 + x1a * s0, o2b = x2b * c1 + x1b * s1;
                    cs[0] += o1a; cs[1] += o1b; cs[2] += o2a; cs[3] += o2b;
                    ow[mm][0] = pack8f(o1a, o1b); ow[mm][1] = pack8f(o2a, o2b); }
                if (am < 3) { const int an = am + 1, ai2 = an >> 1, m2 = (an & 1) * 2;
#pragma unroll
                    for (int mm = 0; mm < 2; ++mm) { const int pos = (rowb + ai2 * HALF + (m2 + mm) * 16) & (SEQ - 1);
                        tc[bf ^ 1][mm][0] = *(const f32x4*)(rc + pos * 64 + dd0); tc[bf ^ 1][mm][1] = *(const f32x4*)(rc + pos * 64 + dd0 + 4); ts[bf ^ 1][mm][0] = *(const f32x4*)(rsn + pos * 64 + dd0); ts[bf ^ 1][mm][1] = *(const f32x4*)(rsn + pos * 64 + dd0 + 4); } }
#pragma unroll
                for (int mm = 0; mm < 2; ++mm) { const int row = rowb + ai * HALF + (m0 + mm) * 16;
                    bf16_t* p = dst + (size_t)row * AW + head * HD + dd0;
                    *(u32x4*)p = ow[mm][0];
                    *(u32x4*)(p + 64) = ow[mm][1]; } }
            if (pn >= 8) {
#pragma unroll
                for (int q = 0; q < 4; ++q)
#pragma unroll
                    for (int j = 0; j < 4; ++j) { float v = cs[q][j]; v += __shfl_xor(v, 1); v += __shfl_xor(v, 2); v += __shfl_xor(v, 4); v += __shfl_xor(v, 8); cs[q][j] = v; }
                if (fr == 0) { float* kp = kmpart + (((size_t)un.pm * NH + head) * 2 + wr) * HD + dd0;
                    *(f32x4*)kp = cs[0]; *(f32x4*)(kp + 4) = cs[1]; *(f32x4*)(kp + 64) = cs[2]; *(f32x4*)(kp + 68) = cs[3]; } }
        } else if (MODE == 1 && pn < 24) {
            const int col0 = (pn - 16) * BM + wc * 32 + 8 * fq;
#pragma unroll
            for (int ai = 0; ai < 2; ++ai)
#pragma unroll
                for (int m = 0; m < 4; ++m) { const int row = rowb + ai * HALF + m * 16; const float r = rsc[ai][m];
#pragma unroll
                    for (int bj = 0; bj < 2; ++bj) *(u32x4*)(V + (size_t)row * AW + col0 + bj * HALF) = pack8f(acc[ai][bj][m][0] * r, acc[ai][bj][m][1] * r); }
        } else if (MODE == 0 && pn < 40) {
            bf16_t* dst = pn < 32 ? U : VS; const int col0 = ((pn - 24) & 7) * BM + wc * 32 + 8 * fq;
#pragma unroll
            for (int ai = 0; ai < 2; ++ai)
#pragma unroll
                for (int m = 0; m < 4; ++m) { const int row = rowb + ai * HALF + m * 16; const float r = rsc[ai][m];
                    float s1 = 0.f, s2 = 0.f;
#pragma unroll
                    for (int bj = 0; bj < 2; ++bj) { const f32x4 g0 = gelu4(acc[ai][bj][m][0] * r), g1 = gelu4(acc[ai][bj][m][1] * r);
                        *(u32x4*)(dst + (size_t)row * SW + col0 + bj * HALF) = pack8f(g0, g1);
                        s1 += (g0[0] + g0[1]) + (g0[2] + g0[3]) + (g1[0] + g1[1]) + (g1[2] + g1[3]);
                        s2 += (g0[0] * g0[0] + g0[1] * g0[1]) + (g0[2] * g0[2] + g0[3] * g0[3]) + (g1[0] * g1[0] + g1[1] * g1[1]) + (g1[2] * g1[2] + g1[3] * g1[3]); }
                    if (pn >= 32) {
                        s1 += __shfl_xor(s1, 16); s1 += __shfl_xor(s1, 32); s2 += __shfl_xor(s2, 16); s2 += __shfl_xor(s2, 32);
                        if (fq == 0) { atomicAdd(lnstat + 2 * row, (unsigned long long)(long long)__builtin_rintf(s1 * SSQ_SCALE)); atomicAdd(lnstat + 2 * row + 1, (unsigned long long)(long long)__builtin_rintf(s2 * SSQ_SCALE)); } } }
        } else if (MODE == 1) {
            unsigned char* dst = (pn < 56 ? SA : SB) + ((size_t)(un.pm * 16 + ((pn - 40) & 15)) * 8) * 8192 + (size_t)(wr * 4 + wc) * 1024 + (fq * 16 + fr) * 16;
#pragma unroll
            for (int ai = 0; ai < 2; ++ai)
#pragma unroll
                for (int m = 0; m < 4; ++m) { const float r = rsc[ai][m]; u32x4 w;
#pragma unroll
                    for (int bj = 0; bj < 2; ++bj) { const f32x4 s0 = sigm4(acc[ai][bj][m][0] * r) * 255.f + 0.5f, s1 = sigm4(acc[ai][bj][m][1] * r) * 255.f + 0.5f;
                        const unsigned lo = (unsigned)s0[0] | ((unsigned)s0[1] << 8) | ((unsigned)s0[2] << 16) | ((unsigned)s0[3] << 24), hi_ = (unsigned)s1[0] | ((unsigned)s1[1] << 8) | ((unsigned)s1[2] << 16) | ((unsigned)s1[3] << 24);
                        if (bj == 0) { w.x = lo; w.y = hi_; } else { w.z = lo; w.w = hi_; } }
                    *(u32x4*)(dst + (size_t)(ai * 4 + m) * 8192) = w; }
        }
    }
};
struct EpiPart {
    static constexpr bool PERM = true, AFTER_DRAIN = false;
    float* P;
    __device__ __forceinline__ bool keep(const Unit&) const { return false; }
    __device__ __forceinline__ void operator()(f32x4 (&acc)[2][2][4][2], const Unit& un, int wr, int wc, int fr, int fq) const {
        const int rowb = un.pm * BM + wr * 64 + fr, col0 = un.pn * BM + wc * 32 + 8 * fq; float* base = P + (size_t)(un.ko >> 9) * (BATCH * NMEM * 2 * XW);
#pragma unroll
        for (int ai = 0; ai < 2; ++ai)
#pragma unroll
            for (int m = 0; m < 4; ++m)
#pragma unroll
                for (int bj = 0; bj < 2; ++bj) { float* p = base + (size_t)(rowb + ai * HALF + m * 16) * (2 * XW) + col0 + bj * HALF; *(f32x4*)p = acc[ai][bj][m][0]; *(f32x4*)(p + 4) = acc[ai][bj][m][1]; }
    }
};
struct EpiScale {
    static constexpr bool PERM = true, AFTER_DRAIN = false;
    const ssq_t* ssq; bf16_t* O; int ldc;
    __device__ __forceinline__ bool keep(const Unit&) const { return false; }
    __device__ __forceinline__ void operator()(f32x4 (&acc)[2][2][4][2], const Unit& un, int wr, int wc, int fr, int fq) const {
        const int rowb = un.pm * BM + wr * 64 + fr, col0 = un.pn * BM + wc * 32 + 8 * fq;
        float rsc[2][4];
#pragma unroll
        for (int ai = 0; ai < 2; ++ai)
#pragma unroll
            for (int m = 0; m < 4; ++m) rsc[ai][m] = ssq ? rs_of(ssq, rowb + ai * HALF + m * 16) : 1.f;
#pragma unroll
        for (int ai = 0; ai < 2; ++ai)
#pragma unroll
            for (int m = 0; m < 4; ++m) { const int row = rowb + ai * HALF + m * 16; const float r = rsc[ai][m];
#pragma unroll
                for (int bj = 0; bj < 2; ++bj) *(u32x4*)(O + (size_t)row * ldc + col0 + bj * HALF) = pack8f(acc[ai][bj][m][0] * r, acc[ai][bj][m][1] * r); }
    }
};
template <int BR> struct EpiBranch {
    static constexpr bool PERM = true, AFTER_DRAIN = false;
    const unsigned char* S8; bf16_t* O;
    __device__ __forceinline__ bool keep(const Unit&) const { return false; }
    static __device__ __forceinline__ f32x4 ub4(unsigned w) { return (f32x4){(float)(w & 255u), (float)((w >> 8) & 255u), (float)((w >> 16) & 255u), (float)(w >> 24)}; }
    __device__ __forceinline__ void operator()(f32x4 (&acc)[2][2][4][2], const Unit& un, int wr, int wc, int fr, int fq) const {
        asm volatile("" : "+v"(fr), "+v"(fq));
        const int rowb = un.pm * BM + wr * 64 + fr, col0 = un.pn * BM + wc * 32 + 8 * fq;
        const size_t goff = ((size_t)(un.pm * 16 + un.pn) * 8) * 8192 + (size_t)(wr * 4 + wc) * 1024 + (fq * 16 + fr) * 16;
        constexpr float SC = (BR == 0 ? ACCA_SCALE : 1.f) * (1.f / 255.f);
        u32x4 wgs[2][4], pw[2][4][2];
#pragma unroll
        for (int m = 0; m < 4; ++m) { wgs[0][m] = *(const u32x4*)(S8 + goff + (size_t)m * 8192);
            if (BR == 1) {
#pragma unroll
                for (int bj = 0; bj < 2; ++bj) pw[0][m][bj] = *(const u32x4*)(O + (size_t)(rowb + m * 16) * DM + col0 + bj * HALF); } }
#pragma unroll
        for (int ai = 0; ai < 2; ++ai) {
            u32x4 ow[4][2];
#pragma unroll
            for (int m = 0; m < 4; ++m) { const u32x4 wg = wgs[ai][m];
#pragma unroll
                for (int bj = 0; bj < 2; ++bj) { f32x4 v0 = ub4(bj ? wg.z : wg.x) * SC * acc[ai][bj][m][0], v1 = ub4(bj ? wg.w : wg.y) * SC * acc[ai][bj][m][1];
                    if (BR == 1) { f32x4 p0, p1; unpack8(pw[ai][m][bj], p0, p1); v0 += p0; v1 += p1; }
                    ow[m][bj] = pack8f(v0, v1); } }
            if (ai == 0) {
#pragma unroll
                for (int m = 0; m < 4; ++m) { wgs[1][m] = *(const u32x4*)(S8 + goff + (size_t)(4 + m) * 8192);
                    if (BR == 1) {
#pragma unroll
                        for (int bj = 0; bj < 2; ++bj) pw[1][m][bj] = *(const u32x4*)(O + (size_t)(rowb + HALF + m * 16) * DM + col0 + bj * HALF); } } }
#pragma unroll
            for (int m = 0; m < 4; ++m) { const size_t off = (size_t)(rowb + ai * HALF + m * 16) * DM + col0;
#pragma unroll
                for (int bj = 0; bj < 2; ++bj) *(u32x4*)(O + off + bj * HALF) = ow[m][bj]; } }
    }
};
struct EpiResid {
    static constexpr bool PERM = true, AFTER_DRAIN = false;
    const float* basef; const bf16_t* baseb; bf16_t* xb; ssq_t* ssq;
    __device__ __forceinline__ bool keep(const Unit&) const { return false; }
    __device__ __forceinline__ void operator()(f32x4 (&acc)[2][2][4][2], const Unit& un, int wr, int wc, int fr, int fq) const {
        const int rowb = un.pm * BM + wr * 64 + fr, col0 = un.pn * BM + wc * 32 + 8 * fq;
        u32x4 bw[2][4][2];
#pragma unroll
        for (int m = 0; m < 4; ++m)
#pragma unroll
            for (int bj = 0; bj < 2; ++bj) bw[0][m][bj] = *(const u32x4*)(baseb + (size_t)(rowb + m * 16) * DM + col0 + bj * HALF);
#pragma unroll
        for (int ai = 0; ai < 2; ++ai) {
            u32x4 ow[4][2]; float ssv[4];
#pragma unroll
            for (int m = 0; m < 4; ++m) { float ss = 0.f;
#pragma unroll
                for (int bj = 0; bj < 2; ++bj) { f32x4 b0, b1; unpack8(bw[ai][m][bj], b0, b1);
                    const f32x4 v0 = acc[ai][bj][m][0] + b0, v1 = acc[ai][bj][m][1] + b1;
                    ow[m][bj] = pack8f(v0, v1);
                    ss += (v0[0] * v0[0] + v0[1] * v0[1]) + (v0[2] * v0[2] + v0[3] * v0[3]) + (v1[0] * v1[0] + v1[1] * v1[1]) + (v1[2] * v1[2] + v1[3] * v1[3]); }
                ss += __shfl_xor(ss, 16); ss += __shfl_xor(ss, 32); ssv[m] = ss; }
            if (ai == 0) {
#pragma unroll
                for (int m = 0; m < 4; ++m)
#pragma unroll
                    for (int bj = 0; bj < 2; ++bj) bw[1][m][bj] = *(const u32x4*)(baseb + (size_t)(rowb + HALF + m * 16) * DM + col0 + bj * HALF); }
#pragma unroll
            for (int m = 0; m < 4; ++m) { const int row = rowb + ai * HALF + m * 16; const size_t off = (size_t)row * DM + col0;
#pragma unroll
                for (int bj = 0; bj < 2; ++bj) *(u32x4*)(xb + off + bj * HALF) = ow[m][bj];
                if (fq == 0) atomicAdd(ssq + row, (ssq_t)(ssv[m] * SSQ_SCALE + 0.5f)); } }
    }
};
struct EpiGU {
    static constexpr bool PERM = true, AFTER_DRAIN = false;
    const ssq_t* ssq; bf16_t* O;
    __device__ __forceinline__ bool keep(const Unit&) const { return false; }
    __device__ __forceinline__ void operator()(f32x4 (&acc)[2][2][4][2], const Unit& un, int wr, int wc, int fr, int fq) const {
        const int rowb = un.pm * BM + wr * 64 + fr, col0 = un.pn * HALF + wc * 32 + 8 * fq;
        float rsc[2][4];
#pragma unroll
        for (int ai = 0; ai < 2; ++ai)
#pragma unroll
            for (int m = 0; m < 4; ++m) rsc[ai][m] = rs_of(ssq, rowb + ai * HALF + m * 16);
#pragma unroll
        for (int ai = 0; ai < 2; ++ai)
#pragma unroll
            for (int m = 0; m < 4; ++m) { const int row = rowb + ai * HALF + m * 16; const float r = rsc[ai][m];
                f32x4 o[2];
#pragma unroll
                for (int n = 0; n < 2; ++n) { const f32x4 g = acc[ai][0][m][n] * r, u = acc[ai][1][m][n] * r;
#pragma unroll
                    for (int j = 0; j < 4; ++j) o[n][j] = g[j] * sigmoidf_(g[j]) * u[j]; }
                *(u32x4*)(O + (size_t)row * DFF + col0) = pack8f(o[0], o[1]); }
    }
};

template <bool F8> struct Frag { bf16x8 k[2]; };
template <> struct Frag<true> { i32x8v v; };
template <class Epi, class Sched, bool ALIGN_EPI = false, bool SP2 = false, bool F8 = false>
__device__ __forceinline__ void gemm_phase(LAS unsigned char* lds, const Gemm g, const Sched& S, const Epi& E) {
    int tid = threadIdx.x; asm volatile("" : "+v"(tid));
    const int wid = __builtin_amdgcn_readfirstlane(tid >> 6), lane = tid & 63, wr = wid >> 2, wc = wid & 3, fr = lane & 15, fq = lane >> 4;
    const int K = g.K, nt = K / BK, ld = g.ld;
    unsigned voffA[2], voffB[2];
#pragma unroll
    for (int i = 0; i < 2; ++i) { int R, C; stage_rc(tid * 16 + i * 8192, R, C); const int Rb = Epi::PERM ? ((R & ~31) + perm32(R & 31)) : R;
        voffA[i] = (unsigned)(R * ld + C) * 2u; voffB[i] = (unsigned)(Rb * ld + C) * 2u; }
    const size_t kstep = (size_t)(BK * 2);
    const size_t hstep = (size_t)HALF * ld * 2;
    const size_t tstep = 2 * hstep;
    const unsigned ldsw = (unsigned)wid * 1024u;
    const int aoff = lds_byte(wr * 64 + fr, fq * 8), boff = lds_byte(wc * 32 + fr, fq * 8);
#define PG8_SA(b, h) (((b) * 2 + (h)) * HTB)
#define PG8_SB(b, h) ((4 + (b) * 2 + (h)) * HTB)
#define PG8_STAGE(bufoff, gbase, voff) do { _Pragma("unroll") for (int _i = 0; _i < 2; ++_i) \
        __builtin_amdgcn_global_load_lds((const unsigned*)((const char*)(gbase) + (voff)[_i]), (LAS unsigned*)(lds + (bufoff) + ldsw + _i * 8192), 16, 0, 0); } while (0)
#define PG8_LDF(dst, addr) do { if constexpr (F8) { dst.v.lo = *(const LAS i32x4v*)(addr); dst.v.hi = *(const LAS i32x4v*)((addr) + 1024); } else { dst.k[0] = *(const LAS bf16x8*)(addr); dst.k[1] = *(const LAS bf16x8*)((addr) + 1024); } } while (0)
#define PG8_LDA(dst, b, h) do { _Pragma("unroll") for (int m = 0; m < 4; ++m) PG8_LDF(dst[m], lds + PG8_SA(b, h) + aoff + m * 2048); } while (0)
#define PG8_LDB(dst, b, h) do { _Pragma("unroll") for (int n = 0; n < 2; ++n) PG8_LDF(dst[n], lds + PG8_SB(b, h) + boff + n * 2048); } while (0)
#define PG8_MMA(ai, bj, At, Bt) do { __builtin_amdgcn_s_setprio(1); _Pragma("unroll") for (int m = 0; m < 4; ++m) _Pragma("unroll") for (int n = 0; n < 2; ++n) { \
        if constexpr (F8) asm volatile("v_mfma_f32_16x16x128_f8f6f4 %0, %1, %2, %0" : "+v"(acc[ai][bj][m][n]) : "v"(Bt[n].v), "v"(At[m].v));     \
        else { _Pragma("unroll") for (int k = 0; k < 2; ++k) acc[ai][bj][m][n] = __builtin_amdgcn_mfma_f32_16x16x32_bf16(Bt[n].k[k], At[m].k[k], acc[ai][bj][m][n], 0, 0, 0); } } \
        __builtin_amdgcn_s_setprio(0); } while (0)
#define PG8_WAIT_V(n) asm volatile("s_waitcnt vmcnt(" #n ")" ::: "memory")
#define PG8_WAIT_L(n) asm volatile("s_waitcnt lgkmcnt(" #n ")" ::: "memory")
#define PG8_BAR __builtin_amdgcn_s_barrier()
#define PG8_SCHED __builtin_amdgcn_sched_barrier(0)
    Unit cur, nxt; int ui = 0;
    if (!S.next(0, cur)) return;
    f32x4 acc[2][2][4][2];
#pragma unroll
    for (int a = 0; a < 2; ++a)
#pragma unroll
        for (int b = 0; b < 2; ++b)
#pragma unroll
            for (int m = 0; m < 4; ++m)
#pragma unroll
                for (int n = 0; n < 2; ++n) acc[a][b][m][n] = (f32x4){0.f, 0.f, 0.f, 0.f};
    Frag<F8> At[4], B0[2], B1[2];
    const char* cA = (const char*)g.A + (size_t)cur.pm * tstep + (size_t)cur.ko * 2; const char* cB = (const char*)g.Bt + (size_t)cur.pn * tstep + (size_t)cur.ko * 2;
    S.a_ready(cur);
    if constexpr (SP2) {
        PG8_STAGE(PG8_SB(0, 0), cB, voffB); PG8_STAGE(PG8_SB(0, 1), cB + hstep, voffB); PG8_STAGE(PG8_SA(0, 0), cA, voffA); PG8_STAGE(PG8_SA(0, 1), cA + hstep, voffA);
        if (wr == 1) PG8_BAR;
        PG8_WAIT_V(2); PG8_BAR;
        PG8_STAGE(PG8_SB(1, 0), cB + kstep, voffB); PG8_STAGE(PG8_SA(1, 0), cA + kstep, voffA); PG8_STAGE(PG8_SB(1, 1), cB + hstep + kstep, voffB);
        PG8_WAIT_V(6); PG8_BAR;
    } else {
        PG8_STAGE(PG8_SB(0, 0), cB, voffB); PG8_STAGE(PG8_SA(0, 0), cA, voffA); PG8_STAGE(PG8_SB(0, 1), cB + hstep, voffB); PG8_STAGE(PG8_SA(0, 1), cA + hstep, voffA);
        if (wr == 1) PG8_BAR;
        PG8_WAIT_V(4); PG8_BAR;
        PG8_STAGE(PG8_SB(1, 0), cB + kstep, voffB); PG8_STAGE(PG8_SA(1, 0), cA + kstep, voffA); PG8_STAGE(PG8_SB(1, 1), cB + hstep + kstep, voffB);
        PG8_WAIT_V(6); PG8_BAR;
    }
    for (;;) {
        const bool has_next = S.next(ui + 1, nxt);
        const char* nA = has_next ? (const char*)g.A + (size_t)nxt.pm * tstep + (size_t)nxt.ko * 2 : cA; const char* nB = has_next ? (const char*)g.Bt + (size_t)nxt.pn * tstep + (size_t)nxt.ko * 2 : cB;
        for (int t = 0; t < nt; t += 2) {
            const bool last = (t == nt - 2);
            const char* a1 = cA + (size_t)(t + 1) * kstep;
            const char* a2 = last ? nA : cA + (size_t)(t + 2) * kstep; const char* b2 = last ? nB : cB + (size_t)(t + 2) * kstep;
            const char* a3 = a2 + kstep; const char* b3 = b2 + kstep;
            if (last && has_next) S.a_ready(nxt);
            if constexpr (SP2) {
            PG8_LDB(B0, 0, 0); PG8_LDB(B1, 0, 1); PG8_SCHED; PG8_LDA(At, 0, 0); PG8_STAGE(PG8_SA(1, 1), a1 + hstep, voffA);
            PG8_WAIT_V(8); PG8_WAIT_L(0); PG8_BAR; PG8_MMA(0, 0, At, B0); PG8_MMA(0, 1, At, B1); PG8_BAR; PG8_SCHED;
            PG8_LDA(At, 0, 1); PG8_STAGE(PG8_SB(0, 0), b2, voffB); PG8_STAGE(PG8_SB(0, 1), b2 + hstep, voffB); PG8_STAGE(PG8_SA(0, 0), a2, voffA);
            PG8_WAIT_V(8); PG8_WAIT_L(0); PG8_BAR; PG8_MMA(1, 0, At, B0); PG8_MMA(1, 1, At, B1); PG8_BAR; PG8_SCHED;
            PG8_LDB(B0, 1, 0); PG8_LDB(B1, 1, 1); PG8_SCHED; PG8_LDA(At, 1, 0); PG8_STAGE(PG8_SA(0, 1), a2 + hstep, voffA);
            PG8_WAIT_V(8); PG8_WAIT_L(0); PG8_BAR; PG8_MMA(0, 0, At, B0); PG8_MMA(0, 1, At, B1); PG8_BAR; PG8_SCHED;
            PG8_LDA(At, 1, 1); PG8_STAGE(PG8_SB(1, 0), b3, voffB); PG8_STAGE(PG8_SB(1, 1), b3 + hstep, voffB); PG8_STAGE(PG8_SA(1, 0), a3, voffA);
            PG8_WAIT_V(8); PG8_WAIT_L(0); PG8_BAR; PG8_MMA(1, 0, At, B0); PG8_MMA(1, 1, At, B1); PG8_BAR; PG8_SCHED;
            } else {
            PG8_LDB(B0, 0, 0); PG8_SCHED; PG8_LDA(At, 0, 0); PG8_STAGE(PG8_SA(1, 1), a1 + hstep, voffA);
            PG8_WAIT_L(8); PG8_BAR; PG8_WAIT_L(0); PG8_MMA(0, 0, At, B0); PG8_BAR; PG8_SCHED;
            PG8_LDB(B1, 0, 1); PG8_STAGE(PG8_SB(0, 0), b2, voffB);
            PG8_BAR; PG8_WAIT_L(0); PG8_MMA(0, 1, At, B1); PG8_BAR;
            PG8_LDA(At, 0, 1); PG8_STAGE(PG8_SA(0, 0), a2, voffA);
            PG8_BAR; PG8_WAIT_L(0); PG8_MMA(1, 0, At, B0); PG8_BAR; PG8_SCHED;
            PG8_STAGE(PG8_SB(0, 1), b2 + hstep, voffB);
            PG8_WAIT_V(6); PG8_BAR; PG8_MMA(1, 1, At, B1); PG8_BAR;
            PG8_LDB(B0, 1, 0); PG8_SCHED; PG8_LDA(At, 1, 0); PG8_STAGE(PG8_SA(0, 1), a2 + hstep, voffA);
            PG8_WAIT_L(8); PG8_BAR; PG8_WAIT_L(0); PG8_MMA(0, 0, At, B0); PG8_BAR; PG8_SCHED;
            PG8_LDB(B1, 1, 1); PG8_STAGE(PG8_SB(1, 0), b3, voffB);
            PG8_BAR; PG8_WAIT_L(0); PG8_MMA(0, 1, At, B1); PG8_BAR;
            PG8_LDA(At, 1, 1); PG8_STAGE(PG8_SA(1, 0), a3, voffA);
            PG8_BAR; PG8_WAIT_L(0); PG8_MMA(1, 0, At, B0); PG8_BAR; PG8_SCHED;
            PG8_STAGE(PG8_SB(1, 1), b3 + hstep, voffB);
            PG8_WAIT_V(6); PG8_BAR; PG8_MMA(1, 1, At, B1); PG8_BAR;
            }
        }
        if constexpr (ALIGN_EPI) { if (wr == 0) PG8_BAR; }
        if constexpr (F8) asm volatile("s_nop 15\n\ts_nop 15" ::: "memory");
        E(acc, cur, wr, wc, fr, fq); S.done(cur);
        if (!has_next) break;
        if (!E.keep(cur)) {
#pragma unroll
        for (int a = 0; a < 2; ++a)
#pragma unroll
            for (int b = 0; b < 2; ++b)
#pragma unroll
                for (int m = 0; m < 4; ++m)
#pragma unroll
                    for (int n = 0; n < 2; ++n) acc[a][b][m][n] = (f32x4){0.f, 0.f, 0.f, 0.f};
        }
        cur = nxt; cA = nA; cB = nB; ++ui;
        if constexpr (ALIGN_EPI) { if (wr == 1) PG8_BAR; }
    }
    PG8_WAIT_V(0);
    if constexpr (!ALIGN_EPI) { if (wr == 0) PG8_BAR; }
    PG8_BAR;
#undef PG8_SA
#undef PG8_SB
#undef PG8_STAGE
#undef PG8_LDA
#undef PG8_LDB
#undef PG8_MMA
#undef PG8_WAIT_V
#undef PG8_WAIT_L
#undef PG8_BAR
#undef PG8_SCHED
}
}

namespace att {
constexpr int D = 128, NW = 8, QBLK = 32, KVBLK = 64, QB = NW * QBLK;
constexpr int SHM_V = KVBLK * D * 2, SHM_K = KVBLK * D * 2;
constexpr int LDS_BYTES = 2 * SHM_V + 2 * SHM_K + NW * 64 * 4;
constexpr float SCALE = 0.08838834764831845f, THR = 8.f;
#define KSWZ(row, colB) ((row) * 256 + ((colB) ^ (((row) & 7) << 4)))
#define SBAR() __builtin_amdgcn_sched_barrier(0)
__device__ __forceinline__ int v_st(int k, int c) { const int kk = (k & ~0xC) | ((k & 4) << 1) | ((k & 8) >> 1); return ((kk >> 3) * 4 + (c >> 5)) * 512 + ((kk & 7) * 32 + (c & 31)) * 2; }
__device__ __forceinline__ int v_rd_base(int lane) { return ((lane & 3) << 3) | (((lane >> 2) & 3) << 6) | (((lane >> 4) & 1) << 5) | (((lane >> 5) & 1) << 8); }
constexpr int v_rd_off(int d0, int ks, int half) { return d0 * 512 + ks * 4096 + half * 2048; }
__device__ __forceinline__ int crow(int r, int hi) { return (r & 3) + 8 * (r >> 2) + 4 * hi; }
__device__ __forceinline__ unsigned cvtpk(float lo, float hi) { return cvt_pk_bf16(lo, hi); }
__device__ __forceinline__ bf16x8 load8(const bf16_t* p) { return *reinterpret_cast<const bf16x8*>(p); }
__device__ __forceinline__ void mask_tile(f32x16& p0, f32x16& p1, int dq) {
    const float NEG = -__builtin_inff();
#pragma unroll
    for (int r = 0; r < 16; ++r) {
        const int c = (r & 3) + 8 * (r >> 2);
        if (dq - c < 0) p0[r] = NEG;
        if (dq - c - 32 < 0) p1[r] = NEG;
    }
}
__device__ __forceinline__ void partialSM(f32x16& p0, f32x16& p1, float& m_reg, float& mn, float& alpha, bool ract) {
    float pmax = p0[0];
#pragma unroll
    for (int r = 1; r < 16; ++r) pmax = fmaxf(pmax, p0[r]);
#pragma unroll
    for (int r = 0; r < 16; ++r) pmax = fmaxf(pmax, p1[r]);
    { auto rr = __builtin_amdgcn_permlane32_swap(__float_as_uint(pmax), __float_as_uint(pmax), false, false);
      pmax = fmaxf(__uint_as_float(rr[0]), __uint_as_float(rr[1])); }
    pmax = ract ? pmax : -__builtin_inff();
    constexpr float C2 = 1.4426950408889634f * SCALE;
    if (__builtin_expect(__all((pmax - m_reg) * SCALE <= THR), 1)) { mn = m_reg; alpha = 1.f; }
    else { mn = fmaxf(m_reg, pmax); alpha = __builtin_amdgcn_exp2f((m_reg - mn) * C2); m_reg = mn; }
    const float mnL = ract ? -mn * C2 : -__builtin_inff();
#pragma unroll
    for (int r = 0; r < 16; ++r) p0[r] = fmaf(p0[r], C2, mnL);
#pragma unroll
    for (int r = 0; r < 16; ++r) p1[r] = fmaf(p1[r], C2, mnL);
#pragma unroll
    for (int r = 0; r < 16; ++r) p0[r] = __builtin_amdgcn_exp2f(p0[r]);
}
__device__ __forceinline__ void finishSM(f32x16& p0, f32x16& p1, float alpha, float& l_reg, bf16x8& pa0, bf16x8& pa1, bf16x8& pa2, bf16x8& pa3) {
#pragma unroll
    for (int r = 0; r < 16; ++r) p1[r] = __builtin_amdgcn_exp2f(p1[r]);
    float ps = 0;
#pragma unroll
    for (int r = 0; r < 16; ++r) ps += p0[r];
#pragma unroll
    for (int r = 0; r < 16; ++r) ps += p1[r];
    { auto rr = __builtin_amdgcn_permlane32_swap(__float_as_uint(ps), __float_as_uint(ps), false, false);
      ps = __uint_as_float(rr[0]) + __uint_as_float(rr[1]); }
    l_reg = l_reg * alpha + ps;
#define PK4(P, B_, OUT) do { unsigned a0 = cvtpk(P[B_+0], P[B_+1]), a1 = cvtpk(P[B_+2], P[B_+3]);                          \
        unsigned b0 = cvtpk(P[B_+4], P[B_+5]), b1 = cvtpk(P[B_+6], P[B_+7]);                                             \
        auto r0 = __builtin_amdgcn_permlane32_swap(a0, b0, false, false); auto r1 = __builtin_amdgcn_permlane32_swap(a1, b1, false, false); \
        u32x4 w = {r0[0], r1[0], r0[1], r1[1]}; OUT = *reinterpret_cast<bf16x8*>(&w); } while (0)
    PK4(p0, 0, pa0); PK4(p0, 8, pa1); PK4(p1, 0, pa2); PK4(p1, 8, pa3);
#undef PK4
}
template <int KB>
__device__ __forceinline__ void qkt(f32x16& p0, f32x16& p1, const char* K_lds, int r32, int hi, const bf16x8* qr) {
    p0 = f32x16{}; p1 = f32x16{};
    const char* kb[4];
#pragma unroll
    for (int dd = 0; dd < 4; ++dd) kb[dd] = K_lds + KB * SHM_K + KSWZ(r32, (dd * 16 + hi * 8) * 2);
#pragma unroll
    for (int d0 = 0; d0 < 8; ++d0) { const char* a = kb[d0 & 3] + (d0 >> 2) * 128;
        bf16x8 b0 = *reinterpret_cast<const bf16x8*>(a);
        bf16x8 b1 = *reinterpret_cast<const bf16x8*>(a + 32 * 256);
        p0 = __builtin_amdgcn_mfma_f32_32x32x16_bf16(b0, qr[d0], p0, 0, 0, 0);
        p1 = __builtin_amdgcn_mfma_f32_32x32x16_bf16(b1, qr[d0], p1, 0, 0, 0); }
}
template <int VOFF>
__device__ __forceinline__ void pv_tile(f32x16* o, int vb0, bf16x8 pa0, bf16x8 pa1, bf16x8 pa2, bf16x8 pa3) {
#define TRRD(dst, off) asm volatile("ds_read_b64_tr_b16 %0, %1 offset:%2" : "=&v"(dst) : "v"(vb0), "i"(off) : "memory")
#define PV_D0(d0) do { s16x4 l0, l1, l2, l3, h0, h1, h2, h3; constexpr int b_ = VOFF + v_rd_off(d0, 0, 0); \
        TRRD(l0, b_); TRRD(h0, b_ + 2048); TRRD(l1, b_ + 4096); TRRD(h1, b_ + 6144); TRRD(l2, b_ + 8192); TRRD(h2, b_ + 10240); TRRD(l3, b_ + 12288); TRRD(h3, b_ + 14336); \
        asm volatile("s_waitcnt lgkmcnt(0)" ::: "memory"); SBAR();   \
        o[d0] = __builtin_amdgcn_mfma_f32_32x32x16_bf16(pa0, (bf16x8){l0[0], l0[1], l0[2], l0[3], h0[0], h0[1], h0[2], h0[3]}, o[d0], 0, 0, 0);   \
        o[d0] = __builtin_amdgcn_mfma_f32_32x32x16_bf16(pa1, (bf16x8){l1[0], l1[1], l1[2], l1[3], h1[0], h1[1], h1[2], h1[3]}, o[d0], 0, 0, 0);   \
        o[d0] = __builtin_amdgcn_mfma_f32_32x32x16_bf16(pa2, (bf16x8){l2[0], l2[1], l2[2], l2[3], h2[0], h2[1], h2[2], h2[3]}, o[d0], 0, 0, 0);   \
        o[d0] = __builtin_amdgcn_mfma_f32_32x32x16_bf16(pa3, (bf16x8){l3[0], l3[1], l3[2], l3[3], h3[0], h3[1], h3[2], h3[3]}, o[d0], 0, 0, 0); } while (0)
    PV_D0(0); PV_D0(1); PV_D0(2); PV_D0(3);
#undef PV_D0
#undef TRRD
}
template <int VOFF>
__device__ __forceinline__ void pv_tile_T(f32x16* o, int vb0, bf16x8 pa0, bf16x8 pa1, bf16x8 pa2, bf16x8 pa3) {
#define TRRD(dst, off) asm volatile("ds_read_b64_tr_b16 %0, %1 offset:%2" : "=&v"(dst) : "v"(vb0), "i"(off) : "memory")
#define PV_D0(d0) do { s16x4 l0, l1, l2, l3, h0, h1, h2, h3; constexpr int b_ = VOFF + v_rd_off(d0, 0, 0); \
        TRRD(l0, b_); TRRD(h0, b_ + 2048); TRRD(l1, b_ + 4096); TRRD(h1, b_ + 6144); TRRD(l2, b_ + 8192); TRRD(h2, b_ + 10240); TRRD(l3, b_ + 12288); TRRD(h3, b_ + 14336); \
        asm volatile("s_waitcnt lgkmcnt(0)" ::: "memory"); SBAR();   \
        o[d0] = __builtin_amdgcn_mfma_f32_32x32x16_bf16((bf16x8){l0[0], l0[1], l0[2], l0[3], h0[0], h0[1], h0[2], h0[3]}, pa0, o[d0], 0, 0, 0);   \
        o[d0] = __builtin_amdgcn_mfma_f32_32x32x16_bf16((bf16x8){l1[0], l1[1], l1[2], l1[3], h1[0], h1[1], h1[2], h1[3]}, pa1, o[d0], 0, 0, 0);   \
        o[d0] = __builtin_amdgcn_mfma_f32_32x32x16_bf16((bf16x8){l2[0], l2[1], l2[2], l2[3], h2[0], h2[1], h2[2], h2[3]}, pa2, o[d0], 0, 0, 0);   \
        o[d0] = __builtin_amdgcn_mfma_f32_32x32x16_bf16((bf16x8){l3[0], l3[1], l3[2], l3[3], h3[0], h3[1], h3[2], h3[3]}, pa3, o[d0], 0, 0, 0); } while (0)
    PV_D0(0); PV_D0(1); PV_D0(2); PV_D0(3);
#undef PV_D0
#undef TRRD
}
struct BlockRef { const bf16_t* Q; const bf16_t* K; const bf16_t* V; bf16_t* O; int P0; int jlo; const unsigned* sel; float* lse; };
struct Seam { bf16x8 qr[8]; bf16x8 st_v0, st_v1, st_k0, st_k1; };
#define ROW(p, k0, rr) ((p) + (size_t)((k0) + (rr)) * KP + sc)
#define VMW() asm volatile("s_waitcnt vmcnt(0)" ::: "memory")
#define VMWN(n) asm volatile("s_waitcnt vmcnt(%0)" :: "i"(n) : "memory")
#define SLOAD_H(Kp, Vp, k0) do { S.st_v0 = load8(ROW(Vp, k0, sr)); S.st_v1 = load8(ROW(Vp, k0, 32 + sr));              \
                         S.st_k0 = load8(ROW(Kp, k0, sr)); S.st_k1 = load8(ROW(Kp, k0, 32 + sr)); } while (0)
#define SWRITE_HK(bf) do { *(bf16x8*)(K_lds + (bf) * SHM_K + kws) = S.st_k0; *(bf16x8*)(K_lds + (bf) * SHM_K + kws + 32 * 256) = S.st_k1; } while (0)
#define SWRITE_HV(bf) do { *(bf16x8*)(V_lds + (bf) * SHM_V + vst0) = S.st_v0; *(bf16x8*)(V_lds + (bf) * SHM_V + vst1) = S.st_v1; } while (0)
#define SWRITE_H(bf) do { SWRITE_HV(bf); SWRITE_HK(bf); } while (0)
template <int QP, int KP>
__device__ __forceinline__ void prime(const BlockRef& cur, char* lds, Seam& S) {
    int tid = threadIdx.x; asm volatile("" : "+v"(tid)); const int wid = __builtin_amdgcn_readfirstlane(tid >> 6), lane = tid & 63, r32 = lane & 31, hi = lane >> 5;
    const int sr = tid >> 4, sc = (tid & 15) * 8, kws = KSWZ(sr, sc * 2); char* K_lds = lds + 2 * SHM_V;
#pragma unroll
    for (int d0 = 0; d0 < 8; ++d0) S.qr[d0] = load8(cur.Q + (size_t)(wid * QBLK + r32) * QP + d0 * 16 + hi * 8);
    SLOAD_H(cur.K, cur.V, cur.jlo * KVBLK); VMW(); SWRITE_HK(0);
    __syncthreads();
}
template <int QP, int KP, int OP, bool OLDS = false>
__device__ __forceinline__ void block(const BlockRef& cur, const BlockRef& nxt, int skv, char* lds, Seam& S) {
    int tid = threadIdx.x; asm volatile("" : "+v"(tid)); const int wid = __builtin_amdgcn_readfirstlane(tid >> 6), lane = tid & 63, r32 = lane & 31, hi = lane >> 5;
    int j_hi = (cur.P0 + QB - 1) / KVBLK + 1; if (j_hi > skv / KVBLK) j_hi = skv / KVBLK;
    const int j_lo = cur.jlo, NT = j_hi - j_lo;
    const int qlo = cur.P0 + wid * QBLK, qm = qlo + r32 - 4 * hi;
    char* V_lds = lds; char* K_lds = lds + 2 * SHM_V;
    float* ws = (float*)(lds + 2 * SHM_V + 2 * SHM_K) + wid * 64; float* li_l = ws, * al_l = ws + 32;
    float m_reg = -1e30f, l_reg = 0; f32x16 o[4] = {};
    const int sr = tid >> 4, sc = (tid & 15) * 8, vst0 = v_st(sr, sc), vst1 = v_st(32 + sr, sc), kws = KSWZ(sr, sc * 2);
    const int vb0 = (int)(uintptr_t)V_lds + v_rd_base(lane);
    const bf16_t* Kh = cur.K; const bf16_t* Vh = cur.V;
    const unsigned selw = cur.sel ? cur.sel[qlo + r32] : 0xffffffffu;
#define RESC(a) do { if (__any((a) < 1.f)) { if (hi == 0) al_l[r32] = (a); asm volatile("s_waitcnt lgkmcnt(0)" ::: "memory");              \
                     for (int d_ = 0; d_ < 4; ++d_) for (int r = 0; r < 16; ++r) o[d_][r] *= al_l[crow(r, hi)]; } } while (0)
#define KBASE(t) ((j_lo + (t)) * KVBLK)
#define RACT(t) (((selw >> ((KBASE(t) >> 8) & 31)) & 1u) != 0u)
#define MASKT(P0_, P1_, t) do { const int kb_ = KBASE(t); if (kb_ + KVBLK - 1 > qlo) mask_tile(P0_, P1_, qm - kb_); } while (0)
    constexpr int NQL = 8;
#define SEAM_K0() do { VMWN(NQL); SWRITE_HK(0); SBAR(); } while (0)
    f32x16 pA0, pA1, pB0, pB1; float mnA, mnB, alA, alB; bf16x8 pa0, pa1, pa2, pa3;
    SWRITE_HV(0); SBAR();
    if (NT > 1) { SLOAD_H(Kh, Vh, KBASE(1)); }
    SBAR(); qkt<0>(pA0, pA1, K_lds, r32, hi, S.qr);
    MASKT(pA0, pA1, 0); partialSM(pA0, pA1, m_reg, mnA, alA, RACT(0));
    if (NT > 1) { VMW(); SWRITE_H(1); }
    __syncthreads();
#define HALF_STEP(PX0, PX1, mnX, alX, PY0, PY1, alY, t, KB, VB, SB) do {                                                      \
        SBAR(); qkt<KB>(PX0, PX1, K_lds, r32, hi, S.qr);                                             \
        finishSM(PY0, PY1, alY, l_reg, pa0, pa1, pa2, pa3); SBAR();                                                           \
        if ((t) + 1 < NT) { SLOAD_H(Kh, Vh, KBASE((t) + 1)); SBAR(); }                                               \
        pv_tile<VB * SHM_V>(o, vb0, pa0, pa1, pa2, pa3); MASKT(PX0, PX1, (t)); partialSM(PX0, PX1, m_reg, mnX, alX, RACT(t));                                        \
        __syncthreads();                                                                                                      \
        if ((t) + 1 < NT) { VMW(); SWRITE_H(SB); }                                                                          \
        RESC(alX); __syncthreads(); } while (0)
    for (int t = 1; t + 1 < NT; t += 2) {
        HALF_STEP(pB0, pB1, mnB, alB, pA0, pA1, alA, t, 1, 0, 0);
        HALF_STEP(pA0, pA1, mnA, alA, pB0, pB1, alB, t + 1, 0, 1, 1);
    }
    const bool even = (NT & 1) == 0;
    if (even) { SBAR(); qkt<1>(pB0, pB1, K_lds, r32, hi, S.qr); SBAR(); }
    SLOAD_H(nxt.K, nxt.V, nxt.jlo * KVBLK); SBAR();
#pragma unroll
    for (int d0 = 0; d0 < 8; ++d0) S.qr[d0] = load8(nxt.Q + (size_t)(wid * QBLK + r32) * QP + d0 * 16 + hi * 8);
    SBAR();
    finishSM(pA0, pA1, alA, l_reg, pa0, pa1, pa2, pa3); SBAR();
    pv_tile<0>(o, vb0, pa0, pa1, pa2, pa3);
    if (even) { MASKT(pB0, pB1, NT - 1); partialSM(pB0, pB1, m_reg, mnB, alB, RACT(NT - 1)); __syncthreads(); RESC(alB);
        finishSM(pB0, pB1, alB, l_reg, pa0, pa1, pa2, pa3); SBAR(); pv_tile<SHM_V>(o, vb0, pa0, pa1, pa2, pa3); }
    SBAR(); SEAM_K0();
    if (hi == 0) li_l[r32] = l_reg; asm volatile("s_waitcnt lgkmcnt(0)" ::: "memory");
    if constexpr (OLDS) { int lo_ = (threadIdx.x >> 6) * QBLK + (threadIdx.x & 31); asm volatile("" : "+v"(lo_));
        if (hi == 0) ((float*)(lds + 133120))[lo_] = m_reg * (1.4426950408889634f * SCALE) + __builtin_amdgcn_logf(l_reg); }
    else { if (cur.lse && hi == 0) cur.lse[wid * QBLK + r32] = m_reg * (1.4426950408889634f * SCALE) + __builtin_amdgcn_logf(l_reg); }
    float rli[16];
#pragma unroll
    for (int r = 0; r < 16; ++r) rli[r] = __builtin_amdgcn_rcpf(li_l[crow(r, hi)]);
    int wq_ = (threadIdx.x >> 6) * QBLK; if constexpr (OLDS) asm volatile("" : "+v"(wq_));
    bf16_t* Ow = OLDS ? (bf16_t*)(lds + 67584) + (size_t)wq_ * OP : cur.O + (size_t)(wid * QBLK) * OP;
#pragma unroll
    for (int r = 0; r < 16; ++r) { const int orow = crow(r, hi);
#pragma unroll
        for (int d0 = 0; d0 < 4; ++d0) { const float v = o[d0][r] * rli[r];
            const float vn = __shfl_xor(v, 1);
            if ((r32 & 1) == 0) *(unsigned*)(Ow + (size_t)orow * OP + d0 * 32 + r32) = cvtpk(v, vn); } }
    __syncthreads();
#undef RESC
#undef KBASE
#undef RACT
#undef MASKT
#undef SEAM_K0
#undef HALF_STEP
}
__device__ __forceinline__ void gather_load_kv(const bf16_t* Kn, const bf16_t* Vn, char* lds) {
    int tid = threadIdx.x; asm volatile("" : "+v"(tid)); const int sr = tid >> 4, sc = (tid & 15) * 8; char* V_lds = lds; char* K_lds = lds + 4 * SHM_V;
    bf16x8 kk[8], vv[8];
#pragma unroll
    for (int i = 0; i < 8; ++i) { kk[i] = load8(Kn + (size_t)(sr + 32 * i) * AW + sc); vv[i] = load8(Vn + (size_t)(sr + 32 * i) * AW + sc); }
#pragma unroll
    for (int i = 0; i < 8; ++i) { const int t = i >> 1, rr = sr + 32 * (i & 1);
        *(bf16x8*)(K_lds + t * SHM_K + KSWZ(rr, sc * 2)) = kk[i]; *(bf16x8*)(V_lds + t * SHM_V + v_st(rr, sc)) = vv[i]; }
}
__device__ __forceinline__ void gather_run(const bf16_t* Qh, const unsigned short* list, int c_lo, int c_hi, int cnt, bf16_t* P01, bf16_t* P2, float* LSE, size_t rowbase, char* lds) {
    int tid = threadIdx.x; asm volatile("" : "+v"(tid)); const int wid = __builtin_amdgcn_readfirstlane(tid >> 6), lane = tid & 63, r32 = lane & 31, hi = lane >> 5;
    char* V_lds = lds; char* K_lds = lds + 4 * SHM_V;
    const int vb0 = (int)(uintptr_t)V_lds + v_rd_base(lane);
    bf16x8 qr[8], qn[8]; unsigned ent = 0xFFFFu, entn = 0xFFFFu; bool has = false, hasn = false;
#define GLOAD(C_, ENT, QR, HAS) do { const int ew_ = (C_) * 256 + wid * 32; HAS = ew_ < cnt; if (HAS) { const int e_ = ew_ + r32; const bool v_ = e_ < cnt; \
        ENT = v_ ? (unsigned)list[e_] : 0xFFFFu; const int sq_ = v_ ? (int)(ENT & 8191u) : (int)((unsigned)list[ew_] & 8191u); \
        _Pragma("unroll") for (int d0 = 0; d0 < 8; ++d0) QR[d0] = load8(Qh + (size_t)sq_ * AW + d0 * 16 + hi * 8); } } while (0)
    GLOAD(c_lo, ent, qr, has);
    for (int c = c_lo; c < c_hi; ++c) {
        hasn = false; if (c + 1 < c_hi) GLOAD(c + 1, entn, qn, hasn);
        if (has) {
            float m_reg = -1e30f, l_reg = 0; f32x16 o[4] = {};
            f32x16 pA0, pA1, pB0, pB1; float mnA, mnB, alA, alB; bf16x8 pa0, pa1, pa2, pa3;
#define GRESC(a) do { if (__any((a) < 1.f)) { _Pragma("unroll") for (int d_ = 0; d_ < 4; ++d_) o[d_] *= (a); } } while (0)
            SBAR(); qkt<0>(pA0, pA1, K_lds, r32, hi, qr); partialSM(pA0, pA1, m_reg, mnA, alA, true);
            SBAR(); qkt<1>(pB0, pB1, K_lds, r32, hi, qr); finishSM(pA0, pA1, alA, l_reg, pa0, pa1, pa2, pa3); SBAR(); pv_tile_T<0 * SHM_V>(o, vb0, pa0, pa1, pa2, pa3); partialSM(pB0, pB1, m_reg, mnB, alB, true); GRESC(alB);
            SBAR(); qkt<2>(pA0, pA1, K_lds, r32, hi, qr); finishSM(pB0, pB1, alB, l_reg, pa0, pa1, pa2, pa3); SBAR(); pv_tile_T<1 * SHM_V>(o, vb0, pa0, pa1, pa2, pa3); partialSM(pA0, pA1, m_reg, mnA, alA, true); GRESC(alA);
            SBAR(); qkt<3>(pB0, pB1, K_lds, r32, hi, qr); finishSM(pA0, pA1, alA, l_reg, pa0, pa1, pa2, pa3); SBAR(); pv_tile_T<2 * SHM_V>(o, vb0, pa0, pa1, pa2, pa3); partialSM(pB0, pB1, m_reg, mnB, alB, true); GRESC(alB);
            SBAR(); finishSM(pB0, pB1, alB, l_reg, pa0, pa1, pa2, pa3); SBAR(); pv_tile_T<3 * SHM_V>(o, vb0, pa0, pa1, pa2, pa3);
#undef GRESC
            if (ent != 0xFFFFu) { const unsigned sl = ent >> 13; const size_t row = rowbase + (ent & 8191u);
                if (hi == 0) LSE[(size_t)sl * (BATCH * NH * SEQ) + row] = m_reg * (1.4426950408889634f * SCALE) + __builtin_amdgcn_logf(l_reg);
                const float rl = __builtin_amdgcn_rcpf(l_reg);
                bf16_t* dst = (sl < 2u ? P01 + (size_t)sl * ((size_t)BATCH * NH * SEQ * D) : P2) + row * D + 4 * hi;
#pragma unroll
                for (int d0 = 0; d0 < 4; ++d0)
#pragma unroll
                    for (int g = 0; g < 4; ++g) { u32x2 w; w.x = cvtpk(o[d0][4 * g] * rl, o[d0][4 * g + 1] * rl); w.y = cvtpk(o[d0][4 * g + 2] * rl, o[d0][4 * g + 3] * rl);
                        *(u32x2*)(dst + d0 * 32 + 8 * g) = w; } }
        }
        has = hasn; ent = entn;
#pragma unroll
        for (int d0 = 0; d0 < 8; ++d0) qr[d0] = qn[d0];
    }
#undef GLOAD
}
#undef ROW
#undef VMW
#undef VMWN
#undef SLOAD_H
#undef SWRITE_HK
#undef SWRITE_HV
#undef SWRITE_H
}

constexpr int NWAVES = 8;
constexpr int N_PHASES = 15;
constexpr size_t MiB = 1u << 20;
constexpr size_t WS_CTL = 0, CTL_ZERO_BYTES = 1 * MiB;
constexpr size_t WS_KM = 1 * MiB, WS_SEL = 2 * MiB, WS_ROPE_C = 3 * MiB, WS_ROPE_S = 5 * MiB, WS_WSGU = 7 * MiB, WS_MEMKV = 8 * MiB, WS_MEMN = 9 * MiB;
constexpr size_t WS_WIN = 16 * MiB, WS_PCAT = 160 * MiB, WS_WOUT = 192 * MiB, WS_WXQ = 224 * MiB, WS_WXKV = 228 * MiB, WS_WXO = 236 * MiB, WS_WGU = 240 * MiB, WS_WDN = 412 * MiB;
constexpr size_t WS_XB = 498 * MiB;
constexpr size_t WS_Q = 626 * MiB, WS_U = 690 * MiB, WS_K = 754 * MiB, WS_V = 818 * MiB, WS_VS = 882 * MiB, WS_SA = 946 * MiB, WS_SB = 1074 * MiB, WS_END = 1202 * MiB;
constexpr size_t WS_MERGED = WS_K;
constexpr size_t WS_QX = WS_VS, WS_OX = WS_VS + 16 * MiB;
constexpr size_t WS_ACT = WS_Q;
static_assert(WS_WDN + (size_t)DM * DFF * 2 <= WS_XB && WS_WGU + (size_t)2 * DFF * DM * 2 <= WS_WDN && WS_ACT + (size_t)M * DFF * 2 <= WS_SB, "ws map");
constexpr int CW_TMO = 0;
constexpr int CW_BAR = 4096;
constexpr int CW_LCNT = 16384, CW_PCNT2 = 24576;
constexpr size_t CTL_SSQ = 256 * 1024;
constexpr int RING_BYTES = 131072, LDS_BYTES = 147456, LDSCTL_OFF = LDS_BYTES - 1024, MISC_OFF = LDSCTL_OFF + 320;
constexpr int OT_OFF = 67584, OTL_OFF = OT_OFF + 65536;

#define RLX_AGENT __ATOMIC_RELAXED, __HIP_MEMORY_SCOPE_AGENT
#define LDS_WAIT() asm volatile("s_waitcnt lgkmcnt(0)" ::: "memory")
#define VM_WAIT() asm volatile("s_waitcnt vmcnt(0)" ::: "memory")
__device__ __forceinline__ unsigned f2bf(float f) { unsigned u = __builtin_bit_cast(unsigned, f); return (u + 0x7fffu + ((u >> 16) & 1u)) >> 16; }
__device__ __forceinline__ unsigned pk2(float lo, float hi) { return f2bf(lo) | (f2bf(hi) << 16); }

#define XB_TMO      128
#define XB_XCNT(j)  (256  + 64 * (j))
#define XB_XSUB(j)  (1280 + 64 * (j))
#define XB_XGEN(j)  (2304 + 64 * (j))
#define XB_TOP      3328
#define XB_TOPGEN   3392
#define XCD_BAR_WORDS 3456
#define XB_SPIN_CAP (1u << 18)
__device__ __forceinline__ unsigned xb_ld(unsigned* p)              { return __hip_atomic_load(p, __ATOMIC_RELAXED, __HIP_MEMORY_SCOPE_AGENT); }
__device__ __forceinline__ unsigned xb_add(unsigned* p, unsigned v) { return __hip_atomic_fetch_add(p, v, __ATOMIC_RELAXED, __HIP_MEMORY_SCOPE_AGENT); }
__device__ __forceinline__ unsigned xb_xcc_id() { return (unsigned)__builtin_amdgcn_s_getreg((3 << 11) | 20) & 0xFu; }
#define XB_SPIN(cond, bar) do { unsigned _sp = 0; while (cond) { __builtin_amdgcn_s_sleep(1); \
    if ((++_sp & 255u) == 0u) { if (xb_ld(&(bar)[XB_TMO])) break; if (_sp > XB_SPIN_CAP) { atomicAdd(&(bar)[XB_TMO], 1u); break; } } } } while (0)
struct XcdBarrier { unsigned* bar; unsigned x; volatile LAS unsigned* st; };
__device__ __forceinline__ XcdBarrier xcd_barrier_post(unsigned* bar, volatile LAS unsigned* st) {
    XcdBarrier b; b.bar = bar; b.x = xb_xcc_id(); b.st = st;
    if (threadIdx.x == 0) (void)xb_add(&bar[XB_XCNT(b.x)], 1u);
    return b;
}
__device__ __forceinline__ void xcd_barrier_complete(unsigned* bar, unsigned x, unsigned& nloc, unsigned& nx) {
    const unsigned G = gridDim.x * gridDim.y * gridDim.z;
    unsigned sum, cnt, mine, sp = 0u;
    for (;;) {
        sum = 0u; cnt = 0u; mine = 0u;
#pragma unroll
        for (unsigned j = 0; j < 16; ++j) { const unsigned c = xb_ld(&bar[XB_XCNT(j)]); sum += c; cnt += (c > 0u) ? 1u : 0u; mine = (j == x) ? c : mine; }
        if (sum == G) break;
        __builtin_amdgcn_s_sleep(1);
        if ((++sp & 255u) == 0u) { if (xb_ld(&bar[XB_TMO])) break; if (sp > XB_SPIN_CAP) { atomicAdd(&bar[XB_TMO], 1u); break; } }
    }
    nloc = mine > 0u ? mine : 1u; nx = cnt > 0u ? cnt : 1u;
}
__device__ __forceinline__ void xcd_barrier(const XcdBarrier& b) {
    asm volatile("s_waitcnt vmcnt(0)" ::: "memory");
    __syncthreads();
    if (threadIdx.x == 0) {
        unsigned* bar = b.bar;
        __builtin_amdgcn_s_waitcnt(0);
        unsigned nloc = b.st[0], nx = b.st[1];
        if (nloc == 0u) { xcd_barrier_complete(bar, b.x, nloc, nx); b.st[0] = nloc; b.st[1] = nx; }
        const unsigned old = xb_add(&bar[XB_XSUB(b.x)], 1u);
        const unsigned gen = old / nloc;
        if (old + 1u == (gen + 1u) * nloc) {
            __builtin_amdgcn_fence(__ATOMIC_RELEASE, "agent");
            asm volatile("s_waitcnt vmcnt(0)" ::: "memory");
            const unsigned og = xb_add(&bar[XB_TOP], 1u);
            const unsigned tg = og / nx;
            if (og + 1u == (tg + 1u) * nx) xb_add(&bar[XB_TOPGEN], 1u);
            else XB_SPIN(xb_ld(&bar[XB_TOPGEN]) == tg, bar);
            __builtin_amdgcn_fence(__ATOMIC_ACQUIRE, "agent");
            xb_add(&bar[XB_XGEN(b.x)], 1u);
            asm volatile("s_waitcnt vmcnt(0)" ::: "memory");
        } else {
            XB_SPIN(xb_ld(&bar[XB_XGEN(b.x)]) == gen, bar);
            __builtin_amdgcn_fence(__ATOMIC_ACQUIRE, "agent");
            asm volatile("s_waitcnt vmcnt(0)" ::: "memory");
        }
    }
    __syncthreads();
}

__device__ __forceinline__ float wave_sum(float v) {
#pragma unroll
    for (int o = 1; o < 64; o <<= 1) v += __shfl_xor(v, o);
    return v;
}
__device__ __forceinline__ void tr_item64(const float* __restrict__ W, int K, int N, int k0, int n0, bf16_t* WT, int drow0, const float* __restrict__ gain, LAS unsigned* scr, int lane) {
    const float* src = W + (size_t)k0 * N + n0 + lane;
    float v[64];
#pragma unroll
    for (int r = 0; r < 64; ++r) v[r] = src[(size_t)r * N];
    if (gain) {
#pragma unroll
        for (int r = 0; r < 64; ++r) v[r] *= gain[k0 + r]; }
#pragma unroll
    for (int i = 0; i < 32; ++i) scr[i * 65 + lane] = cvt_pk_bf16(v[2 * i], v[2 * i + 1]);
    LDS_WAIT(); asm volatile("" ::: "memory");
    const int c = lane & 7;
#pragma unroll
    for (int jj = 0; jj < 8; ++jj) { const int n = (lane >> 3) + 8 * jj; const LAS unsigned* sp = scr + (4 * c) * 65 + n;
        u32x4 o; o.x = sp[0]; o.y = sp[65]; o.z = sp[130]; o.w = sp[195];
        *(GAS u32x4*)(WT + (size_t)(drow0 + n) * K + k0 + 8 * c) = o; }
    LDS_WAIT(); asm volatile("" ::: "memory");
}
struct TrItem { const float* W; bf16_t* WT; const float* gain; int K, N, k0, n0, kind, rowbase; };
__device__ __forceinline__ void tr_issue(const TrItem& it, f32x4 (&v)[8], int wave, int lane) {
    const float* src = it.W + (size_t)(it.k0 + 8 * wave) * it.N + it.n0 + 4 * lane;
#pragma unroll
    for (int r = 0; r < 8; ++r) v[r] = __builtin_nontemporal_load((const f32x4*)(src + (size_t)r * it.N));
}
__device__ __forceinline__ void tr_stage(const TrItem& it, const f32x4 (&v)[8], LAS unsigned* T, int wave, int lane) {
    if (it.kind >= 4) {
        float g[8];
#pragma unroll
        for (int r = 0; r < 8; ++r) g[r] = (it.gain ? it.gain[it.k0 + 8 * wave + r] : 1.f) * W8_SCALE;
#pragma unroll
        for (int j = 0; j < 4; ++j) { T[(4 * lane + j) * 17 + 2 * wave] = pk4_fp8(v[0][j] * g[0], v[1][j] * g[1], v[2][j] * g[2], v[3][j] * g[3]);
            T[(4 * lane + j) * 17 + 2 * wave + 1] = pk4_fp8(v[4][j] * g[4], v[5][j] * g[5], v[6][j] * g[6], v[7][j] * g[7]); }
        return; }
#pragma unroll
    for (int rp = 0; rp < 4; ++rp) { float g0 = 1.f, g1 = 1.f; if (it.gain) { g0 = it.gain[it.k0 + 8 * wave + 2 * rp]; g1 = it.gain[it.k0 + 8 * wave + 2 * rp + 1]; }
#pragma unroll
        for (int j = 0; j < 4; ++j) T[(4 * lane + j) * 33 + 4 * wave + rp] = cvt_pk_bf16(v[2 * rp][j] * g0, v[2 * rp + 1][j] * g1); }
}
__device__ __forceinline__ void tr_readout(const TrItem& it, const LAS unsigned* T, int tid) {
    if (it.kind >= 4) {
#pragma unroll
        for (int i = 0; i < 2; ++i) { const int q = tid + 512 * i, nl = q >> 2, c = q & 3, n = it.n0 + nl; int drow = it.rowbase + n;
            if (it.kind == 5) { const int t = n >> 8, l8 = n & 255; drow = t * 256 + 128 * ((l8 >> 6) & 1) + 64 * (l8 >> 7) + (l8 & 63); }
            const LAS unsigned* sp = T + nl * 17 + 4 * c; u32x4 o; o.x = sp[0]; o.y = sp[1]; o.z = sp[2]; o.w = sp[3];
            *(GAS u32x4*)((unsigned char*)it.WT + (size_t)drow * it.K + it.k0 + 16 * c) = o; }
        return; }
#pragma unroll
    for (int i = 0; i < 4; ++i) { const int q = tid + 512 * i, nl = q >> 3, c = q & 7, n = it.n0 + nl; int drow = it.rowbase + n;
        if (it.kind == 1) { if (n < 4096) { const int t = n >> 8, l8 = n & 255; drow = t * 256 + 128 * ((l8 >> 6) & 1) + 64 * (l8 >> 7) + (l8 & 63); } }
        else if (it.kind >= 2) drow = (n >> 7) * 256 + (it.kind == 3 ? 128 : 0) + (n & 127);
        const LAS unsigned* sp = T + nl * 33 + 4 * c; u32x4 o; o.x = sp[0]; o.y = sp[1]; o.z = sp[2]; o.w = sp[3];
        *(GAS u32x4*)(it.WT + (size_t)drow * it.K + it.k0 + 8 * c) = o; }
}
__device__ __forceinline__ float row_to_bf16(const float* xrow, bf16_t* orow, const float* gain, int lane, unsigned char* o8 = nullptr) {
    const GAS f32x4* xr = (const GAS f32x4*)xrow + lane;
    f32x4 v[16]; float s = 0.f;
#pragma unroll
    for (int j = 0; j < 16; ++j) { v[j] = __builtin_nontemporal_load(xr + 64 * j); s += (v[j].x * v[j].x + v[j].y * v[j].y) + (v[j].z * v[j].z + v[j].w * v[j].w); }
    s = wave_sum(s);
    const float r = gain ? __builtin_amdgcn_rsqf(s * (1.f / DM) + RMS_EPS) : 1.f;
    GAS u32x2* o8b = (GAS u32x2*)orow + lane;
#pragma unroll
    for (int j = 0; j < 16; ++j) { f32x4 g = gain ? ((const GAS f32x4*)gain)[lane + 64 * j] * r : (f32x4){1.f, 1.f, 1.f, 1.f}; f32x4 w = v[j] * g;
        u32x2 o; o.x = cvt_pk_bf16(w.x, w.y); o.y = cvt_pk_bf16(w.z, w.w); o8b[64 * j] = o;
        if (o8) ((GAS unsigned*)o8)[lane + 64 * j] = pk4_fp8(w.x * X8_SCALE, w.y * X8_SCALE, w.z * X8_SCALE, w.w * X8_SCALE); }
    return s;
}
__device__ const float INV_FREQ[64] = {1.f, 0.865964353f, 0.749894261f, 0.649381638f, 0.562341332f, 0.486967534f, 0.421696514f, 0.365174115f, 0.316227764f, 0.273841977f, 0.237137377f, 0.2053525f, 0.177827939f, 0.153992653f, 0.133352131f, 0.115478203f, 0.100000001f, 0.0865964293f, 0.0749894157f, 0.0649381652f, 0.0562341325f, 0.0486967526f, 0.0421696529f, 0.0365174115f, 0.0316227749f, 0.0273841973f, 0.0237137377f, 0.0205352511f, 0.0177827943f, 0.0153992651f, 0.0133352149f, 0.0115478206f, 0.00999999978f, 0.00865964312f, 0.00749894185f, 0.00649381615f, 0.00562341325f, 0.00486967526f, 0.00421696482f, 0.00365174119f, 0.00316227763f, 0.00273841969f, 0.00237137359f, 0.00205352483f, 0.00177827943f, 0.00153992651f, 0.00133352145f, 0.0011547819f, 0.00100000005f, 0.000865964335f, 0.000749894243f, 0.000649381662f, 0.000562341302f, 0.000486967532f, 0.000421696517f, 0.000365174143f, 0.000316227757f, 0.000273841957f, 0.00023713737f, 0.00020535251f, 0.00017782794f, 0.000153992645f, 0.00013335215f, 0.0001154782f};
__device__ __forceinline__ void rope_entry(int pos, int i, float& c, float& s) {
    const float af = (float)pos * INV_FREQ[i];
    const double x = (double)af, k = __builtin_rint(x * 0.63661977236758134308);
    double r = __builtin_fma(-k, 1.57079632673412561417e+00, x); r = __builtin_fma(-k, 6.07710050650619224932e-11, r);
    const double z = r * r;
    double sp = 1.0 / 1307674368000.0; sp = sp * z - 1.0 / 6227020800.0; sp = sp * z + 1.0 / 39916800.0; sp = sp * z - 1.0 / 362880.0; sp = sp * z + 1.0 / 5040.0; sp = sp * z - 1.0 / 120.0; sp = sp * z + 1.0 / 6.0;
    const double sn = r - r * z * sp;
    double cp = 1.0 / 20922789888000.0; cp = cp * z - 1.0 / 87178291200.0; cp = cp * z + 1.0 / 479001600.0; cp = cp * z - 1.0 / 3628800.0; cp = cp * z + 1.0 / 40320.0; cp = cp * z - 1.0 / 720.0; cp = cp * z + 1.0 / 24.0;
    const double cs = 1.0 - 0.5 * z + z * z * cp;
    const int q = (int)k & 3;
    const double so = (q & 1) ? cs : sn, co = (q & 1) ? sn : cs;
    s = (float)((q & 2) ? -so : so); c = (float)(((q + 1) & 2) ? -co : co);
}

__device__ __forceinline__ void sgu_unit(int unit, const bf16_t* __restrict__ VS, const unsigned long long* __restrict__ LNS, const bf16_t* U, bf16_t* OB, const bf16_t* __restrict__ Wt, const float* __restrict__ lng, const float* __restrict__ lnb,
                                         const float* __restrict__ bs, char* lds, int tid, int wid, int lane) {
    const int half = unit & 1, bc = unit >> 1, t0 = bc * SCH, r32 = lane & 31, hi = lane >> 5;
    float* stats = (float*)(lds + 65536);
    if (tid < SCH) { const float m1 = (float)(long long)LNS[2 * (t0 + tid)] * (1.f / (SSQ_SCALE * SW)), m2 = (float)(long long)LNS[2 * (t0 + tid) + 1] * (1.f / (SSQ_SCALE * SW));
        stats[2 * tid] = m1; stats[2 * tid + 1] = __builtin_amdgcn_rsqf(fmaxf(m2 - m1 * m1, 0.f) + LN_EPS); }
    __syncthreads();
    for (int gp = 0; gp < 4; ++gp) {
        const int g0 = half * 8 + gp * 2;
        { const int dc = tid & 15, s0 = tid >> 4; u32x4 vr[8];
#pragma unroll
            for (int i = 0; i < 8; ++i) vr[i] = *(const u32x4*)(VS + (size_t)(t0 + s0 + 32 * (i & 3)) * SW + (g0 + (i >> 2)) * 128 + dc * 8);
#pragma unroll
            for (int gi = 0; gi < 2; ++gi) { const int col = (g0 + gi) * 128 + dc * 8;
                const f32x4 ga = *(const f32x4*)(lng + col), gb = *(const f32x4*)(lng + col + 4), ba = *(const f32x4*)(lnb + col), bb = *(const f32x4*)(lnb + col + 4);
#pragma unroll
                for (int k = 0; k < 4; ++k) { const int s = s0 + 32 * k; f32x4 x0, x1; unpack8(vr[gi * 4 + k], x0, x1);
                    const float mean = stats[2 * s], rstd = stats[2 * s + 1];
                    x0 = (x0 - mean) * rstd * ga + ba; x1 = (x1 - mean) * rstd * gb + bb;
                    *(u32x4*)(lds + gi * 32768 + (s >> 6) * 16384 + att::v_st(s & 63, dc * 8)) = pack8f(x0, x1); } } }
        __syncthreads();
        const int grp = wid >> 2, tt = wid & 3, g = g0 + grp;
        f32x16 o[4] = {};
        const int vb0 = (int)(uintptr_t)lds + grp * 32768 + att::v_rd_base(lane);
        const bf16_t* wp = Wt + ((size_t)g * SCH + tt * 32 + r32) * SCH + hi * 8;
        { const bf16x8 pa0 = att::load8(wp), pa1 = att::load8(wp + 16), pa2 = att::load8(wp + 32), pa3 = att::load8(wp + 48); att::pv_tile<0>(o, vb0, pa0, pa1, pa2, pa3); }
        if (tt >= 2) { const bf16x8 pa0 = att::load8(wp + 64), pa1 = att::load8(wp + 80), pa2 = att::load8(wp + 96), pa3 = att::load8(wp + 112); att::pv_tile<16384>(o, vb0, pa0, pa1, pa2, pa3); }
#pragma unroll
        for (int rh = 0; rh < 2; ++rh) {
            unsigned short up[8][4]; float bias[8];
#pragma unroll
            for (int r = 0; r < 8; ++r) { const int t = tt * 32 + att::crow(rh * 8 + r, hi); bias[r] = bs[g * SCH + t];
#pragma unroll
                for (int d0 = 0; d0 < 4; ++d0) up[r][d0] = U[(size_t)(t0 + t) * SW + g * 128 + d0 * 32 + r32]; }
#pragma unroll
            for (int r = 0; r < 8; ++r) { const int t = tt * 32 + att::crow(rh * 8 + r, hi);
#pragma unroll
                for (int d0 = 0; d0 < 4; ++d0) { const size_t idx = (size_t)(t0 + t) * SW + g * 128 + d0 * 32 + r32;
                    const float uv = __builtin_bit_cast(float, (unsigned)up[r][d0] << 16), v = uv * (o[d0][rh * 8 + r] + bias[r]), vn = __shfl_xor(v, 1);
                    if ((r32 & 1) == 0) *(unsigned*)(OB + idx) = att::cvtpk(v, vn); } } }
        __syncthreads();
    }
}
__device__ __forceinline__ att::BlockRef own_ref(int unit, const bf16_t* Qb, const bf16_t* Kb, const bf16_t* Vb, bf16_t* Ob, float* lse3) {
    const int bh = unit >> 5, cur = unit & 31, b = bh >> 4, h = bh & 15;
    att::BlockRef r; r.Q = Qb + ((size_t)(b * SEQ + cur * 256)) * AW + h * HD; r.O = Ob + ((size_t)(b * SEQ + cur * 256)) * AW + h * HD; r.K = Kb + (size_t)(b * SEQ) * AW + h * HD; r.V = Vb + (size_t)(b * SEQ) * AW + h * HD;
    r.P0 = cur * 256; r.jlo = 4 * cur; r.sel = nullptr; r.lse = lse3 + (size_t)bh * SEQ + cur * 256; return r;
}
__device__ __forceinline__ att::BlockRef xattn_ref(int unit, const bf16_t* QX, const bf16_t* KV, bf16_t* OX) {
    const int b = unit >> 7, hx = (unit >> 5) & 3, qb = unit & 31;
    att::BlockRef r; r.Q = QX + ((size_t)(b * SEQ + qb * 256)) * XW + hx * HD; r.O = OX + ((size_t)(b * SEQ + qb * 256)) * XW + hx * HD;
    r.K = KV + (size_t)(b * NMEM) * (2 * XW) + hx * HD; r.V = r.K + XW; r.P0 = 256; r.jlo = 0; r.sel = nullptr; r.lse = nullptr; return r;
}

struct Args { const float* in[21]; float* out; unsigned char* ws; int ph_lo, ph_hi; };
#define ctl ((unsigned*)((unsigned*)(ws + WS_CTL)))
#define ssq1 ((ssq_t*)((ssq_t*)(ws + CTL_SSQ)))
#define ssq2 ((ssq_t*)(ssq1 + M))
#define ssq3 ((ssq_t*)(ssq2 + M))
#define ssq4 ((ssq_t*)(ssq3 + M))
#define x_in ((const float*)(args.in[0]))
#define mem_in ((const float*)(args.in[1]))
#define g_mix ((const float*)(args.in[2]))
#define w_in ((const float*)(args.in[3]))
#define ln_g ((const float*)(args.in[4]))
#define ln_b ((const float*)(args.in[5]))
#define w_sgu ((const float*)(args.in[6]))
#define b_sgu ((const float*)(args.in[7]))
#define w_pa ((const float*)(args.in[8]))
#define w_pb ((const float*)(args.in[9]))
#define w_out ((const float*)(args.in[10]))
#define g_xat ((const float*)(args.in[11]))
#define g_mem ((const float*)(args.in[12]))
#define w_xq ((const float*)(args.in[13]))
#define w_xkv ((const float*)(args.in[14]))
#define w_xo ((const float*)(args.in[15]))
#define g_ffn ((const float*)(args.in[16]))
#define w_gate ((const float*)(args.in[17]))
#define w_up ((const float*)(args.in[18]))
#define w_down ((const float*)(args.in[19]))
#define g_fin ((const float*)(args.in[20]))
#define out_f ((float*)(args.out))
#define kmpart ((float*)((float*)(ws + WS_KM)))
#define LSE3 ((float*)((float*)(ws + WS_SEL)))
#define LSE ((float*)((float*)(ws + 13 * MiB)))
#define lcnt ((unsigned*)(ctl + CW_LCNT))
#define lists ((unsigned short*)((unsigned short*)(ws + WS_WIN + 128 * MiB)))
#define P01 ((bf16_t*)((bf16_t*)(ws + WS_WIN)))
#define P2 ((bf16_t*)((bf16_t*)(ws + WS_VS)))
#define rope_c ((float*)((float*)(ws + WS_ROPE_C)))
#define rope_s ((float*)((float*)(ws + WS_ROPE_S)))
#define kvpart ((float*)((float*)(ws + WS_SA + 64 * MiB)))
#define wsgu_t ((bf16_t*)((bf16_t*)(ws + WS_WSGU)))
#define memkv ((bf16_t*)((bf16_t*)(ws + WS_MEMKV)))
#define memn ((bf16_t*)((bf16_t*)(ws + WS_MEMN)))
#define Win_t ((bf16_t*)((bf16_t*)(ws + WS_WIN)))
#define Win8 ((unsigned char*)(ws + WS_WIN + 64 * MiB))
#define lnstat ((unsigned long long*)(ws + 768 * 1024))
#define XB8 ((unsigned char*)(ws + WS_SB + 64 * MiB))
#define OA8 ((unsigned char*)(ws + WS_SB + 64 * MiB))
#define Pcat_t ((bf16_t*)((bf16_t*)(ws + WS_PCAT)))
#define Wout_t ((bf16_t*)((bf16_t*)(ws + WS_WOUT)))
#define Wxq_t ((bf16_t*)((bf16_t*)(ws + WS_WXQ)))
#define Wxkv_t ((bf16_t*)((bf16_t*)(ws + WS_WXKV)))
#define Wxo_t ((bf16_t*)((bf16_t*)(ws + WS_WXO)))
#define Wgu_t ((bf16_t*)((bf16_t*)(ws + WS_WGU)))
#define Wdn_t ((bf16_t*)((bf16_t*)(ws + WS_WDN)))
#define XB ((bf16_t*)((bf16_t*)(ws + WS_XB)))
#define OA ((bf16_t*)((bf16_t*)(ws + WS_Q)))
#define OB ((bf16_t*)((bf16_t*)(ws + WS_U)))
#define Qb ((bf16_t*)((bf16_t*)(ws + WS_Q)))
#define Ub ((bf16_t*)((bf16_t*)(ws + WS_U)))
#define Kb ((bf16_t*)((bf16_t*)(ws + WS_K)))
#define Vb ((bf16_t*)((bf16_t*)(ws + WS_V)))
#define VSb ((bf16_t*)((bf16_t*)(ws + WS_VS)))
#define SAb ((unsigned char*)((unsigned char*)(ws + WS_SA)))
#define SBb ((unsigned char*)((unsigned char*)(ws + WS_SB)))
#define MG ((bf16_t*)((bf16_t*)(ws + WS_MERGED)))
#define QX ((bf16_t*)((bf16_t*)(ws + WS_QX)))
#define OX ((bf16_t*)((bf16_t*)(ws + WS_OX)))
#define ACT ((bf16_t*)((bf16_t*)(ws + WS_ACT)))
__global__ void __launch_bounds__(NWAVES * 64, 2) mk_fwd(Args args) {
    extern __shared__ __attribute__((aligned(16))) unsigned char lds[];
    LAS unsigned char* ldsl = (LAS unsigned char*)lds;
    const int tid = threadIdx.x, lane = tid & 63, wave = __builtin_amdgcn_readfirstlane(tid >> 6), G = gridDim.x, B = blockIdx.x;
    unsigned char* ws = args.ws;

    for (int u = tid; u < (LDS_BYTES - LDSCTL_OFF) / 4; u += NWAVES * 64) ((LAS unsigned*)(ldsl + LDSCTL_OFF))[u] = 0u;
    __syncthreads();
    volatile LAS unsigned* MISC = (volatile LAS unsigned*)(ldsl + MISC_OFF);
    const XcdBarrier bar = xcd_barrier_post(ctl + CW_BAR, MISC + 8);
#define GRID_BAR() xcd_barrier(bar)
    const int lo = args.ph_lo, hi_ = args.ph_hi;
#define IN(k) (lo <= (k) && (k) < hi_)
#define BOTH(k) (IN(k) && IN((k) + 1))
    const int gw = B * NWAVES + wave, NGW = G * NWAVES;

            constexpr int J_IN = (DM / 64) * (NIN / 256), J_PA = (AW / 64) * (DM / 256), J_PB = J_PA, J_WO = (DM / 64) * (DM / 256), J_XQ = (DM / 64) * (XW / 256), J_XKV = (DM / 64) * (2 * XW / 256),
                          J_XO = (XW / 64) * (DM / 256), J_G = (DM / 64) * (DFF / 256), J_U = J_G, J_D = (DFF / 64) * (DM / 256);
            constexpr int NJ = J_IN + J_PA + J_PB + J_WO + J_XQ + J_XKV + J_XO + J_G + J_U + J_D, J_FFN0 = NJ - J_G - J_U - J_D, J_DN0 = NJ - J_D;
#define TR_DECODE(IT, idx) do { int r = (idx); TrItem& t_ = (IT); \
            if (r < J_IN) { const int n0_ = (r % (NIN / 256)) * 256, k0_ = (r / (NIN / 256)) * 64; \
                if (n0_ < 4096) t_ = TrItem{w_in, (bf16_t*)Win8, g_mix, DM, NIN, k0_, n0_, 5, 0}; else if (n0_ < 6144) t_ = TrItem{w_in, (bf16_t*)Win8, g_mix, DM, NIN, k0_, n0_, 4, 0}; \
                else if (n0_ < 10240) t_ = TrItem{w_in, Win_t, g_mix, DM, NIN, k0_, n0_, 0, -6144}; else t_ = TrItem{w_in, (bf16_t*)Win8, g_mix, DM, NIN, k0_, n0_, 4, -4096}; break; } r -= J_IN; \
            if (r < J_PA) { t_ = TrItem{w_pa, Pcat_t, nullptr, AW, DM, (r / (DM / 256)) * 64, (r % (DM / 256)) * 256, 4, 0}; break; } r -= J_PA;     \
            if (r < J_PB) { t_ = TrItem{w_pb, Pcat_t, nullptr, SW, DM, (r / (DM / 256)) * 64, (r % (DM / 256)) * 256, 0, DM}; break; } r -= J_PB; \
            if (r < J_WO) { t_ = TrItem{w_out, Wout_t, nullptr, DM, DM, (r / (DM / 256)) * 64, (r % (DM / 256)) * 256, 0, 0}; break; } r -= J_WO; \
            if (r < J_XQ) { t_ = TrItem{w_xq, Wxq_t, g_xat, DM, XW, (r / (XW / 256)) * 64, (r % (XW / 256)) * 256, 0, 0}; break; } r -= J_XQ; \
            if (r < J_XKV) { t_ = TrItem{w_xkv, Wxkv_t, nullptr, DM, 2 * XW, (r / (2 * XW / 256)) * 64, (r % (2 * XW / 256)) * 256, 0, 0}; break; } r -= J_XKV; \
            if (r < J_XO) { t_ = TrItem{w_xo, Wxo_t, nullptr, XW, DM, (r / (DM / 256)) * 64, (r % (DM / 256)) * 256, 0, 0}; break; } r -= J_XO; \
            if (r < J_G) { t_ = TrItem{w_gate, Wgu_t, g_ffn, DM, DFF, (r / (DFF / 256)) * 64, (r % (DFF / 256)) * 256, 2, 0}; break; } r -= J_G; \
            if (r < J_U) { t_ = TrItem{w_up, Wgu_t, g_ffn, DM, DFF, (r / (DFF / 256)) * 64, (r % (DFF / 256)) * 256, 3, 0}; break; } r -= J_U; \
            t_ = TrItem{w_down, Wdn_t, nullptr, DFF, DM, (r / (DM / 256)) * 64, (r % (DM / 256)) * 256, 0, 0}; } while (0)
#define TR_LOOP(LO, HI, RANK, NBLK) do { f32x4 v[8]; TrItem cur_, nxt_; int idx = (LO) + (RANK), par = 0; int lane_ = threadIdx.x & 63; asm volatile("" : "+v"(lane_));     \
            if (idx < (HI)) { TR_DECODE(cur_, idx); tr_issue(cur_, v, wave, lane_); } \
            for (; idx < (HI); idx += (NBLK), par ^= 1) { LAS unsigned* T = (LAS unsigned*)(ldsl + par * 34816); \
                tr_stage(cur_, v, T, wave, lane_); \
                const bool more = idx + (NBLK) < (HI); \
                if (more) { TR_DECODE(nxt_, idx + (NBLK)); tr_issue(nxt_, v, wave, lane_); } \
                __syncthreads(); \
                tr_readout(cur_, T, tid); \
                if (more) cur_ = nxt_; } \
            __syncthreads(); } while (0)
    if (IN(0)) { for (int rep_ = 0; rep_ <= ((MK_REP >> 0) & 1) * MK_REPN; ++rep_) { if (rep_) GRID_BAR();
        TR_LOOP(0, J_FFN0, B, G);
        for (int m = gw; m < M; m += NGW) { const float s = row_to_bf16(x_in + (size_t)m * DM, XB + (size_t)m * DM, nullptr, lane, XB8 + (size_t)m * DM); if (lane == 0) ssq1[m] = (ssq_t)(s * SSQ_SCALE + 0.5f); }
        for (int m = gw; m < BATCH * NMEM; m += NGW) (void)row_to_bf16(mem_in + (size_t)m * DM, memn + (size_t)m * DM, g_mem, lane);
        for (int e = B * 512 + tid; e < SEQ * 64; e += G * 512) { float c, s; rope_entry(e >> 6, e & 63, c, s); rope_c[e] = c; rope_s[e] = s; }
        for (int e = B * 512 + tid; e < NGRP * SCH * SCH; e += G * 512) { const int t = (e >> 7) & 127, s = e & 127; wsgu_t[e] = (bf16_t)(s <= t ? f2bf(w_sgu[e]) : 0u); }
        } if (BOTH(0)) GRID_BAR();
    }
    if (IN(1)) { for (int rep_ = 0; rep_ <= ((MK_REP >> 1) & 1) * MK_REPN; ++rep_) { if (rep_) GRID_BAR();
        { pg8::Gemm g{XB, Win_t, M, 4096, DM, DM}; pg8::StaticOrder S; S.init(M, 4096, G, B, 4);
          pg8::EpiIn<0> E{ssq1, rope_c, rope_s, Qb, Kb, Vb, Ub, VSb, SAb, SBb, kmpart, lnstat};
          pg8::gemm_phase<pg8::EpiIn<0>, pg8::StaticOrder, true, true, false>(ldsl, g, S, E); }
        { pg8::Gemm g{(const bf16_t*)XB8, (const bf16_t*)Win8, M, 14336, DM / 2, DM / 2}; pg8::StaticOrder S; S.init(M, 14336, G, B);
          pg8::EpiIn<1> E{ssq1, rope_c, rope_s, Qb, Kb, Vb, Ub, VSb, SAb, SBb, kmpart, lnstat};
          pg8::gemm_phase<pg8::EpiIn<1>, pg8::StaticOrder, true, true, true>(ldsl, g, S, E); }
        } if (BOTH(1)) GRID_BAR();
    }
    if (IN(3)) { for (int rep_ = 0; rep_ <= ((MK_REP >> 3) & 1) * MK_REPN; ++rep_) { if (rep_) GRID_BAR();
        if (B < 64 && G >= 128) {
            pg8::Gemm g{memn, Wxkv_t, BATCH * NMEM, 2 * XW, 512, DM}; pg8::MemKVOrder S{B};
            pg8::EpiPart E{kvpart};
            pg8::gemm_phase<pg8::EpiPart, pg8::MemKVOrder, true, true>(ldsl, g, S, E);
        }
        for (int j = B, rd = 0; j < 512; j += G, ++rd) { const int bh = j >> 4; int cc = j & 15; if (rd & 1) cc = 15 - cc;
            const int s = cc * 512 + tid, cur = __builtin_amdgcn_readfirstlane(s >> 8), b = bh >> 4, h = bh & 15;
            LAS float* kml = (LAS float*)ldsl;
            __syncthreads();
            { const int e8 = tid * 8, n_ = e8 >> 7, d_ = e8 & 127; const float* p0_ = kmpart + ((((size_t)(b * 32 + n_)) * NH + h) * 2) * HD + d_;
              const f32x4 a0 = *(const f32x4*)p0_, a1 = *(const f32x4*)(p0_ + 4), b0 = *(const f32x4*)(p0_ + HD), b1 = *(const f32x4*)(p0_ + HD + 4);
              *(LAS f32x4*)(kml + e8) = (a0 + b0) * (1.f / 256.f); *(LAS f32x4*)(kml + e8 + 4) = (a1 + b1) * (1.f / 256.f); }
            __syncthreads();
            int i0 = 0, i1 = 1, i2 = 2;
            if (cur > 3) {
                f32x4 qf[32]; const bf16_t* qp = Qb + (size_t)(b * SEQ + s) * AW + h * HD;
#pragma unroll
                for (int i = 0; i < 16; ++i) unpack8(*(const u32x4*)(qp + 8 * i), qf[2 * i], qf[2 * i + 1]);
                float v0 = -__builtin_inff(), v1 = v0, v2 = v0;
                for (int n = 0; n < cur; ++n) { const LAS float* kp = kml + n * HD; f32x4 dv = {0.f, 0.f, 0.f, 0.f};
#pragma unroll
                    for (int i = 0; i < 32; ++i) dv += qf[i] * *(const LAS f32x4*)(kp + 4 * i);
                    const float d0 = dv[0] + dv[2], d1 = dv[1] + dv[3];
                    const float gsc = d0 + d1;
                    if (gsc > v2) { if (gsc > v1) { v2 = v1; i2 = i1; if (gsc > v0) { v1 = v0; i1 = i0; v0 = gsc; i0 = n; } else { v1 = gsc; i1 = n; } } else { v2 = gsc; i2 = n; } } }
            }
            const int nv = cur < 3 ? cur : 3;
            LAS int* lc = (LAS int*)(ldsl + 137216); LAS int* gb = lc + 32;
            if (tid < 32) lc[tid] = 0;
            __syncthreads();
            int lp0 = 0, lp1 = 0, lp2 = 0;
            if (nv > 0) lp0 = __hip_atomic_fetch_add(lc + i0, 1, __ATOMIC_RELAXED, __HIP_MEMORY_SCOPE_WORKGROUP);
            if (nv > 1) lp1 = __hip_atomic_fetch_add(lc + i1, 1, __ATOMIC_RELAXED, __HIP_MEMORY_SCOPE_WORKGROUP);
            if (nv > 2) lp2 = __hip_atomic_fetch_add(lc + i2, 1, __ATOMIC_RELAXED, __HIP_MEMORY_SCOPE_WORKGROUP);
            __syncthreads();
            if (tid < 32) { const int c_ = lc[tid]; gb[tid] = c_ > 0 ? (int)atomicAdd((rep_ ? ctl + CW_PCNT2 : lcnt) + bh * 32 + tid, (unsigned)c_) : 0; }
            __syncthreads();
            unsigned short* lists_ = rep_ ? (unsigned short*)(ws + WS_SA + 80 * MiB) : lists;
            if (nv > 0) lists_[(size_t)(bh * 32 + i0) * 8192 + gb[i0] + lp0] = (unsigned short)s;
            if (nv > 1) lists_[(size_t)(bh * 32 + i1) * 8192 + gb[i1] + lp1] = (unsigned short)(s | (1 << 13));
            if (nv > 2) lists_[(size_t)(bh * 32 + i2) * 8192 + gb[i2] + lp2] = (unsigned short)(s | (2 << 13));
            __syncthreads();
        }

        for (int u = B; u < 2 * (M / SCH); u += G) sgu_unit(u, VSb, lnstat, Ub, rep_ ? (bf16_t*)(ws + WS_SB + 64 * MiB) : OB, wsgu_t, ln_g, ln_b, b_sgu, (char*)lds, tid, wave, lane);
        } if (BOTH(3)) GRID_BAR();
    }
    if (IN(4)) { for (int rep_ = 0; rep_ <= ((MK_REP >> 4) & 1) * MK_REPN; ++rep_) { if (rep_) GRID_BAR();
        {
            int* pre = (int*)((char*)lds + 137216); int* wtot = pre + 1028;
            { const int c0_ = (int)((lcnt[2 * tid] + 255u) >> 8), c1_ = (int)((lcnt[2 * tid + 1] + 255u) >> 8), a_ = 4 * c0_ + 3 * (c0_ > 0), b_ = 4 * c1_ + 3 * (c1_ > 0); int v = a_ + b_;
#pragma unroll
              for (int o_ = 1; o_ < 64; o_ <<= 1) { const int t2 = __shfl_up(v, o_); if (lane >= o_) v += t2; }
              if (lane == 63) wtot[wave] = v;
              __syncthreads();
              int off = 0; for (int w_ = 0; w_ < wave; ++w_) off += wtot[w_];
              v += off; pre[2 * tid] = v - a_ - b_; pre[2 * tid + 1] = v - b_; if (tid == 511) pre[1024] = v;
              __syncthreads(); }
            const int T = pre[1024]; const int glo = (int)((long)B * T / G), ghi = (int)((long)(B + 1) * T / G);
            for (int pass_ = 0; pass_ <= ((MK_REP >> 23) & 1); ++pass_) {
            int li = 0;
            for (int g_ = glo; g_ < ghi;) {
                while (pre[li + 1] <= g_) ++li;
                const int nch = (pre[li + 1] - pre[li] - 3) >> 2, rend = pre[li + 1] < ghi ? pre[li + 1] : ghi;
                int c_lo = (g_ - pre[li] - 3 + 3) >> 2; if (g_ - pre[li] - 3 < 0) c_lo = 0; int c_hi = (rend - pre[li] - 3 + 3) >> 2; if (rend - pre[li] - 3 < 0) c_hi = 0; if (c_hi > nch) c_hi = nch;
                g_ = rend;
                if (c_hi <= c_lo) continue;
                const int cntl = (int)lcnt[li], bh = li >> 5, n = li & 31, b = bh >> 4, h = bh & 15; (void)nch;
                __syncthreads();
                att::gather_load_kv(Kb + (size_t)(b * SEQ + n * 256) * AW + h * HD, Vb + (size_t)(b * SEQ + n * 256) * AW + h * HD, (char*)lds);
                __syncthreads();
                att::gather_run(Qb + (size_t)(b * SEQ) * AW + h * HD, lists + (size_t)li * 8192, c_lo, c_hi, cntl, P01, P2, LSE, (size_t)bh * SEQ, (char*)lds);
            } }
        }
        } if (BOTH(4)) GRID_BAR();
    }
    if (IN(5)) { for (int rep_ = 0; rep_ <= ((MK_REP >> 5) & 1) * MK_REPN; ++rep_) { if (rep_) GRID_BAR();
        for (int e = B * 512 + tid; e < BATCH * NMEM * 2 * XW / 4; e += G * 512) { f32x4 a = ((const f32x4*)kvpart)[e];
#pragma unroll
            for (int k = 1; k < 8; ++k) a += ((const f32x4*)kvpart)[e + k * (BATCH * NMEM * 2 * XW / 4)];
            u32x2 o; o.x = cvt_pk_bf16(a[0], a[1]); o.y = cvt_pk_bf16(a[2], a[3]); ((u32x2*)memkv)[e] = o; }
        if (B < BATCH * NH * 32) {
            att::Seam S; int unit = B;
            att::BlockRef cur = own_ref(unit, Qb, Kb, Vb, OA, LSE3); att::prime<AW, AW>(cur, (char*)lds, S);
            for (;;) { const int nunit = unit + G; const bool last = nunit >= BATCH * NH * 32;
                const att::BlockRef nxt = last ? cur : own_ref(nunit, Qb, Kb, Vb, OA, LSE3);
                att::block<AW, AW, HD, true>(cur, nxt, SEQ, (char*)lds, S);
                {
                    const int bh = unit >> 5, cq = unit & 31, nv = cq < 3 ? cq : 3, b = bh >> 4, h = bh & 15;
                    const bf16_t* Ot = (const bf16_t*)((char*)lds + OT_OFF); const float* Ol = (const float*)((char*)lds + OTL_OFF);
                    int tid_c = threadIdx.x; asm volatile("" : "+v"(tid_c));
#pragma unroll 2
                    for (int i = 0; i < 8; ++i) { const int it = tid_c + 512 * i, rr = it >> 4, c = it & 15; const size_t row = (size_t)bh * SEQ + cq * 256 + rr;
                        const float l3 = Ol[rr]; float lj[3]; float lmax = l3;
#pragma unroll
                        for (int j = 0; j < 3; ++j) { lj[j] = j < nv ? LSE[(size_t)j * (BATCH * NH * SEQ) + row] : -__builtin_inff(); lmax = fmaxf(lmax, lj[j]); }
                        const float w3 = __builtin_amdgcn_exp2f(l3 - lmax); float wsum = w3;
                        f32x4 a0, a1; unpack8(*(const u32x4*)(Ot + rr * HD + c * 8), a0, a1); a0 *= w3; a1 *= w3;
#pragma unroll
                        for (int j = 0; j < 3; ++j) if (j < nv) { const float wj = __builtin_amdgcn_exp2f(lj[j] - lmax); wsum += wj;
                            const bf16_t* pp = (j < 2 ? P01 + (size_t)j * ((size_t)BATCH * NH * SEQ * HD) : P2) + row * HD + c * 8;
                            f32x4 p0_, p1_; unpack8(*(const u32x4*)pp, p0_, p1_); a0 += p0_ * wj; a1 += p1_ * wj; }
                        const float rw = __builtin_amdgcn_rcpf(wsum);
                        a0 *= rw * OA8_SCALE; a1 *= rw * OA8_SCALE; u32x2 w8; w8.x = pk4_fp8(a0[0], a0[1], a0[2], a0[3]); w8.y = pk4_fp8(a1[0], a1[1], a1[2], a1[3]);
                        *(u32x2*)(OA8 + (size_t)(b * SEQ + cq * 256 + rr) * AW + h * HD + c * 8) = w8; }
                }
                if (last) break;
                cur = nxt; unit = nunit; }
        }
        } if (BOTH(5)) GRID_BAR();
    }
    if (IN(7)) { for (int rep_ = 0; rep_ <= ((MK_REP >> 7) & 1) * MK_REPN; ++rep_) { if (rep_) GRID_BAR();
        { pg8::Gemm g{(const bf16_t*)OA8, Pcat_t, M, DM, AW / 2, AW / 2}; pg8::StaticOrder S; S.init(M, DM, G, B, 4);
          pg8::EpiBranch<0> E{SAb, MG};
          pg8::gemm_phase<pg8::EpiBranch<0>, pg8::StaticOrder, true, true, true>(ldsl, g, S, E); }
        { pg8::Gemm g{OB, Pcat_t + (size_t)DM * AW, M, DM, AW, AW}; pg8::StaticOrder S; S.init(M, DM, G, B, 4);
          pg8::EpiBranch<1> E{SBb, MG};
          pg8::gemm_phase<pg8::EpiBranch<1>, pg8::StaticOrder, true, true, false>(ldsl, g, S, E); }
        } if (BOTH(7)) GRID_BAR();
    }
    if (IN(8)) { for (int rep_ = 0; rep_ <= ((MK_REP >> 8) & 1) * MK_REPN; ++rep_) { if (rep_) GRID_BAR();
        pg8::Gemm g{MG, Wout_t, M, DM, DM, DM}; pg8::StaticOrder S; S.init(M, DM, G, B, 4);
        pg8::EpiResid E{nullptr, XB, rep_ ? (bf16_t*)(ws + WS_SB) : XB, rep_ ? (ssq_t*)(ws + 13 * MiB) : ssq2};
        pg8::gemm_phase<pg8::EpiResid, pg8::StaticOrder, true, true>(ldsl, g, S, E);
        } if (BOTH(8)) GRID_BAR();
    }
    if (IN(9)) { for (int rep_ = 0; rep_ <= ((MK_REP >> 9) & 1) * MK_REPN; ++rep_) { if (rep_) GRID_BAR();
        pg8::Gemm g{XB, Wxq_t, M, XW, DM, DM}; pg8::StaticOrder S; S.init(M, XW, G, B);
        pg8::EpiScale E{ssq2, QX, XW};
        pg8::gemm_phase<pg8::EpiScale, pg8::StaticOrder, true, true>(ldsl, g, S, E);
        { pg8::Unit uq;
          if (G == 256 && S.next(0, uq)) {
            att::Seam AS; const int ub = (uq.pm >> 5) * 128 + (uq.pn * 2) * 32 + (uq.pm & 31);
            att::BlockRef cur = xattn_ref(ub, QX, memkv, OX); att::prime<XW, 2 * XW>(cur, (char*)lds, AS);
#pragma nounroll
            for (int k_ = 0; k_ < 2; ++k_) { const att::BlockRef nxt = xattn_ref(ub + 32, QX, memkv, OX);
                att::block<XW, 2 * XW, XW>(cur, nxt, NMEM, (char*)lds, AS); cur = nxt; } } }
        { constexpr int NXQ = (M / 256) * (XW / 256);
          if (G > NXQ) { if (B >= NXQ) TR_LOOP(J_FFN0, J_DN0, B - NXQ, G - NXQ); } else TR_LOOP(J_FFN0, J_DN0, B, G); }
        } if (BOTH(9)) GRID_BAR();
    }
    if (IN(11)) { for (int rep_ = 0; rep_ <= ((MK_REP >> 11) & 1) * MK_REPN; ++rep_) { if (rep_) GRID_BAR();
        pg8::Gemm g{OX, Wxo_t, M, DM, XW, XW}; pg8::StaticOrder S; S.init(M, DM, G, B, 4);
        pg8::EpiResid E{nullptr, XB, rep_ ? (bf16_t*)(ws + WS_SB) : XB, rep_ ? (ssq_t*)(ws + 13 * MiB) : ssq3};
        pg8::gemm_phase<pg8::EpiResid, pg8::StaticOrder, true, true>(ldsl, g, S, E);
        } if (BOTH(11)) GRID_BAR();
    }
    if (IN(12)) { for (int rep_ = 0; rep_ <= ((MK_REP >> 12) & 1) * MK_REPN; ++rep_) { if (rep_) GRID_BAR();
        pg8::Gemm g{XB, Wgu_t, M, 2 * DFF, DM, DM}; pg8::StaticOrder S; S.init(M, 2 * DFF, G, B);
        pg8::EpiGU E{ssq3, ACT};
        pg8::gemm_phase<pg8::EpiGU, pg8::StaticOrder, true, true>(ldsl, g, S, E);
        { const int rem = ((M / 256) * (2 * DFF / 256)) % G;
          if (rem != 0) { if (B >= rem) TR_LOOP(J_DN0, NJ, B - rem, G - rem); } else TR_LOOP(J_DN0, NJ, B, G); }
        } if (BOTH(12)) GRID_BAR();
    }
    if (IN(13)) { for (int rep_ = 0; rep_ <= ((MK_REP >> 13) & 1) * MK_REPN; ++rep_) { if (rep_) GRID_BAR();
        pg8::Gemm g{ACT, Wdn_t, M, DM, DFF, DFF};
        pg8::EpiResid E{nullptr, XB, rep_ ? (bf16_t*)(ws + WS_SB) : XB, rep_ ? (ssq_t*)(ws + 13 * MiB) : ssq4};
        pg8::StaticOrder S; S.init(M, DM, G, B, 4); pg8::gemm_phase<pg8::EpiResid, pg8::StaticOrder, true, true>(ldsl, g, S, E);
        } if (BOTH(13)) GRID_BAR();
    }
    if (IN(14)) { for (int rep_ = 0; rep_ <= ((MK_REP >> 14) & 1) * MK_REPN; ++rep_) { if (rep_) GRID_BAR();
        int lane_ = threadIdx.x & 63; asm volatile("" : "+v"(lane_));
        for (int m = (int)blockIdx.x * NWAVES + (int)(threadIdx.x >> 6); m < M; m += NGW) { const float r = rs_of(ssq4, m); GAS f32x4* p = (GAS f32x4*)(out_f + (size_t)m * DM) + 2 * lane_; const GAS u32x4* xp = (const GAS u32x4*)(XB + (size_t)m * DM) + lane_;
#pragma unroll
            for (int j = 0; j < 8; ++j) { f32x4 a0, a1; unpack8(xp[64 * j], a0, a1); const GAS f32x4* gp = (const GAS f32x4*)g_fin + 2 * lane_ + 128 * j;
                p[128 * j] = a0 * gp[0] * r; p[128 * j + 1] = a1 * gp[1] * r; } }
    } }
#undef IN
#undef BOTH
}

#undef ctl
#undef ssq1
#undef ssq2
#undef ssq3
#undef ssq4
#undef x_in
#undef mem_in
#undef g_mix
#undef w_in
#undef ln_g
#undef ln_b
#undef w_sgu
#undef b_sgu
#undef w_pa
#undef w_pb
#undef w_out
#undef g_xat
#undef g_mem
#undef w_xq
#undef w_xkv
#undef w_xo
#undef g_ffn
#undef w_gate
#undef w_up
#undef w_down
#undef g_fin
#undef out_f
#undef kmpart
#undef LSE3
#undef LSE
#undef lcnt
#undef lists
#undef P01
#undef P2
#undef rope_c
#undef rope_s
#undef kvpart
#undef wsgu_t
#undef memkv
#undef memn
#undef Win_t
#undef Pcat_t
#undef Wout_t
#undef Wxq_t
#undef Wxkv_t
#undef Wxo_t
#undef Wgu_t
#undef Wdn_t
#undef XB
#undef OA
#undef OB
#undef Qb
#undef Ub
#undef Kb
#undef Vb
#undef VSb
#undef SAb
#undef SBb
#undef MG
#undef QX
#undef OX
#undef ACT
extern "C" void kernel_launch(void* const* d_in, const int* in_sizes, int n_in, void* d_out, int out_size, void* d_ws, size_t ws_size, hipStream_t stream) {
    static int grid = 0;
    if (grid == 0) {
        if (n_in != 21 || in_sizes[0] != M * DM || out_size != M * DM || ws_size < WS_END) { fprintf(stderr, "kernel_launch: unexpected shapes / workspace (n_in %d, ws %zu < %zu); nothing launched\n", n_in, ws_size, (size_t)WS_END); grid = -1; return; }
        int dev = 0, cus = 0, per_cu = 0;
        if (hipGetDevice(&dev) != hipSuccess || hipDeviceGetAttribute(&cus, hipDeviceAttributeMultiprocessorCount, dev) != hipSuccess) { grid = -1; return; }
        if (hipFuncSetAttribute((const void*)mk_fwd, hipFuncAttributeMaxDynamicSharedMemorySize, LDS_BYTES) != hipSuccess) { fprintf(stderr, "kernel_launch: hipFuncSetAttribute failed\n"); grid = -1; return; }
        if (hipOccupancyMaxActiveBlocksPerMultiprocessor(&per_cu, (const void*)mk_fwd, NWAVES * 64, LDS_BYTES) != hipSuccess || per_cu < 1) { fprintf(stderr, "kernel_launch: occupancy query reports %d workgroups per CU\n", per_cu); }
        (void)hipGetLastError();
        if (cus < 256) { fprintf(stderr, "kernel_launch: this kernel's phase program is dealt over exactly 256 workgroups, one per CU; the device has %d CUs; nothing launched\n", cus); grid = -1; return; }
        grid = 256;
    }
    if (grid < 0) return;
    (void)hipMemsetAsync((char*)d_ws + WS_CTL, 0, CTL_ZERO_BYTES, stream);
    Args a{};
    for (int i = 0; i < 21; ++i) a.in[i] = (const float*)d_in[i];
    a.out = (float*)d_out; a.ws = (unsigned char*)d_ws;
#if MK_PER_PHASE
    for (int p = 0; p < N_PHASES; ++p) { a.ph_lo = p; a.ph_hi = p + 1; hipLaunchKernelGGL(mk_fwd, dim3(grid), dim3(NWAVES * 64), LDS_BYTES, stream, a); }
#else
    a.ph_lo = 0; a.ph_hi = N_PHASES; hipLaunchKernelGGL(mk_fwd, dim3(grid), dim3(NWAVES * 64), LDS_BYTES, stream, a);
#endif
}
```

```cpp
#include <hip/hip_runtime.h>
#include <cstdio>
#include <cstdint>

#ifndef MK_REP
#define MK_REP 0
#endif
#ifndef MK_REPN
#define MK_REPN 1
#endif
#ifndef MK_PER_PHASE
#define MK_PER_PHASE 0
#endif

#define GAS __attribute__((address_space(1)))
#define LAS __attribute__((address_space(3)))
typedef unsigned short bf16_t;
typedef short bf16x8 __attribute__((ext_vector_type(8)));
typedef short s16x4 __attribute__((ext_vector_type(4)));
typedef float f32x2 __attribute__((ext_vector_type(2)));
typedef float f32x4 __attribute__((ext_vector_type(4)));
typedef float f32x16 __attribute__((ext_vector_type(16)));
typedef unsigned u32x2 __attribute__((ext_vector_type(2)));
typedef unsigned u32x4 __attribute__((ext_vector_type(4)));

constexpr int BATCH = 2, SEQ = 8192, M = BATCH * SEQ, DM = 4096, HD = 128, NH = 16, AW = 2048, SW = 2048, NIN = 18432, DFF = 11008, NMEM = 256, XH = 4, XW = 512;
constexpr int NGRP = 16, SCH = 128;
constexpr float RMS_EPS = 1e-6f, LN_EPS = 1e-5f;

typedef __bf16 bf16x2_t __attribute__((ext_vector_type(2)));
__device__ __forceinline__ unsigned cvt_pk_bf16(float lo, float hi) { f32x2 v = {lo, hi}; bf16x2_t b = __builtin_convertvector(v, bf16x2_t); return __builtin_bit_cast(unsigned, b); }
__device__ __forceinline__ u32x4 pack8f(f32x4 a, f32x4 b) { u32x4 w; w.x = cvt_pk_bf16(a[0], a[1]); w.y = cvt_pk_bf16(a[2], a[3]); w.z = cvt_pk_bf16(b[0], b[1]); w.w = cvt_pk_bf16(b[2], b[3]); return w; }
__device__ __forceinline__ float bflo(unsigned w) { return __builtin_bit_cast(float, w << 16); }
__device__ __forceinline__ float bfhi(unsigned w) { return __builtin_bit_cast(float, w & 0xffff0000u); }
__device__ __forceinline__ void unpack8(u32x4 w, f32x4& a, f32x4& b) { a = (f32x4){bflo(w.x), bfhi(w.x), bflo(w.y), bfhi(w.y)}; b = (f32x4){bflo(w.z), bfhi(w.z), bflo(w.w), bfhi(w.w)}; }
typedef int i32x4v __attribute__((ext_vector_type(4)));
typedef int i32x8v __attribute__((ext_vector_type(8)));
__device__ __forceinline__ f32x4 up4_fp8(unsigned w) { const auto lo = __builtin_amdgcn_cvt_pk_f32_fp8(w, false), hi = __builtin_amdgcn_cvt_pk_f32_fp8(w, true); return (f32x4){lo[0], lo[1], hi[0], hi[1]}; }
__device__ __forceinline__ unsigned pk4_fp8(float a, float b, float c, float d) { unsigned w = 0; w = __builtin_amdgcn_cvt_pk_fp8_f32(a, b, w, false); w = __builtin_amdgcn_cvt_pk_fp8_f32(c, d, w, true); return w; }
constexpr float X8_SCALE = 16.f, W8_SCALE = 1024.f, ACC8_SCALE = 1.f / (16.f * 1024.f), OA8_SCALE = 32.f, ACCA_SCALE = 1.f / (32.f * 1024.f);
typedef unsigned long long ssq_t;
constexpr float SSQ_SCALE = 16777216.f;
__device__ __forceinline__ float rs_of(const ssq_t* p, int row) { return __builtin_amdgcn_rsqf((float)p[row] * (1.f / (SSQ_SCALE * 4096.f)) + 1e-6f); }
__device__ __forceinline__ float sigmoidf_(float v) { return __builtin_amdgcn_rcpf(1.f + __builtin_amdgcn_exp2f(-1.4426950408889634f * v)); }
__device__ __forceinline__ float gelu_tanh(float v) { const float y = 0.7978845608028654f * (v + 0.044715f * v * v * v); return v * __builtin_amdgcn_rcpf(1.f + __builtin_amdgcn_exp2f(-2.8853900817779268f * y)); }
__device__ __forceinline__ f32x4 gelu4(f32x4 v) { return (f32x4){gelu_tanh(v[0]), gelu_tanh(v[1]), gelu_tanh(v[2]), gelu_tanh(v[3])}; }
__device__ __forceinline__ f32x4 sigm4(f32x4 v) { return (f32x4){sigmoidf_(v[0]), sigmoidf_(v[1]), sigmoidf_(v[2]), sigmoidf_(v[3])}; }

namespace pg8 {
constexpr int BM = 256, BK = 64, HALF = 128, HTB = HALF * BK * 2, STAGE_BYTES = 8 * HTB, NXCD = 8, WGM = 8;
__host__ __device__ __forceinline__ int lds_byte(int r, int c) { const int st = (r >> 4) * 2 + (c >> 5), rr = r & 15, cc = c & 31, ob = rr * 64 + cc * 2; return st * 1024 + (ob ^ (((ob >> 9) & 1) << 5)); }
__host__ __device__ __forceinline__ void stage_rc(int b, int& R, int& C) { const int st = b / 1024, sb = b % 1024, swz = sb ^ (((sb >> 9) & 1) << 5); R = (st >> 1) * 16 + swz / 64; C = (st & 1) * 32 + (swz % 64) / 2; }
__host__ __device__ __forceinline__ int perm32(int rho) { const int n = rho >> 4, i = rho & 15; return 8 * (i >> 2) + 4 * n + (i & 3); }
struct Unit { int pm, pn, ko; };
struct Gemm { const bf16_t* A; const bf16_t* Bt; int M, N, K, ld; };
struct StaticOrder {
    int nM, nN, nwg, G, c, wgm;
    __host__ __device__ void init(int M_, int N_, int G_, int c_, int wgm_ = WGM) { nM = M_ / BM; nN = N_ / BM; nwg = nM * nN; G = G_; c = c_; wgm = wgm_; }
    __host__ __device__ __forceinline__ bool next(int i, Unit& u) const {
        const long L = (long)i * G + c; if (L >= nwg) return false;
        int wgid = (int)L; { const int q = nwg / NXCD, r = nwg % NXCD, xcd = wgid % NXCD, off = wgid / NXCD; wgid = (xcd < r ? xcd * (q + 1) : r * (q + 1) + (xcd - r) * q) + off; }
        const int nig = wgm * nN, gid = wgid / nig, fm = gid * wgm, gsz = (nM - fm) < wgm ? (nM - fm) : wgm;
        u.pm = fm + ((wgid % nig) % gsz); u.pn = (wgid % nig) / gsz; u.ko = 0; return true;
    }
    __device__ __forceinline__ void a_ready(const Unit&) const {}
    __device__ __forceinline__ void done(const Unit&) const {}
};

struct MemKVOrder {
    int c;
    __device__ bool next(int i, Unit& u) const { if (i > 0 || c >= 64) return false; u.pm = c & 1; u.pn = (c >> 1) & 3; u.ko = (c >> 3) * 512; return true; }
    __device__ __forceinline__ void a_ready(const Unit&) const {}
    __device__ __forceinline__ void done(const Unit&) const {}
};

template <int MODE> struct EpiIn {
    static constexpr bool PERM = true, AFTER_DRAIN = false;
    const ssq_t* ssq; const float* rc; const float* rsn; bf16_t *Q, *K, *V, *U, *VS; unsigned char *SA, *SB; float* kmpart; unsigned long long* lnstat;
    __device__ __forceinline__ bool keep(const Unit&) const { return false; }
    __device__ __forceinline__ void operator()(f32x4 (&acc)[2][2][4][2], const Unit& un, int wr, int wc, int fr, int fq) const {
        asm volatile("" : "+v"(fr), "+v"(fq));
        const int rowb = un.pm * BM + wr * 64 + fr, pn = MODE ? (un.pn < 24 ? un.pn : un.pn + 16) : un.pn + 24;
        float rsc[2][4];
#pragma unroll
        for (int ai = 0; ai < 2; ++ai)
#pragma unroll
            for (int m = 0; m < 4; ++m) rsc[ai][m] = rs_of(ssq, rowb + ai * HALF + m * 16) * (MODE ? ACC8_SCALE : 1.f);
        if (MODE == 1 && pn < 16) {
            bf16_t* dst = pn < 8 ? Q : K; const int head = (pn & 7) * 2 + (wc >> 1), dd0 = 32 * (wc & 1) + 8 * fq;
            f32x4 cs[4] = {};
            f32x4 tc[2][2][2], ts[2][2][2];
#pragma unroll
            for (int mm = 0; mm < 2; ++mm) { const int pos = (rowb + mm * 16) & (SEQ - 1);
                tc[0][mm][0] = *(const f32x4*)(rc + pos * 64 + dd0); tc[0][mm][1] = *(const f32x4*)(rc + pos * 64 + dd0 + 4); ts[0][mm][0] = *(const f32x4*)(rsn + pos * 64 + dd0); ts[0][mm][1] = *(const f32x4*)(rsn + pos * 64 + dd0 + 4); }
#pragma unroll
            for (int am = 0; am < 4; ++am) {
                const int ai = am >> 1, m0 = (am & 1) * 2, bf = am & 1;
                u32x4 ow[2][2];
#pragma unroll
                for (int mm = 0; mm < 2; ++mm) { const int m = m0 + mm; const float r = rsc[ai][m];
                    const f32x4 c0 = tc[bf][mm][0], c1 = tc[bf][mm][1], s0 = ts[bf][mm][0], s1 = ts[bf][mm][1];
                    const f32x4 x1a = acc[ai][0][m][0] * r, x1b = acc[ai][0][m][1] * r, x2a = acc[ai][1][m][0] * r, x2b = acc[ai][1][m][1] * r;
                    const f32x4 o1a = x1a * c0 - x2a * s0, o1b = x1b * c1 - x2b * s1, o2a = x2a * c0 + x1a * s0, o2b = x2b * c1 + x1b * s1;
                    cs[0] += o1a; cs[1] += o1b; cs[2] += o2a; cs[3] += o2b;
                    ow[mm][0] = pack8f(o1a, o1b); ow[mm][1] = pack8f(o2a, o2b); }
                if (am < 3) { const int an = am + 1, ai2 = an >> 1, m2 = (an & 1) * 2;
#pragma unroll
                    for (int mm = 0; mm < 2; ++mm) { const int pos = (rowb + ai2 * HALF + (m2 + mm) * 16) & (SEQ - 1);
                        tc[bf ^ 1][mm][0] = *(const f32x4*)(rc + pos * 64 + dd0); tc[bf ^ 1][mm][1] = *(const f32x4*)(rc + pos * 64 + dd0 + 4); ts[bf ^ 1][mm][0] = *(const f32x4*)(rsn + pos * 64 + dd0); ts[bf ^ 1][mm][1] = *(const f32x4*)(rsn + pos * 64 + dd0 + 4); } }
#pragma unroll
                for (int mm = 0; mm < 2; ++mm) { const int row = rowb + ai * HALF + (m0 + mm) * 16;
                    bf16_t* p = dst + (size_t)row * AW + head * HD + dd0;
                    *(u32x4*)p = ow[mm][0];
                    *(u32x4*)(p + 64) = ow[mm][1]; } }
            if (pn >= 8) {
#pragma unroll
                for (int q = 0; q < 4; ++q)
#pragma unroll
                    for (int j = 0; j < 4; ++j) { float v = cs[q][j]; v += __shfl_xor(v, 1); v += __shfl_xor(v, 2); v += __shfl_xor(v, 4); v += __shfl_xor(v, 8); cs[q][j] = v; }
                if (fr == 0) { float* kp = kmpart + (((size_t)un.pm * NH + head) * 2 + wr) * HD + dd0;
                    *(f32x4*)kp = cs[0]; *(f32x4*)(kp + 4) = cs[1]; *(f32x4*)(kp + 64) = cs[2]; *(f32x4*)(kp + 68) = cs[3]; } }
        } else if (MODE == 1 && pn < 24) {
            const int col0 = (pn - 16) * BM + wc * 32 + 8 * fq;
#pragma unroll
            for (int ai = 0; ai < 2; ++ai)
#pragma unroll
                for (int m = 0; m < 4; ++m) { const int row = rowb + ai * HALF + m * 16; const float r = rsc[ai][m];
#pragma unroll
                    for (int bj = 0; bj < 2; ++bj) *(u32x4*)(V + (size_t)row * AW + col0 + bj * HALF) = pack8f(acc[ai][bj][m][0] * r, acc[ai][bj][m][1] * r); }
        } else if (MODE == 0 && pn < 40) {
            bf16_t* dst = pn < 32 ? U : VS; const int col0 = ((pn - 24) & 7) * BM + wc * 32 + 8 * fq;
#pragma unroll
            for (int ai = 0; ai < 2; ++ai)
#pragma unroll
                for (int m = 0; m < 4; ++m) { const int row = rowb + ai * HALF + m * 16; const float r = rsc[ai][m];
                    float s1 = 0.f, s2 = 0.f;
#pragma unroll
                    for (int bj = 0; bj < 2; ++bj) { const f32x4 g0 = gelu4(acc[ai][bj][m][0] * r), g1 = gelu4(acc[ai][bj][m][1] * r);
                        *(u32x4*)(dst + (size_t)row * SW + col0 + bj * HALF) = pack8f(g0, g1);
                        s1 += (g0[0] + g0[1]) + (g0[2] + g0[3]) + (g1[0] + g1[1]) + (g1[2] + g1[3]);
                        s2 += (g0[0] * g0[0] + g0[1] * g0[1]) + (g0[2] * g0[2] + g0[3] * g0[3]) + (g1[0] * g1[0] + g1[1] * g1[1]) + (g1[2] * g1[2] + g1[3] * g1[3]); }
                    if (pn >= 32) {
                        s1 += __shfl_xor(s1, 16); s1 += __shfl_xor(s1, 32); s2 += __shfl_xor(s2, 16); s2 += __shfl_xor(s2, 32);
                        if (fq == 0) { atomicAdd(lnstat + 2 * row, (unsigned long long)(long long)__builtin_rintf(s1 * SSQ_SCALE)); atomicAdd(lnstat + 2 * row + 1, (unsigned long long)(long long)__builtin_rintf(s2 * SSQ_SCALE)); } } }
        } else if (MODE == 1) {
            unsigned char* dst = (pn < 56 ? SA : SB) + ((size_t)(un.pm * 16 + ((pn - 40) & 15)) * 8) * 8192 + (size_t)(wr * 4 + wc) * 1024 + (fq * 16 + fr) * 16;
#pragma unroll
            for (int ai = 0; ai < 2; ++ai)
#pragma unroll
                for (int m = 0; m < 4; ++m) { const float r = rsc[ai][m]; u32x4 w;
#pragma unroll
                    for (int bj = 0; bj < 2; ++bj) { const f32x4 s0 = sigm4(acc[ai][bj][m][0] * r) * 255.f + 0.5f, s1 = sigm4(acc[ai][bj][m][1] * r) * 255.f + 0.5f;
                        const unsigned lo = (unsigned)s0[0] | ((unsigned)s0[1] << 8) | ((unsigned)s0[2] << 16) | ((unsigned)s0[3] << 24), hi_ = (unsigned)s1[0] | ((unsigned)s1[1] << 8) | ((unsigned)s1[2] << 16) | ((unsigned)s1[3] << 24);
                        if (bj == 0) { w.x = lo; w.y = hi_; } else { w.z = lo; w.w = hi_; } }
                    *(u32x4*)(dst + (size_t)(ai * 4 + m) * 8192) = w; }
        }
    }
};
struct EpiPart {
    static constexpr bool PERM = true, AFTER_DRAIN = false;
    float* P;
    __device__ __forceinline__ bool keep(const Unit&) const { return false; }
    __device__ __forceinline__ void operator()(f32x4 (&acc)[2][2][4][2], const Unit& un, int wr, int wc, int fr, int fq) const {
        const int rowb = un.pm * BM + wr * 64 + fr, col0 = un.pn * BM + wc * 32 + 8 * fq; float* base = P + (size_t)(un.ko >> 9) * (BATCH * NMEM * 2 * XW);
#pragma unroll
        for (int ai = 0; ai < 2; ++ai)
#pragma unroll
            for (int m = 0; m < 4; ++m)
#pragma unroll
                for (int bj = 0; bj < 2; ++bj) { float* p = base + (size_t)(rowb + ai * HALF + m * 16) * (2 * XW) + col0 + bj * HALF; *(f32x4*)p = acc[ai][bj][m][0]; *(f32x4*)(p + 4) = acc[ai][bj][m][1]; }
    }
};
struct EpiScale {
    static constexpr bool PERM = true, AFTER_DRAIN = false;
    const ssq_t* ssq; bf16_t* O; int ldc;
    __device__ __forceinline__ bool keep(const Unit&) const { return false; }
    __device__ __forceinline__ void operator()(f32x4 (&acc)[2][2][4][2], const Unit& un, int wr, int wc, int fr, int fq) const {
        const int rowb = un.pm * BM + wr * 64 + fr, col0 = un.pn * BM + wc * 32 + 8 * fq;
        float rsc[2][4];
#pragma unroll
        for (int ai = 0; ai < 2; ++ai)
#pragma unroll
            for (int m = 0; m < 4; ++m) rsc[ai][m] = ssq ? rs_of(ssq, rowb + ai * HALF + m * 16) : 1.f;
#pragma unroll
        for (int ai = 0; ai < 2; ++ai)
#pragma unroll
            for (int m = 0; m < 4; ++m) { const int row = rowb + ai * HALF + m * 16; const float r = rsc[ai][m];
#pragma unroll
                for (int bj = 0; bj < 2; ++bj) *(u32x4*)(O + (size_t)row * ldc + col0 + bj * HALF) = pack8f(acc[ai][bj][m][0] * r, acc[ai][bj][m][1] * r); }
    }
};
template <int BR> struct EpiBranch {
    static constexpr bool PERM = true, AFTER_DRAIN = false;
    const unsigned char* S8; bf16_t* O;
    __device__ __forceinline__ bool keep(const Unit&) const { return false; }
    static __device__ __forceinline__ f32x4 ub4(unsigned w) { return (f32x4){(float)(w & 255u), (float)((w >> 8) & 255u), (float)((w >> 16) & 255u), (float)(w >> 24)}; }
    __device__ __forceinline__ void operator()(f32x4 (&acc)[2][2][4][2], const Unit& un, int wr, int wc, int fr, int fq) const {
        asm volatile("" : "+v"(fr), "+v"(fq));
        const int rowb = un.pm * BM + wr * 64 + fr, col0 = un.pn * BM + wc * 32 + 8 * fq;
        const size_t goff = ((size_t)(un.pm * 16 + un.pn) * 8) * 8192 + (size_t)(wr * 4 + wc) * 1024 + (fq * 16 + fr) * 16;
        constexpr float SC = (BR == 0 ? ACCA_SCALE : 1.f) * (1.f / 255.f);
        u32x4 wgs[2][4], pw[2][4][2];
#pragma unroll
        for (int m = 0; m < 4; ++m) { wgs[0][m] = *(const u32x4*)(S8 + goff + (size_t)m * 8192);
            if (BR == 1) {
#pragma unroll
                for (int bj = 0; bj < 2; ++bj) pw[0][m][bj] = *(const u32x4*)(O + (size_t)(rowb + m * 16) * DM + col0 + bj * HALF); } }
#pragma unroll
        for (int ai = 0; ai < 2; ++ai) {
            u32x4 ow[4][2];
#pragma unroll
            for (int m = 0; m < 4; ++m) { const u32x4 wg = wgs[ai][m];
#pragma unroll
                for (int bj = 0; bj < 2; ++bj) { f32x4 v0 = ub4(bj ? wg.z : wg.x) * SC * acc[ai][bj][m][0], v1 = ub4(bj ? wg.w : wg.y) * SC * acc[ai][bj][m][1];
                    if (BR == 1) { f32x4 p0, p1; unpack8(pw[ai][m][bj], p0, p1); v0 += p0; v1 += p1; }
                    ow[m][bj] = pack8f(v0, v1); } }
            if (ai == 0) {
#pragma unroll
                for (int m = 0; m < 4; ++m) { wgs[1][m] = *(const u32x4*)(S8 + goff + (size_t)(4 + m) * 8192);
                    if (BR == 1) {
#pragma unroll
                        for (int bj = 0; bj < 2; ++bj) pw[1][m][bj] = *(const u32x4*)(O + (size_t)(rowb + HALF + m * 16) * DM + col0 + bj * HALF); } } }
#pragma unroll
            for (int m = 0; m < 4; ++m) { const size_t off = (size_t)(rowb + ai * HALF + m * 16) * DM + col0;
#pragma unroll
                for (int bj = 0; bj < 2; ++bj) *(u32x4*)(O + off + bj * HALF) = ow[m][bj]; } }
    }
};
struct EpiResid {
    static constexpr bool PERM = true, AFTER_DRAIN = false;
    const float* basef; const bf16_t* baseb; bf16_t* xb; ssq_t* ssq;
    __device__ __forceinline__ bool keep(const Unit&) const { return false; }
    __device__ __forceinline__ void operator()(f32x4 (&acc)[2][2][4][2], const Unit& un, int wr, int wc, int fr, int fq) const {
        const int rowb = un.pm * BM + wr * 64 + fr, col0 = un.pn * BM + wc * 32 + 8 * fq;
        u32x4 bw[2][4][2];
#pragma unroll
        for (int m = 0; m < 4; ++m)
#pragma unroll
            for (int bj = 0; bj < 2; ++bj) bw[0][m][bj] = *(const u32x4*)(baseb + (size_t)(rowb + m * 16) * DM + col0 + bj * HALF);
#pragma unroll
        for (int ai = 0; ai < 2; ++ai) {
            u32x4 ow[4][2]; float ssv[4];
#pragma unroll
            for (int m = 0; m < 4; ++m) { float ss = 0.f;
#pragma unroll
                for (int bj = 0; bj < 2; ++bj) { f32x4 b0, b1; unpack8(bw[ai][m][bj], b0, b1);
                    const f32x4 v0 = acc[ai][bj][m][0] + b0, v1 = acc[ai][bj][m][1] + b1;
                    ow[m][bj] = pack8f(v0, v1);
                    ss += (v0[0] * v0[0] + v0[1] * v0[1]) + (v0[2] * v0[2] + v0[3] * v0[3]) + (v1[0] * v1[0] + v1[1] * v1[1]) + (v1[2] * v1[2] + v1[3] * v1[3]); }
                ss += __shfl_xor(ss, 16); ss += __shfl_xor(ss, 32); ssv[m] = ss; }
            if (ai == 0) {
#pragma unroll
                for (int m = 0; m < 4; ++m)
#pragma unroll
                    for (int bj = 0; bj < 2; ++bj) bw[1][m][bj] = *(const u32x4*)(baseb + (size_t)(rowb + HALF + m * 16) * DM + col0 + bj * HALF); }
#pragma unroll
            for (int m = 0; m < 4; ++m) { const int row = rowb + ai * HALF + m * 16; const size_t off = (size_t)row * DM + col0;
#pragma unroll
                for (int bj = 0; bj < 2; ++bj) *(u32x4*)(xb + off + bj * HALF) = ow[m][bj];
                if (fq == 0) atomicAdd(ssq + row, (ssq_t)(ssv[m] * SSQ_SCALE + 0.5f)); } }
    }
};
struct EpiGU {
    static constexpr bool PERM = true, AFTER_DRAIN = false;
    const ssq_t* ssq; bf16_t* O;
    __device__ __forceinline__ bool keep(const Unit&) const { return false; }
    __device__ __forceinline__ void operator()(f32x4 (&acc)[2][2][4][2], const Unit& un, int wr, int wc, int fr, int fq) const {
        const int rowb = un.pm * BM + wr * 64 + fr, col0 = un.pn * HALF + wc * 32 + 8 * fq;
        float rsc[2][4];
#pragma unroll
        for (int ai = 0; ai < 2; ++ai)
#pragma unroll
            for (int m = 0; m < 4; ++m) rsc[ai][m] = rs_of(ssq, rowb + ai * HALF + m * 16);
#pragma unroll
        for (int ai = 0; ai < 2; ++ai)
#pragma unroll
            for (int m = 0; m < 4; ++m) { const int row = rowb + ai * HALF + m * 16; const float r = rsc[ai][m];
                f32x4 o[2];
#pragma unroll
                for (int n = 0; n < 2; ++n) { const f32x4 g = acc[ai][0][m][n] * r, u = acc[ai][1][m][n] * r;
#pragma unroll
                    for (int j = 0; j < 4; ++j) o[n][j] = g[j] * sigmoidf_(g[j]) * u[j]; }
                *(u32x4*)(O + (size_t)row * DFF + col0) = pack8f(o[0], o[1]); }
    }
};

template <bool F8> struct Frag { bf16x8 k[2]; };
template <> struct Frag<true> { i32x8v v; };
template <class Epi, class Sched, bool ALIGN_EPI = false, bool SP2 = false, bool F8 = false>
__device__ __forceinline__ void gemm_phase(LAS unsigned char* lds, const Gemm g, const Sched& S, const Epi& E) {
    int tid = threadIdx.x; asm volatile("" : "+v"(tid));
    const int wid = __builtin_amdgcn_readfirstlane(tid >> 6), lane = tid & 63, wr = wid >> 2, wc = wid & 3, fr = lane & 15, fq = lane >> 4;
    const int K = g.K, nt = K / BK, ld = g.ld;
    unsigned voffA[2], voffB[2];
#pragma unroll
    for (int i = 0; i < 2; ++i) { int R, C; stage_rc(tid * 16 + i * 8192, R, C); const int Rb = Epi::PERM ? ((R & ~31) + perm32(R & 31)) : R;
        voffA[i] = (unsigned)(R * ld + C) * 2u; voffB[i] = (unsigned)(Rb * ld + C) * 2u; }
    const size_t kstep = (size_t)(BK * 2);
    const size_t hstep = (size_t)HALF * ld * 2;
    const size_t tstep = 2 * hstep;
    const unsigned ldsw = (unsigned)wid * 1024u;
    const int aoff = lds_byte(wr * 64 + fr, fq * 8), boff = lds_byte(wc * 32 + fr, fq * 8);
#define PG8_SA(b, h) (((b) * 2 + (h)) * HTB)
#define PG8_SB(b, h) ((4 + (b) * 2 + (h)) * HTB)
#define PG8_STAGE(bufoff, gbase, voff) do { _Pragma("unroll") for (int _i = 0; _i < 2; ++_i) \
        __builtin_amdgcn_global_load_lds((const unsigned*)((const char*)(gbase) + (voff)[_i]), (LAS unsigned*)(lds + (bufoff) + ldsw + _i * 8192), 16, 0, 0); } while (0)
#define PG8_LDF(dst, addr) do { if constexpr (F8) { dst.v.lo = *(const LAS i32x4v*)(addr); dst.v.hi = *(const LAS i32x4v*)((addr) + 1024); } else { dst.k[0] = *(const LAS bf16x8*)(addr); dst.k[1] = *(const LAS bf16x8*)((addr) + 1024); } } while (0)
#define PG8_LDA(dst, b, h) do { _Pragma("unroll") for (int m = 0; m < 4; ++m) PG8_LDF(dst[m], lds + PG8_SA(b, h) + aoff + m * 2048); } while (0)
#define PG8_LDB(dst, b, h) do { _Pragma("unroll") for (int n = 0; n < 2; ++n) PG8_LDF(dst[n], lds + PG8_SB(b, h) + boff + n * 2048); } while (0)
#define PG8_MMA(ai, bj, At, Bt) do { __builtin_amdgcn_s_setprio(1); _Pragma("unroll") for (int m = 0; m < 4; ++m) _Pragma("unroll") for (int n = 0; n < 2; ++n) { \
        if constexpr (F8) asm volatile("v_mfma_f32_16x16x128_f8f6f4 %0, %1, %2, %0" : "+v"(acc[ai][bj][m][n]) : "v"(Bt[n].v), "v"(At[m].v));     \
        else { _Pragma("unroll") for (int k = 0; k < 2; ++k) acc[ai][bj][m][n] = __builtin_amdgcn_mfma_f32_16x16x32_bf16(Bt[n].k[k], At[m].k[k], acc[ai][bj][m][n], 0, 0, 0); } } \
        __builtin_amdgcn_s_setprio(0); } while (0)
#define PG8_WAIT_V(n) asm volatile("s_waitcnt vmcnt(" #n ")" ::: "memory")
#define PG8_WAIT_L(n) asm volatile("s_waitcnt lgkmcnt(" #n ")" ::: "memory")
#define PG8_BAR __builtin_amdgcn_s_barrier()
#define PG8_SCHED __builtin_amdgcn_sched_barrier(0)
    Unit cur, nxt; int ui = 0;
    if (!S.next(0, cur)) return;
    f32x4 acc[2][2][4][2];
#pragma unroll
    for (int a = 0; a < 2; ++a)
#pragma unroll
        for (int b = 0; b < 2; ++b)
#pragma unroll
            for (int m = 0; m < 4; ++m)
#pragma unroll
                for (int n = 0; n < 2; ++n) acc[a][b][m][n] = (f32x4){0.f, 0.f, 0.f, 0.f};
    Frag<F8> At[4], B0[2], B1[2];
    const char* cA = (const char*)g.A + (size_t)cur.pm * tstep + (size_t)cur.ko * 2; const char* cB = (const char*)g.Bt + (size_t)cur.pn * tstep + (size_t)cur.ko * 2;
    S.a_ready(cur);
    if constexpr (SP2) {
        PG8_STAGE(PG8_SB(0, 0), cB, voffB); PG8_STAGE(PG8_SB(0, 1), cB + hstep, voffB); PG8_STAGE(PG8_SA(0, 0), cA, voffA); PG8_STAGE(PG8_SA(0, 1), cA + hstep, voffA);
        if (wr == 1) PG8_BAR;
        PG8_WAIT_V(2); PG8_BAR;
        PG8_STAGE(PG8_SB(1, 0), cB + kstep, voffB); PG8_STAGE(PG8_SA(1, 0), cA + kstep, voffA); PG8_STAGE(PG8_SB(1, 1), cB + hstep + kstep, voffB);
        PG8_WAIT_V(6); PG8_BAR;
    } else {
        PG8_STAGE(PG8_SB(0, 0), cB, voffB); PG8_STAGE(PG8_SA(0, 0), cA, voffA); PG8_STAGE(PG8_SB(0, 1), cB + hstep, voffB); PG8_STAGE(PG8_SA(0, 1), cA + hstep, voffA);
        if (wr == 1) PG8_BAR;
        PG8_WAIT_V(4); PG8_BAR;
        PG8_STAGE(PG8_SB(1, 0), cB + kstep, voffB); PG8_STAGE(PG8_SA(1, 0), cA + kstep, voffA); PG8_STAGE(PG8_SB(1, 1), cB + hstep + kstep, voffB);
        PG8_WAIT_V(6); PG8_BAR;
    }
    for (;;) {
        const bool has_next = S.next(ui + 1, nxt);
        const char* nA = has_next ? (const char*)g.A + (size_t)nxt.pm * tstep + (size_t)nxt.ko * 2 : cA; const char* nB = has_next ? (const char*)g.Bt + (size_t)nxt.pn * tstep + (size_t)nxt.ko * 2 : cB;
        for (int t = 0; t < nt; t += 2) {
            const bool last = (t == nt - 2);
            const char* a1 = cA + (size_t)(t + 1) * kstep;
            const char* a2 = last ? nA : cA + (size_t)(t + 2) * kstep; const char* b2 = last ? nB : cB + (size_t)(t + 2) * kstep;
            const char* a3 = a2 + kstep; const char* b3 = b2 + kstep;
            if (last && has_next) S.a_ready(nxt);
            if constexpr (SP2) {
            PG8_LDB(B0, 0, 0); PG8_LDB(B1, 0, 1); PG8_SCHED; PG8_LDA(At, 0, 0); PG8_STAGE(PG8_SA(1, 1), a1 + hstep, voffA);
            PG8_WAIT_V(8); PG8_WAIT_L(0); PG8_BAR; PG8_MMA(0, 0, At, B0); PG8_MMA(0, 1, At, B1); PG8_BAR; PG8_SCHED;
            PG8_LDA(At, 0, 1); PG8_STAGE(PG8_SB(0, 0), b2, voffB); PG8_STAGE(PG8_SB(0, 1), b2 + hstep, voffB); PG8_STAGE(PG8_SA(0, 0), a2, voffA);
            PG8_WAIT_V(8); PG8_WAIT_L(0); PG8_BAR; PG8_MMA(1, 0, At, B0); PG8_MMA(1, 1, At, B1); PG8_BAR; PG8_SCHED;
            PG8_LDB(B0, 1, 0); PG8_LDB(B1, 1, 1); PG8_SCHED; PG8_LDA(At, 1, 0); PG8_STAGE(PG8_SA(0, 1), a2 + hstep, voffA);
            PG8_WAIT_V(8); PG8_WAIT_L(0); PG8_BAR; PG8_MMA(0, 0, At, B0); PG8_MMA(0, 1, At, B1); PG8_BAR; PG8_SCHED;
            PG8_LDA(At, 1, 1); PG8_STAGE(PG8_SB(1, 0), b3, voffB); PG8_STAGE(PG8_SB(1, 1), b3 + hstep, voffB); PG8_STAGE(PG8_SA(1, 0), a3, voffA);
            PG8_WAIT_V(8); PG8_WAIT_L(0); PG8_BAR; PG8_MMA(1, 0, At, B0); PG8_MMA(1, 1, At, B1); PG8_BAR; PG8_SCHED;
            } else {
            PG8_LDB(B0, 0, 0); PG8_SCHED; PG8_LDA(At, 0, 0); PG8_STAGE(PG8_SA(1, 1), a1 + hstep, voffA);
            PG8_WAIT_L(8); PG8_BAR; PG8_WAIT_L(0); PG8_MMA(0, 0, At, B0); PG8_BAR; PG8_SCHED;
            PG8_LDB(B1, 0, 1); PG8_STAGE(PG8_SB(0, 0), b2, voffB);
            PG8_BAR; PG8_WAIT_L(0); PG8_MMA(0, 1, At, B1); PG8_BAR;
            PG8_LDA(At, 0, 1); PG8_STAGE(PG8_SA(0, 0), a2, voffA);
            PG8_BAR; PG8_WAIT_L(0); PG8_MMA(1, 0, At, B0); PG8_BAR; PG8_SCHED;
            PG8_STAGE(PG8_SB(0, 1), b2 + hstep, voffB);
            PG8_WAIT_V(6); PG8_BAR; PG8_MMA(1, 1, At, B1); PG8_BAR;
            PG8_LDB(B0, 1, 0); PG8_SCHED; PG8_LDA(At, 1, 0); PG8_STAGE(PG8_SA(0, 1), a2 + hstep, voffA);
            PG8_WAIT_L(8); PG8_BAR; PG8_WAIT_L(0); PG8_MMA(0, 0, At, B0); PG8_BAR; PG8_SCHED;
            PG8_LDB(B1, 1, 1); PG8_STAGE(PG8_SB(1, 0), b3, voffB);
            PG8_BAR; PG8_WAIT_L(0); PG8_MMA(0, 1, At, B1); PG8_BAR;
            PG8_LDA(At, 1, 1); PG8_STAGE(PG8_SA(1, 0), a3, voffA);
            PG8_BAR; PG8_WAIT_L(0); PG8_MMA(1, 0, At, B0); PG8_BAR; PG8_SCHED;
            PG8_STAGE(PG8_SB(1, 1), b3 + hstep, voffB);
            PG8_WAIT_V(6); PG8_BAR; PG8_MMA(1, 1, At, B1); PG8_BAR;
            }
        }
        if constexpr (ALIGN_EPI) { if (wr == 0) PG8_BAR; }
        if constexpr (F8) asm volatile("s_nop 15\n\ts_nop 15" ::: "memory");
        E(acc, cur, wr, wc, fr, fq); S.done(cur);
        if (!has_next) break;
        if (!E.keep(cur)) {
#pragma unroll
        for (int a = 0; a < 2; ++a)
#pragma unroll
            for (int b = 0; b < 2; ++b)
#pragma unroll
                for (int m = 0; m < 4; ++m)
#pragma unroll
                    for (int n = 0; n < 2; ++n) acc[a][b][m][n] = (f32x4){0.f, 0.f, 0.f, 0.f};
        }
        cur = nxt; cA = nA; cB = nB; ++ui;
        if constexpr (ALIGN_EPI) { if (wr == 1) PG8_BAR; }
    }
    PG8_WAIT_V(0);
    if constexpr (!ALIGN_EPI) { if (wr == 0) PG8_BAR; }
    PG8_BAR;
#undef PG8_SA
#undef PG8_SB
#undef PG8_STAGE
#undef PG8_LDA
#undef PG8_LDB
#undef PG8_MMA
#undef PG8_WAIT_V
#undef PG8_WAIT_L
#undef PG8_BAR
#undef PG8_SCHED
}
}

namespace att {
constexpr int D = 128, NW = 8, QBLK = 32, KVBLK = 64, QB = NW * QBLK;
constexpr int SHM_V = KVBLK * D * 2, SHM_K = KVBLK * D * 2;
constexpr int LDS_BYTES = 2 * SHM_V + 2 * SHM_K + NW * 64 * 4;
constexpr float SCALE = 0.08838834764831845f, THR = 8.f;
#define KSWZ(row, colB) ((row) * 256 + ((colB) ^ (((row) & 7) << 4)))
#define SBAR() __builtin_amdgcn_sched_barrier(0)
__device__ __forceinline__ int v_st(int k, int c) { const int kk = (k & ~0xC) | ((k & 4) << 1) | ((k & 8) >> 1); return ((kk >> 3) * 4 + (c >> 5)) * 512 + ((kk & 7) * 32 + (c & 31)) * 2; }
__device__ __forceinline__ int v_rd_base(int lane) { return ((lane & 3) << 3) | (((lane >> 2) & 3) << 6) | (((lane >> 4) & 1) << 5) | (((lane >> 5) & 1) << 8); }
constexpr int v_rd_off(int d0, int ks, int half) { return d0 * 512 + ks * 4096 + half * 2048; }
__device__ __forceinline__ int crow(int r, int hi) { return (r & 3) + 8 * (r >> 2) + 4 * hi; }
__device__ __forceinline__ unsigned cvtpk(float lo, float hi) { return cvt_pk_bf16(lo, hi); }
__device__ __forceinline__ bf16x8 load8(const bf16_t* p) { return *reinterpret_cast<const bf16x8*>(p); }
__device__ __forceinline__ void mask_tile(f32x16& p0, f32x16& p1, int dq) {
    const float NEG = -__builtin_inff();
#pragma unroll
    for (int r = 0; r < 16; ++r) {
        const int c = (r & 3) + 8 * (r >> 2);
        if (dq - c < 0) p0[r] = NEG;
        if (dq - c - 32 < 0) p1[r] = NEG;
    }
}
__device__ __forceinline__ void partialSM(f32x16& p0, f32x16& p1, float& m_reg, float& mn, float& alpha, bool ract) {
    float pmax = p0[0];
#pragma unroll
    for (int r = 1; r < 16; ++r) pmax = fmaxf(pmax, p0[r]);
#pragma unroll
    for (int r = 0; r < 16; ++r) pmax = fmaxf(pmax, p1[r]);
    { auto rr = __builtin_amdgcn_permlane32_swap(__float_as_uint(pmax), __float_as_uint(pmax), false, false);
      pmax = fmaxf(__uint_as_float(rr[0]), __uint_as_float(rr[1])); }
    pmax = ract ? pmax : -__builtin_inff();
    constexpr float C2 = 1.4426950408889634f * SCALE;
    if (__builtin_expect(__all((pmax - m_reg) * SCALE <= THR), 1)) { mn = m_reg; alpha = 1.f; }
    else { mn = fmaxf(m_reg, pmax); alpha = __builtin_amdgcn_exp2f((m_reg - mn) * C2); m_reg = mn; }
    const float mnL = ract ? -mn * C2 : -__builtin_inff();
#pragma unroll
    for (int r = 0; r < 16; ++r) p0[r] = fmaf(p0[r], C2, mnL);
#pragma unroll
    for (int r = 0; r < 16; ++r) p1[r] = fmaf(p1[r], C2, mnL);
#pragma unroll
    for (int r = 0; r < 16; ++r) p0[r] = __builtin_amdgcn_exp2f(p0[r]);
}
__device__ __forceinline__ void finishSM(f32x16& p0, f32x16& p1, float alpha, float& l_reg, bf16x8& pa0, bf16x8& pa1, bf16x8& pa2, bf16x8& pa3) {
#pragma unroll
    for (int r = 0; r < 16; ++r) p1[r] = __builtin_amdgcn_exp2f(p1[r]);
    float ps = 0;
#pragma unroll
    for (int r = 0; r < 16; ++r) ps += p0[r];
#pragma unroll
    for (int r = 0; r < 16; ++r) ps += p1[r];
    { auto rr = __builtin_amdgcn_permlane32_swap(__float_as_uint(ps), __float_as_uint(ps), false, false);
      ps = __uint_as_float(rr[0]) + __uint_as_float(rr[1]); }
    l_reg = l_reg * alpha + ps;
#define PK4(P, B_, OUT) do { unsigned a0 = cvtpk(P[B_+0], P[B_+1]), a1 = cvtpk(P[B_+2], P[B_+3]);                          \
        unsigned b0 = cvtpk(P[B_+4], P[B_+5]), b1 = cvtpk(P[B_+6], P[B_+7]);                                             \
        auto r0 = __builtin_amdgcn_permlane32_swap(a0, b0, false, false); auto r1 = __builtin_amdgcn_permlane32_swap(a1, b1, false, false); \
        u32x4 w = {r0[0], r1[0], r0[1], r1[1]}; OUT = *reinterpret_cast<bf16x8*>(&w); } while (0)
    PK4(p0, 0, pa0); PK4(p0, 8, pa1); PK4(p1, 0, pa2); PK4(p1, 8, pa3);
#undef PK4
}
template <int KB>
__device__ __forceinline__ void qkt(f32x16& p0, f32x16& p1, const char* K_lds, int r32, int hi, const bf16x8* qr) {
    p0 = f32x16{}; p1 = f32x16{};
    const char* kb[4];
#pragma unroll
    for (int dd = 0; dd < 4; ++dd) kb[dd] = K_lds + KB * SHM_K + KSWZ(r32, (dd * 16 + hi * 8) * 2);
#pragma unroll
    for (int d0 = 0; d0 < 8; ++d0) { const char* a = kb[d0 & 3] + (d0 >> 2) * 128;
        bf16x8 b0 = *reinterpret_cast<const bf16x8*>(a);
        bf16x8 b1 = *reinterpret_cast<const bf16x8*>(a + 32 * 256);
        p0 = __builtin_amdgcn_mfma_f32_32x32x16_bf16(b0, qr[d0], p0, 0, 0, 0);
        p1 = __builtin_amdgcn_mfma_f32_32x32x16_bf16(b1, qr[d0], p1, 0, 0, 0); }
}
template <int VOFF>
__device__ __forceinline__ void pv_tile(f32x16* o, int vb0, bf16x8 pa0, bf16x8 pa1, bf16x8 pa2, bf16x8 pa3) {
#define TRRD(dst, off) asm volatile("ds_read_b64_tr_b16 %0, %1 offset:%2" : "=&v"(dst) : "v"(vb0), "i"(off) : "memory")
#define PV_D0(d0) do { s16x4 l0, l1, l2, l3, h0, h1, h2, h3; constexpr int b_ = VOFF + v_rd_off(d0, 0, 0); \
        TRRD(l0, b_); TRRD(h0, b_ + 2048); TRRD(l1, b_ + 4096); TRRD(h1, b_ + 6144); TRRD(l2, b_ + 8192); TRRD(h2, b_ + 10240); TRRD(l3, b_ + 12288); TRRD(h3, b_ + 14336); \
        asm volatile("s_waitcnt lgkmcnt(0)" ::: "memory"); SBAR();   \
        o[d0] = __builtin_amdgcn_mfma_f32_32x32x16_bf16(pa0, (bf16x8){l0[0], l0[1], l0[2], l0[3], h0[0], h0[1], h0[2], h0[3]}, o[d0], 0, 0, 0);   \
        o[d0] = __builtin_amdgcn_mfma_f32_32x32x16_bf16(pa1, (bf16x8){l1[0], l1[1], l1[2], l1[3], h1[0], h1[1], h1[2], h1[3]}, o[d0], 0, 0, 0);   \
        o[d0] = __builtin_amdgcn_mfma_f32_32x32x16_bf16(pa2, (bf16x8){l2[0], l2[1], l2[2], l2[3], h2[0], h2[1], h2[2], h2[3]}, o[d0], 0, 0, 0);   \
        o[d0] = __builtin_amdgcn_mfma_f32_32x32x16_bf16(pa3, (bf16x8){l3[0], l3[1], l3[2], l3[3], h3[0], h3[1], h3[2], h3[3]}, o[d0], 0, 0, 0); } while (0)
    PV_D0(0); PV_D0(1); PV_D0(2); PV_D0(3);
#undef PV_D0
#undef TRRD
}
template <int VOFF>
__device__ __forceinline__ void pv_tile_T(f32x16* o, int vb0, bf16x8 pa0, bf16x8 pa1, bf16x8 pa2, bf16x8 pa3) {
#define TRRD(dst, off) asm volatile("ds_read_b64_tr_b16 %0, %1 offset:%2" : "=&v"(dst) : "v"(vb0), "i"(off) : "memory")
#define PV_D0(d0) do { s16x4 l0, l1, l2, l3, h0, h1, h2, h3; constexpr int b_ = VOFF + v_rd_off(d0, 0, 0); \
        TRRD(l0, b_); TRRD(h0, b_ + 2048); TRRD(l1, b_ + 4096); TRRD(h1, b_ + 6144); TRRD(l2, b_ + 8192); TRRD(h2, b_ + 10240); TRRD(l3, b_ + 12288); TRRD(h3, b_ + 14336); \
        asm volatile("s_waitcnt lgkmcnt(0)" ::: "memory"); SBAR();   \
        o[d0] = __builtin_amdgcn_mfma_f32_32x32x16_bf16((bf16x8){l0[0], l0[1], l0[2], l0[3], h0[0], h0[1], h0[2], h0[3]}, pa0, o[d0], 0, 0, 0);   \
        o[d0] = __builtin_amdgcn_mfma_f32_32x32x16_bf16((bf16x8){l1[0], l1[1], l1[2], l1[3], h1[0], h1[1], h1[2], h1[3]}, pa1, o[d0], 0, 0, 0);   \
        o[d0] = __builtin_amdgcn_mfma_f32_32x32x16_bf16((bf16x8){l2[0], l2[1], l2[2], l2[3], h2[0], h2[1], h2[2], h2[3]}, pa2, o[d0], 0, 0, 0);   \
        o[d0] = __builtin_amdgcn_mfma_f32_32x32x16_bf16((bf16x8){l3[0], l3[1], l3[2], l3[3], h3[0], h3[1], h3[2], h3[3]}, pa3, o[d0], 0, 0, 0); } while (0)
    PV_D0(0); PV_D0(1); PV_D0(2); PV_D0(3);
#undef PV_D0
#undef TRRD
}
struct BlockRef { const bf16_t* Q; const bf16_t* K; const bf16_t* V; bf16_t* O; int P0; int jlo; const unsigned* sel; float* lse; };
struct Seam { bf16x8 qr[8]; bf16x8 st_v0, st_v1, st_k0, st_k1; };
#define ROW(p, k0, rr) ((p) + (size_t)((k0) + (rr)) * KP + sc)
#define VMW() asm volatile("s_waitcnt vmcnt(0)" ::: "memory")
#define VMWN(n) asm volatile("s_waitcnt vmcnt(%0)" :: "i"(n) : "memory")
#define SLOAD_H(Kp, Vp, k0) do { S.st_v0 = load8(ROW(Vp, k0, sr)); S.st_v1 = load8(ROW(Vp, k0, 32 + sr));              \
                         S.st_k0 = load8(ROW(Kp, k0, sr)); S.st_k1 = load8(ROW(Kp, k0, 32 + sr)); } while (0)
#define SWRITE_HK(bf) do { *(bf16x8*)(K_lds + (bf) * SHM_K + kws) = S.st_k0; *(bf16x8*)(K_lds + (bf) * SHM_K + kws + 32 * 256) = S.st_k1; } while (0)
#define SWRITE_HV(bf) do { *(bf16x8*)(V_lds + (bf) * SHM_V + vst0) = S.st_v0; *(bf16x8*)(V_lds + (bf) * SHM_V + vst1) = S.st_v1; } while (0)
#define SWRITE_H(bf) do { SWRITE_HV(bf); SWRITE_HK(bf); } while (0)
template <int QP, int KP>
__device__ __forceinline__ void prime(const BlockRef& cur, char* lds, Seam& S) {
    int tid = threadIdx.x; asm volatile("" : "+v"(tid)); const int wid = __builtin_amdgcn_readfirstlane(tid >> 6), lane = tid & 63, r32 = lane & 31, hi = lane >> 5;
    const int sr = tid >> 4, sc = (tid & 15) * 8, kws = KSWZ(sr, sc * 2); char* K_lds = lds + 2 * SHM_V;
#pragma unroll
    for (int d0 = 0; d0 < 8; ++d0) S.qr[d0] = load8(cur.Q + (size_t)(wid * QBLK + r32) * QP + d0 * 16 + hi * 8);
    SLOAD_H(cur.K, cur.V, cur.jlo * KVBLK); VMW(); SWRITE_HK(0);
    __syncthreads();
}
template <int QP, int KP, int OP, bool OLDS = false>
__device__ __forceinline__ void block(const BlockRef& cur, const BlockRef& nxt, int skv, char* lds, Seam& S) {
    int tid = threadIdx.x; asm volatile("" : "+v"(tid)); const int wid = __builtin_amdgcn_readfirstlane(tid >> 6), lane = tid & 63, r32 = lane & 31, hi = lane >> 5;
    int j_hi = (cur.P0 + QB - 1) / KVBLK + 1; if (j_hi > skv / KVBLK) j_hi = skv / KVBLK;
    const int j_lo = cur.jlo, NT = j_hi - j_lo;
    const int qlo = cur.P0 + wid * QBLK, qm = qlo + r32 - 4 * hi;
    char* V_lds = lds; char* K_lds = lds + 2 * SHM_V;
    float* ws = (float*)(lds + 2 * SHM_V + 2 * SHM_K) + wid * 64; float* li_l = ws, * al_l = ws + 32;
    float m_reg = -1e30f, l_reg = 0; f32x16 o[4] = {};
    const int sr = tid >> 4, sc = (tid & 15) * 8, vst0 = v_st(sr, sc), vst1 = v_st(32 + sr, sc), kws = KSWZ(sr, sc * 2);
    const int vb0 = (int)(uintptr_t)V_lds + v_rd_base(lane);
    const bf16_t* Kh = cur.K; const bf16_t* Vh = cur.V;
    const unsigned selw = cur.sel ? cur.sel[qlo + r32] : 0xffffffffu;
#define RESC(a) do { if (__any((a) < 1.f)) { if (hi == 0) al_l[r32] = (a); asm volatile("s_waitcnt lgkmcnt(0)" ::: "memory");              \
                     for (int d_ = 0; d_ < 4; ++d_) for (int r = 0; r < 16; ++r) o[d_][r] *= al_l[crow(r, hi)]; } } while (0)
#define KBASE(t) ((j_lo + (t)) * KVBLK)
#define RACT(t) (((selw >> ((KBASE(t) >> 8) & 31)) & 1u) != 0u)
#define MASKT(P0_, P1_, t) do { const int kb_ = KBASE(t); if (kb_ + KVBLK - 1 > qlo) mask_tile(P0_, P1_, qm - kb_); } while (0)
    constexpr int NQL = 8;
#define SEAM_K0() do { VMWN(NQL); SWRITE_HK(0); SBAR(); } while (0)
    f32x16 pA0, pA1, pB0, pB1; float mnA, mnB, alA, alB; bf16x8 pa0, pa1, pa2, pa3;
    SWRITE_HV(0); SBAR();
    if (NT > 1) { SLOAD_H(Kh, Vh, KBASE(1)); }
    SBAR(); qkt<0>(pA0, pA1, K_lds, r32, hi, S.qr);
    MASKT(pA0, pA1, 0); partialSM(pA0, pA1, m_reg, mnA, alA, RACT(0));
    if (NT > 1) { VMW(); SWRITE_H(1); }
    __syncthreads();
#define HALF_STEP(PX0, PX1, mnX, alX, PY0, PY1, alY, t, KB, VB, SB) do {                                                      \
        SBAR(); qkt<KB>(PX0, PX1, K_lds, r32, hi, S.qr);                                             \
        finishSM(PY0, PY1, alY, l_reg, pa0, pa1, pa2, pa3); SBAR();                                                           \
        if ((t) + 1 < NT) { SLOAD_H(Kh, Vh, KBASE((t) + 1)); SBAR(); }                                               \
        pv_tile<VB * SHM_V>(o, vb0, pa0, pa1, pa2, pa3); MASKT(PX0, PX1, (t)); partialSM(PX0, PX1, m_reg, mnX, alX, RACT(t));                                        \
        __syncthreads();                                                                                                      \
        if ((t) + 1 < NT) { VMW(); SWRITE_H(SB); }                                                                          \
        RESC(alX); __syncthreads(); } while (0)
    for (int t = 1; t + 1 < NT; t += 2) {
        HALF_STEP(pB0, pB1, mnB, alB, pA0, pA1, alA, t, 1, 0, 0);
        HALF_STEP(pA0, pA1, mnA, alA, pB0, pB1, alB, t + 1, 0, 1, 1);
    }
    const bool even = (NT & 1) == 0;
    if (even) { SBAR(); qkt<1>(pB0, pB1, K_lds, r32, hi, S.qr); SBAR(); }
    SLOAD_H(nxt.K, nxt.V, nxt.jlo * KVBLK); SBAR();
#pragma unroll
    for (int d0 = 0; d0 < 8; ++d0) S.qr[d0] = load8(nxt.Q + (size_t)(wid * QBLK + r32) * QP + d0 * 16 + hi * 8);
    SBAR();
    finishSM(pA0, pA1, alA, l_reg, pa0, pa1, pa2, pa3); SBAR();
    pv_tile<0>(o, vb0, pa0, pa1, pa2, pa3);
    if (even) { MASKT(pB0, pB1, NT - 1); partialSM(pB0, pB1, m_reg, mnB, alB, RACT(NT - 1)); __syncthreads(); RESC(alB);
        finishSM(pB0, pB1, alB, l_reg, pa0, pa1, pa2, pa3); SBAR(); pv_tile<SHM_V>(o, vb0, pa0, pa1, pa2, pa3); }
    SBAR(); SEAM_K0();
    if (hi == 0) li_l[r32] = l_reg; asm volatile("s_waitcnt lgkmcnt(0)" ::: "memory");
    if constexpr (OLDS) { int lo_ = (threadIdx.x >> 6) * QBLK + (threadIdx.x & 31); asm volatile("" : "+v"(lo_));
        if (hi == 0) ((float*)(lds + 133120))[lo_] = m_reg * (1.4426950408889634f * SCALE) + __builtin_amdgcn_logf(l_reg); }
    else { if (cur.lse && hi == 0) cur.lse[wid * QBLK + r32] = m_reg * (1.4426950408889634f * SCALE) + __builtin_amdgcn_logf(l_reg); }
    float rli[16];
#pragma unroll
    for (int r = 0; r < 16; ++r) rli[r] = __builtin_amdgcn_rcpf(li_l[crow(r, hi)]);
    int wq_ = (threadIdx.x >> 6) * QBLK; if constexpr (OLDS) asm volatile("" : "+v"(wq_));
    bf16_t* Ow = OLDS ? (bf16_t*)(lds + 67584) + (size_t)wq_ * OP : cur.O + (size_t)(wid * QBLK) * OP;
#pragma unroll
    for (int r = 0; r < 16; ++r) { const int orow = crow(r, hi);
#pragma unroll
        for (int d0 = 0; d0 < 4; ++d0) { const float v = o[d0][r] * rli[r];
            const float vn = __shfl_xor(v, 1);
            if ((r32 & 1) == 0) *(unsigned*)(Ow + (size_t)orow * OP + d0 * 32 + r32) = cvtpk(v, vn); } }
    __syncthreads();
#undef RESC
#undef KBASE
#undef RACT
#undef MASKT
#undef SEAM_K0
#undef HALF_STEP
}
__device__ __forceinline__ void gather_load_kv(const bf16_t* Kn, const bf16_t* Vn, char* lds) {
    int tid = threadIdx.x; asm volatile("" : "+v"(tid)); const int sr = tid >> 4, sc = (tid & 15) * 8; char* V_lds = lds; char* K_lds = lds + 4 * SHM_V;
    bf16x8 kk[8], vv[8];
#pragma unroll
    for (int i = 0; i < 8; ++i) { kk[i] = load8(Kn + (size_t)(sr + 32 * i) * AW + sc); vv[i] = load8(Vn + (size_t)(sr + 32 * i) * AW + sc); }
#pragma unroll
    for (int i = 0; i < 8; ++i) { const int t = i >> 1, rr = sr + 32 * (i & 1);
        *(bf16x8*)(K_lds + t * SHM_K + KSWZ(rr, sc * 2)) = kk[i]; *(bf16x8*)(V_lds + t * SHM_V + v_st(rr, sc)) = vv[i]; }
}
__device__ __forceinline__ void gather_run(const bf16_t* Qh, const unsigned short* list, int c_lo, int c_hi, int cnt, bf16_t* P01, bf16_t* P2, float* LSE, size_t rowbase, char* lds) {
    int tid = threadIdx.x; asm volatile("" : "+v"(tid)); const int wid = __builtin_amdgcn_readfirstlane(tid >> 6), lane = tid & 63, r32 = lane & 31, hi = lane >> 5;
    char* V_lds = lds; char* K_lds = lds + 4 * SHM_V;
    const int vb0 = (int)(uintptr_t)V_lds + v_rd_base(lane);
    bf16x8 qr[8], qn[8]; unsigned ent = 0xFFFFu, entn = 0xFFFFu; bool has = false, hasn = false;
#define GLOAD(C_, ENT, QR, HAS) do { const int ew_ = (C_) * 256 + wid * 32; HAS = ew_ < cnt; if (HAS) { const int e_ = ew_ + r32; const bool v_ = e_ < cnt; \
        ENT = v_ ? (unsigned)list[e_] : 0xFFFFu; const int sq_ = v_ ? (int)(ENT & 8191u) : (int)((unsigned)list[ew_] & 8191u); \
        _Pragma("unroll") for (int d0 = 0; d0 < 8; ++d0) QR[d0] = load8(Qh + (size_t)sq_ * AW + d0 * 16 + hi * 8); } } while (0)
    GLOAD(c_lo, ent, qr, has);
    for (int c = c_lo; c < c_hi; ++c) {
        hasn = false; if (c + 1 < c_hi) GLOAD(c + 1, entn, qn, hasn);
        if (has) {
            float m_reg = -1e30f, l_reg = 0; f32x16 o[4] = {};
            f32x16 pA0, pA1, pB0, pB1; float mnA, mnB, alA, alB; bf16x8 pa0, pa1, pa2, pa3;
#define GRESC(a) do { if (__any((a) < 1.f)) { _Pragma("unroll") for (int d_ = 0; d_ < 4; ++d_) o[d_] *= (a); } } while (0)
            SBAR(); qkt<0>(pA0, pA1, K_lds, r32, hi, qr); partialSM(pA0, pA1, m_reg, mnA, alA, true);
            SBAR(); qkt<1>(pB0, pB1, K_lds, r32, hi, qr); finishSM(pA0, pA1, alA, l_reg, pa0, pa1, pa2, pa3); SBAR(); pv_tile_T<0 * SHM_V>(o, vb0, pa0, pa1, pa2, pa3); partialSM(pB0, pB1, m_reg, mnB, alB, true); GRESC(alB);
            SBAR(); qkt<2>(pA0, pA1, K_lds, r32, hi, qr); finishSM(pB0, pB1, alB, l_reg, pa0, pa1, pa2, pa3); SBAR(); pv_tile_T<1 * SHM_V>(o, vb0, pa0, pa1, pa2, pa3); partialSM(pA0, pA1, m_reg, mnA, alA, true); GRESC(alA);
            SBAR(); qkt<3>(pB0, pB1, K_lds, r32, hi, qr); finishSM(pA0, pA1, alA, l_reg, pa0, pa1, pa2, pa3); SBAR(); pv_tile_T<2 * SHM_V>(o, vb0, pa0, pa1, pa2, pa3); partialSM(pB0, pB1, m_reg, mnB, alB, true); GRESC(alB);
            SBAR(); finishSM(pB0, pB1, alB, l_reg, pa0, pa1, pa2, pa3); SBAR(); pv_tile_T<3 * SHM_V>(o, vb0, pa0, pa1, pa2, pa3);
#undef GRESC
            if (ent != 0xFFFFu) { const unsigned sl = ent >> 13; const size_t row = rowbase + (ent & 8191u);
                if (hi == 0) LSE[(size_t)sl * (BATCH * NH * SEQ) + row] = m_reg * (1.4426950408889634f * SCALE) + __builtin_amdgcn_logf(l_reg);
                const float rl = __builtin_amdgcn_rcpf(l_reg);
                unsigned char* dst = (unsigned char*)(sl < 2u ? P01 + (size_t)sl * ((size_t)BATCH * NH * SEQ * D) : P2) + row * D + 16 * hi; const float rs = rl * OA8_SCALE;
#pragma unroll
                for (int d0 = 0; d0 < 4; ++d0) {
                    const unsigned q0 = pk4_fp8(o[d0][0] * rs, o[d0][1] * rs, o[d0][2] * rs, o[d0][3] * rs), q1 = pk4_fp8(o[d0][4] * rs, o[d0][5] * rs, o[d0][6] * rs, o[d0][7] * rs);
                    const unsigned q2 = pk4_fp8(o[d0][8] * rs, o[d0][9] * rs, o[d0][10] * rs, o[d0][11] * rs), q3 = pk4_fp8(o[d0][12] * rs, o[d0][13] * rs, o[d0][14] * rs, o[d0][15] * rs);
                    auto r0 = __builtin_amdgcn_permlane32_swap(q0, q2, false, false); auto r1 = __builtin_amdgcn_permlane32_swap(q1, q3, false, false);
                    u32x4 w; w.x = r0[0]; w.y = r0[1]; w.z = r1[0]; w.w = r1[1];
                    *(u32x4*)(dst + d0 * 32) = w; } }
        }
        has = hasn; ent = entn;
#pragma unroll
        for (int d0 = 0; d0 < 8; ++d0) qr[d0] = qn[d0];
    }
#undef GLOAD
}
#undef ROW
#undef VMW
#undef VMWN
#undef SLOAD_H
#undef SWRITE_HK
#undef SWRITE_HV
#undef SWRITE_H
}

constexpr int NWAVES = 8;
constexpr int N_PHASES = 15;
constexpr size_t MiB = 1u << 20;
constexpr size_t WS_CTL = 0, CTL_ZERO_BYTES = 1 * MiB;
constexpr size_t WS_KM = 1 * MiB, WS_SEL = 2 * MiB, WS_ROPE_C = 3 * MiB, WS_ROPE_S = 5 * MiB, WS_WSGU = 7 * MiB, WS_MEMKV = 8 * MiB, WS_MEMN = 9 * MiB;
constexpr size_t WS_WIN = 16 * MiB, WS_PCAT = 160 * MiB, WS_WOUT = 192 * MiB, WS_WXQ = 224 * MiB, WS_WXKV = 228 * MiB, WS_WXO = 236 * MiB, WS_WGU = 240 * MiB, WS_WDN = 412 * MiB;
constexpr size_t WS_XB = 498 * MiB;
constexpr size_t WS_Q = 626 * MiB, WS_U = 690 * MiB, WS_K = 754 * MiB, WS_V = 818 * MiB, WS_VS = 882 * MiB, WS_SA = 946 * MiB, WS_SB = 1074 * MiB, WS_END = 1202 * MiB;
constexpr size_t WS_MERGED = WS_K;
constexpr size_t WS_QX = WS_VS, WS_OX = WS_VS + 16 * MiB;
constexpr size_t WS_ACT = WS_Q;
static_assert(WS_WDN + (size_t)DM * DFF * 2 <= WS_XB && WS_WGU + (size_t)2 * DFF * DM * 2 <= WS_WDN && WS_ACT + (size_t)M * DFF * 2 <= WS_SB, "ws map");
constexpr int CW_TMO = 0;
constexpr int CW_BAR = 4096;
constexpr int CW_LCNT = 16384, CW_PCNT2 = 24576;
constexpr size_t CTL_SSQ = 256 * 1024;
constexpr int RING_BYTES = 131072, LDS_BYTES = 147456, LDSCTL_OFF = LDS_BYTES - 1024, MISC_OFF = LDSCTL_OFF + 320;
constexpr int OT_OFF = 67584, OTL_OFF = OT_OFF + 65536;

#define RLX_AGENT __ATOMIC_RELAXED, __HIP_MEMORY_SCOPE_AGENT
#define LDS_WAIT() asm volatile("s_waitcnt lgkmcnt(0)" ::: "memory")
#define VM_WAIT() asm volatile("s_waitcnt vmcnt(0)" ::: "memory")
__device__ __forceinline__ unsigned f2bf(float f) { unsigned u = __builtin_bit_cast(unsigned, f); return (u + 0x7fffu + ((u >> 16) & 1u)) >> 16; }
__device__ __forceinline__ unsigned pk2(float lo, float hi) { return f2bf(lo) | (f2bf(hi) << 16); }

#define XB_TMO      128
#define XB_XCNT(j)  (256  + 64 * (j))
#define XB_XSUB(j)  (1280 + 64 * (j))
#define XB_XGEN(j)  (2304 + 64 * (j))
#define XB_TOP      3328
#define XB_TOPGEN   3392
#define XCD_BAR_WORDS 3456
#define XB_SPIN_CAP (1u << 18)
__device__ __forceinline__ unsigned xb_ld(unsigned* p)              { return __hip_atomic_load(p, __ATOMIC_RELAXED, __HIP_MEMORY_SCOPE_AGENT); }
__device__ __forceinline__ unsigned xb_add(unsigned* p, unsigned v) { return __hip_atomic_fetch_add(p, v, __ATOMIC_RELAXED, __HIP_MEMORY_SCOPE_AGENT); }
__device__ __forceinline__ unsigned xb_xcc_id() { return (unsigned)__builtin_amdgcn_s_getreg((3 << 11) | 20) & 0xFu; }
#define XB_SPIN(cond, bar) do { unsigned _sp = 0; while (cond) { __builtin_amdgcn_s_sleep(1); \
    if ((++_sp & 255u) == 0u) { if (xb_ld(&(bar)[XB_TMO])) break; if (_sp > XB_SPIN_CAP) { atomicAdd(&(bar)[XB_TMO], 1u); break; } } } } while (0)
struct XcdBarrier { unsigned* bar; unsigned x; volatile LAS unsigned* st; };
__device__ __forceinline__ XcdBarrier xcd_barrier_post(unsigned* bar, volatile LAS unsigned* st) {
    XcdBarrier b; b.bar = bar; b.x = xb_xcc_id(); b.st = st;
    if (threadIdx.x == 0) (void)xb_add(&bar[XB_XCNT(b.x)], 1u);
    return b;
}
__device__ __forceinline__ void xcd_barrier_complete(unsigned* bar, unsigned x, unsigned& nloc, unsigned& nx) {
    const unsigned G = gridDim.x * gridDim.y * gridDim.z;
    unsigned sum, cnt, mine, sp = 0u;
    for (;;) {
        sum = 0u; cnt = 0u; mine = 0u;
#pragma unroll
        for (unsigned j = 0; j < 16; ++j) { const unsigned c = xb_ld(&bar[XB_XCNT(j)]); sum += c; cnt += (c > 0u) ? 1u : 0u; mine = (j == x) ? c : mine; }
        if (sum == G) break;
        __builtin_amdgcn_s_sleep(1);
        if ((++sp & 255u) == 0u) { if (xb_ld(&bar[XB_TMO])) break; if (sp > XB_SPIN_CAP) { atomicAdd(&bar[XB_TMO], 1u); break; } }
    }
    nloc = mine > 0u ? mine : 1u; nx = cnt > 0u ? cnt : 1u;
}
__device__ __forceinline__ void xcd_barrier(const XcdBarrier& b) {
    asm volatile("s_waitcnt vmcnt(0)" ::: "memory");
    __syncthreads();
    if (threadIdx.x == 0) {
        unsigned* bar = b.bar;
        __builtin_amdgcn_s_waitcnt(0);
        unsigned nloc = b.st[0], nx = b.st[1];
        if (nloc == 0u) { xcd_barrier_complete(bar, b.x, nloc, nx); b.st[0] = nloc; b.st[1] = nx; }
        const unsigned old = xb_add(&bar[XB_XSUB(b.x)], 1u);
        const unsigned gen = old / nloc;
        if (old + 1u == (gen + 1u) * nloc) {
            __builtin_amdgcn_fence(__ATOMIC_RELEASE, "agent");
            asm volatile("s_waitcnt vmcnt(0)" ::: "memory");
            const unsigned og = xb_add(&bar[XB_TOP], 1u);
            const unsigned tg = og / nx;
            if (og + 1u == (tg + 1u) * nx) xb_add(&bar[XB_TOPGEN], 1u);
            else XB_SPIN(xb_ld(&bar[XB_TOPGEN]) == tg, bar);
            __builtin_amdgcn_fence(__ATOMIC_ACQUIRE, "agent");
            xb_add(&bar[XB_XGEN(b.x)], 1u);
            asm volatile("s_waitcnt vmcnt(0)" ::: "memory");
        } else {
            XB_SPIN(xb_ld(&bar[XB_XGEN(b.x)]) == gen, bar);
            __builtin_amdgcn_fence(__ATOMIC_ACQUIRE, "agent");
            asm volatile("s_waitcnt vmcnt(0)" ::: "memory");
        }
    }
    __syncthreads();
}

__device__ __forceinline__ float wave_sum(float v) {
#pragma unroll
    for (int o = 1; o < 64; o <<= 1) v += __shfl_xor(v, o);
    return v;
}
__device__ __forceinline__ void tr_item64(const float* __restrict__ W, int K, int N, int k0, int n0, bf16_t* WT, int drow0, const float* __restrict__ gain, LAS unsigned* scr, int lane) {
    const float* src = W + (size_t)k0 * N + n0 + lane;
    float v[64];
#pragma unroll
    for (int r = 0; r < 64; ++r) v[r] = src[(size_t)r * N];
    if (gain) {
#pragma unroll
        for (int r = 0; r < 64; ++r) v[r] *= gain[k0 + r]; }
#pragma unroll
    for (int i = 0; i < 32; ++i) scr[i * 65 + lane] = cvt_pk_bf16(v[2 * i], v[2 * i + 1]);
    LDS_WAIT(); asm volatile("" ::: "memory");
    const int c = lane & 7;
#pragma unroll
    for (int jj = 0; jj < 8; ++jj) { const int n = (lane >> 3) + 8 * jj; const LAS unsigned* sp = scr + (4 * c) * 65 + n;
        u32x4 o; o.x = sp[0]; o.y = sp[65]; o.z = sp[130]; o.w = sp[195];
        *(GAS u32x4*)(WT + (size_t)(drow0 + n) * K + k0 + 8 * c) = o; }
    LDS_WAIT(); asm volatile("" ::: "memory");
}
struct TrItem { const float* W; bf16_t* WT; const float* gain; int K, N, k0, n0, kind, rowbase; };
__device__ __forceinline__ void tr_issue(const TrItem& it, f32x4 (&v)[8], int wave, int lane) {
    const float* src = it.W + (size_t)(it.k0 + 8 * wave) * it.N + it.n0 + 4 * lane;
#pragma unroll
    for (int r = 0; r < 8; ++r) v[r] = __builtin_nontemporal_load((const f32x4*)(src + (size_t)r * it.N));
}
__device__ __forceinline__ void tr_stage(const TrItem& it, const f32x4 (&v)[8], LAS unsigned* T, int wave, int lane) {
    if (it.kind >= 4) {
        float g[8];
#pragma unroll
        for (int r = 0; r < 8; ++r) g[r] = (it.gain ? it.gain[it.k0 + 8 * wave + r] : 1.f) * W8_SCALE;
#pragma unroll
        for (int j = 0; j < 4; ++j) { T[(4 * lane + j) * 17 + 2 * wave] = pk4_fp8(v[0][j] * g[0], v[1][j] * g[1], v[2][j] * g[2], v[3][j] * g[3]);
            T[(4 * lane + j) * 17 + 2 * wave + 1] = pk4_fp8(v[4][j] * g[4], v[5][j] * g[5], v[6][j] * g[6], v[7][j] * g[7]); }
        return; }
#pragma unroll
    for (int rp = 0; rp < 4; ++rp) { float g0 = 1.f, g1 = 1.f; if (it.gain) { g0 = it.gain[it.k0 + 8 * wave + 2 * rp]; g1 = it.gain[it.k0 + 8 * wave + 2 * rp + 1]; }
#pragma unroll
        for (int j = 0; j < 4; ++j) T[(4 * lane + j) * 33 + 4 * wave + rp] = cvt_pk_bf16(v[2 * rp][j] * g0, v[2 * rp + 1][j] * g1); }
}
__device__ __forceinline__ void tr_readout(const TrItem& it, const LAS unsigned* T, int tid) {
    if (it.kind >= 4) {
#pragma unroll
        for (int i = 0; i < 2; ++i) { const int q = tid + 512 * i, nl = q >> 2, c = q & 3, n = it.n0 + nl; int drow = it.rowbase + n;
            if (it.kind == 5) { const int t = n >> 8, l8 = n & 255; drow = t * 256 + 128 * ((l8 >> 6) & 1) + 64 * (l8 >> 7) + (l8 & 63); }
            const LAS unsigned* sp = T + nl * 17 + 4 * c; u32x4 o; o.x = sp[0]; o.y = sp[1]; o.z = sp[2]; o.w = sp[3];
            *(GAS u32x4*)((unsigned char*)it.WT + (size_t)drow * it.K + it.k0 + 16 * c) = o; }
        return; }
#pragma unroll
    for (int i = 0; i < 4; ++i) { const int q = tid + 512 * i, nl = q >> 3, c = q & 7, n = it.n0 + nl; int drow = it.rowbase + n;
        if (it.kind == 1) { if (n < 4096) { const int t = n >> 8, l8 = n & 255; drow = t * 256 + 128 * ((l8 >> 6) & 1) + 64 * (l8 >> 7) + (l8 & 63); } }
        else if (it.kind >= 2) drow = (n >> 7) * 256 + (it.kind == 3 ? 128 : 0) + (n & 127);
        const LAS unsigned* sp = T + nl * 33 + 4 * c; u32x4 o; o.x = sp[0]; o.y = sp[1]; o.z = sp[2]; o.w = sp[3];
        *(GAS u32x4*)(it.WT + (size_t)drow * it.K + it.k0 + 8 * c) = o; }
}
__device__ __forceinline__ float row_to_bf16(const float* xrow, bf16_t* orow, const float* gain, int lane, unsigned char* o8 = nullptr) {
    const GAS f32x4* xr = (const GAS f32x4*)xrow + lane;
    f32x4 v[16]; float s = 0.f;
#pragma unroll
    for (int j = 0; j < 16; ++j) { v[j] = __builtin_nontemporal_load(xr + 64 * j); s += (v[j].x * v[j].x + v[j].y * v[j].y) + (v[j].z * v[j].z + v[j].w * v[j].w); }
    s = wave_sum(s);
    const float r = gain ? __builtin_amdgcn_rsqf(s * (1.f / DM) + RMS_EPS) : 1.f;
    GAS u32x2* o8b = (GAS u32x2*)orow + lane;
#pragma unroll
    for (int j = 0; j < 16; ++j) { f32x4 g = gain ? ((const GAS f32x4*)gain)[lane + 64 * j] * r : (f32x4){1.f, 1.f, 1.f, 1.f}; f32x4 w = v[j] * g;
        u32x2 o; o.x = cvt_pk_bf16(w.x, w.y); o.y = cvt_pk_bf16(w.z, w.w); o8b[64 * j] = o;
        if (o8) ((GAS unsigned*)o8)[lane + 64 * j] = pk4_fp8(w.x * X8_SCALE, w.y * X8_SCALE, w.z * X8_SCALE, w.w * X8_SCALE); }
    return s;
}
__device__ const float INV_FREQ[64] = {1.f, 0.865964353f, 0.749894261f, 0.649381638f, 0.562341332f, 0.486967534f, 0.421696514f, 0.365174115f, 0.316227764f, 0.273841977f, 0.237137377f, 0.2053525f, 0.177827939f, 0.153992653f, 0.133352131f, 0.115478203f, 0.100000001f, 0.0865964293f, 0.0749894157f, 0.0649381652f, 0.0562341325f, 0.0486967526f, 0.0421696529f, 0.0365174115f, 0.0316227749f, 0.0273841973f, 0.0237137377f, 0.0205352511f, 0.0177827943f, 0.0153992651f, 0.0133352149f, 0.0115478206f, 0.00999999978f, 0.00865964312f, 0.00749894185f, 0.00649381615f, 0.00562341325f, 0.00486967526f, 0.00421696482f, 0.00365174119f, 0.00316227763f, 0.00273841969f, 0.00237137359f, 0.00205352483f, 0.00177827943f, 0.00153992651f, 0.00133352145f, 0.0011547819f, 0.00100000005f, 0.000865964335f, 0.000749894243f, 0.000649381662f, 0.000562341302f, 0.000486967532f, 0.000421696517f, 0.000365174143f, 0.000316227757f, 0.000273841957f, 0.00023713737f, 0.00020535251f, 0.00017782794f, 0.000153992645f, 0.00013335215f, 0.0001154782f};
__device__ __forceinline__ void rope_entry(int pos, int i, float& c, float& s) {
    const float af = (float)pos * INV_FREQ[i];
    const double x = (double)af, k = __builtin_rint(x * 0.63661977236758134308);
    double r = __builtin_fma(-k, 1.57079632673412561417e+00, x); r = __builtin_fma(-k, 6.07710050650619224932e-11, r);
    const double z = r * r;
    double sp = 1.0 / 1307674368000.0; sp = sp * z - 1.0 / 6227020800.0; sp = sp * z + 1.0 / 39916800.0; sp = sp * z - 1.0 / 362880.0; sp = sp * z + 1.0 / 5040.0; sp = sp * z - 1.0 / 120.0; sp = sp * z + 1.0 / 6.0;
    const double sn = r - r * z * sp;
    double cp = 1.0 / 20922789888000.0; cp = cp * z - 1.0 / 87178291200.0; cp = cp * z + 1.0 / 479001600.0; cp = cp * z - 1.0 / 3628800.0; cp = cp * z + 1.0 / 40320.0; cp = cp * z - 1.0 / 720.0; cp = cp * z + 1.0 / 24.0;
    const double cs = 1.0 - 0.5 * z + z * z * cp;
    const int q = (int)k & 3;
    const double so = (q & 1) ? cs : sn, co = (q & 1) ? sn : cs;
    s = (float)((q & 2) ? -so : so); c = (float)(((q + 1) & 2) ? -co : co);
}

__device__ __forceinline__ void sgu_unit(int unit, const bf16_t* __restrict__ VS, const unsigned long long* __restrict__ LNS, const bf16_t* U, bf16_t* OB, const bf16_t* __restrict__ Wt, const float* __restrict__ lng, const float* __restrict__ lnb,
                                         const float* __restrict__ bs, char* lds, int tid, int wid, int lane) {
    const int half = unit & 1, bc = unit >> 1, t0 = bc * SCH, r32 = lane & 31, hi = lane >> 5;
    float* stats = (float*)(lds + 65536);
    if (tid < SCH) { const float m1 = (float)(long long)LNS[2 * (t0 + tid)] * (1.f / (SSQ_SCALE * SW)), m2 = (float)(long long)LNS[2 * (t0 + tid) + 1] * (1.f / (SSQ_SCALE * SW));
        stats[2 * tid] = m1; stats[2 * tid + 1] = __builtin_amdgcn_rsqf(fmaxf(m2 - m1 * m1, 0.f) + LN_EPS); }
    __syncthreads();
    for (int gp = 0; gp < 4; ++gp) {
        const int g0 = half * 8 + gp * 2;
        { const int dc = tid & 15, s0 = tid >> 4; u32x4 vr[8];
#pragma unroll
            for (int i = 0; i < 8; ++i) vr[i] = *(const u32x4*)(VS + (size_t)(t0 + s0 + 32 * (i & 3)) * SW + (g0 + (i >> 2)) * 128 + dc * 8);
#pragma unroll
            for (int gi = 0; gi < 2; ++gi) { const int col = (g0 + gi) * 128 + dc * 8;
                const f32x4 ga = *(const f32x4*)(lng + col), gb = *(const f32x4*)(lng + col + 4), ba = *(const f32x4*)(lnb + col), bb = *(const f32x4*)(lnb + col + 4);
#pragma unroll
                for (int k = 0; k < 4; ++k) { const int s = s0 + 32 * k; f32x4 x0, x1; unpack8(vr[gi * 4 + k], x0, x1);
                    const float mean = stats[2 * s], rstd = stats[2 * s + 1];
                    x0 = (x0 - mean) * rstd * ga + ba; x1 = (x1 - mean) * rstd * gb + bb;
                    *(u32x4*)(lds + gi * 32768 + (s >> 6) * 16384 + att::v_st(s & 63, dc * 8)) = pack8f(x0, x1); } } }
        __syncthreads();
        const int grp = wid >> 2, tt = wid & 3, g = g0 + grp;
        f32x16 o[4] = {};
        const int vb0 = (int)(uintptr_t)lds + grp * 32768 + att::v_rd_base(lane);
        const bf16_t* wp = Wt + ((size_t)g * SCH + tt * 32 + r32) * SCH + hi * 8;
        { const bf16x8 pa0 = att::load8(wp), pa1 = att::load8(wp + 16), pa2 = att::load8(wp + 32), pa3 = att::load8(wp + 48); att::pv_tile<0>(o, vb0, pa0, pa1, pa2, pa3); }
        if (tt >= 2) { const bf16x8 pa0 = att::load8(wp + 64), pa1 = att::load8(wp + 80), pa2 = att::load8(wp + 96), pa3 = att::load8(wp + 112); att::pv_tile<16384>(o, vb0, pa0, pa1, pa2, pa3); }
#pragma unroll
        for (int rh = 0; rh < 2; ++rh) {
            unsigned short up[8][4]; float bias[8];
#pragma unroll
            for (int r = 0; r < 8; ++r) { const int t = tt * 32 + att::crow(rh * 8 + r, hi); bias[r] = bs[g * SCH + t];
#pragma unroll
                for (int d0 = 0; d0 < 4; ++d0) up[r][d0] = U[(size_t)(t0 + t) * SW + g * 128 + d0 * 32 + r32]; }
#pragma unroll
            for (int r = 0; r < 8; ++r) { const int t = tt * 32 + att::crow(rh * 8 + r, hi);
#pragma unroll
                for (int d0 = 0; d0 < 4; ++d0) { const size_t idx = (size_t)(t0 + t) * SW + g * 128 + d0 * 32 + r32;
                    const float uv = __builtin_bit_cast(float, (unsigned)up[r][d0] << 16), v = uv * (o[d0][rh * 8 + r] + bias[r]), vn = __shfl_xor(v, 1);
                    if ((r32 & 1) == 0) *(unsigned*)(OB + idx) = att::cvtpk(v, vn); } } }
        __syncthreads();
    }
}
__device__ __forceinline__ att::BlockRef own_ref(int unit, const bf16_t* Qb, const bf16_t* Kb, const bf16_t* Vb, bf16_t* Ob, float* lse3) {
    const int bh = unit >> 5, cur = unit & 31, b = bh >> 4, h = bh & 15;
    att::BlockRef r; r.Q = Qb + ((size_t)(b * SEQ + cur * 256)) * AW + h * HD; r.O = Ob + ((size_t)(b * SEQ + cur * 256)) * AW + h * HD; r.K = Kb + (size_t)(b * SEQ) * AW + h * HD; r.V = Vb + (size_t)(b * SEQ) * AW + h * HD;
    r.P0 = cur * 256; r.jlo = 4 * cur; r.sel = nullptr; r.lse = lse3 + (size_t)bh * SEQ + cur * 256; return r;
}
__device__ __forceinline__ att::BlockRef xattn_ref(int unit, const bf16_t* QX, const bf16_t* KV, bf16_t* OX) {
    const int b = unit >> 7, hx = (unit >> 5) & 3, qb = unit & 31;
    att::BlockRef r; r.Q = QX + ((size_t)(b * SEQ + qb * 256)) * XW + hx * HD; r.O = OX + ((size_t)(b * SEQ + qb * 256)) * XW + hx * HD;
    r.K = KV + (size_t)(b * NMEM) * (2 * XW) + hx * HD; r.V = r.K + XW; r.P0 = 256; r.jlo = 0; r.sel = nullptr; r.lse = nullptr; return r;
}

struct Args { const float* in[21]; float* out; unsigned char* ws; int ph_lo, ph_hi; };
#define ctl ((unsigned*)((unsigned*)(ws + WS_CTL)))
#define ssq1 ((ssq_t*)((ssq_t*)(ws + CTL_SSQ)))
#define ssq2 ((ssq_t*)(ssq1 + M))
#define ssq3 ((ssq_t*)(ssq2 + M))
#define ssq4 ((ssq_t*)(ssq3 + M))
#define x_in ((const float*)(args.in[0]))
#define mem_in ((const float*)(args.in[1]))
#define g_mix ((const float*)(args.in[2]))
#define w_in ((const float*)(args.in[3]))
#define ln_g ((const float*)(args.in[4]))
#define ln_b ((const float*)(args.in[5]))
#define w_sgu ((const float*)(args.in[6]))
#define b_sgu ((const float*)(args.in[7]))
#define w_pa ((const float*)(args.in[8]))
#define w_pb ((const float*)(args.in[9]))
#define w_out ((const float*)(args.in[10]))
#define g_xat ((const float*)(args.in[11]))
#define g_mem ((const float*)(args.in[12]))
#define w_xq ((const float*)(args.in[13]))
#define w_xkv ((const float*)(args.in[14]))
#define w_xo ((const float*)(args.in[15]))
#define g_ffn ((const float*)(args.in[16]))
#define w_gate ((const float*)(args.in[17]))
#define w_up ((const float*)(args.in[18]))
#define w_down ((const float*)(args.in[19]))
#define g_fin ((const float*)(args.in[20]))
#define out_f ((float*)(args.out))
#define kmpart ((float*)((float*)(ws + WS_KM)))
#define LSE3 ((float*)((float*)(ws + WS_SEL)))
#define LSE ((float*)((float*)(ws + 13 * MiB)))
#define lcnt ((unsigned*)(ctl + CW_LCNT))
#define lists ((unsigned short*)((unsigned short*)(ws + WS_WIN + 128 * MiB)))
#define P01 ((bf16_t*)((bf16_t*)(ws + WS_WIN)))
#define P2 ((bf16_t*)((bf16_t*)(ws + WS_VS)))
#define rope_c ((float*)((float*)(ws + WS_ROPE_C)))
#define rope_s ((float*)((float*)(ws + WS_ROPE_S)))
#define kvpart ((float*)((float*)(ws + WS_SA + 64 * MiB)))
#define wsgu_t ((bf16_t*)((bf16_t*)(ws + WS_WSGU)))
#define memkv ((bf16_t*)((bf16_t*)(ws + WS_MEMKV)))
#define memn ((bf16_t*)((bf16_t*)(ws + WS_MEMN)))
#define Win_t ((bf16_t*)((bf16_t*)(ws + WS_WIN)))
#define Win8 ((unsigned char*)(ws + WS_WIN + 64 * MiB))
#define lnstat ((unsigned long long*)(ws + 768 * 1024))
#define XB8 ((unsigned char*)(ws + WS_SB + 64 * MiB))
#define OA8 ((unsigned char*)(ws + WS_SB + 64 * MiB))
#define Pcat_t ((bf16_t*)((bf16_t*)(ws + WS_PCAT)))
#define Wout_t ((bf16_t*)((bf16_t*)(ws + WS_WOUT)))
#define Wxq_t ((bf16_t*)((bf16_t*)(ws + WS_WXQ)))
#define Wxkv_t ((bf16_t*)((bf16_t*)(ws + WS_WXKV)))
#define Wxo_t ((bf16_t*)((bf16_t*)(ws + WS_WXO)))
#define Wgu_t ((bf16_t*)((bf16_t*)(ws + WS_WGU)))
#define Wdn_t ((bf16_t*)((bf16_t*)(ws + WS_WDN)))
#define XB ((bf16_t*)((bf16_t*)(ws + WS_XB)))
#define OA ((bf16_t*)((bf16_t*)(ws + WS_Q)))
#define OB ((bf16_t*)((bf16_t*)(ws + WS_U)))
#define Qb ((bf16_t*)((bf16_t*)(ws + WS_Q)))
#define Ub ((bf16_t*)((bf16_t*)(ws + WS_U)))
#define Kb ((bf16_t*)((bf16_t*)(ws + WS_K)))
#define Vb ((bf16_t*)((bf16_t*)(ws + WS_V)))
#define VSb ((bf16_t*)((bf16_t*)(ws + WS_VS)))
#define SAb ((unsigned char*)((unsigned char*)(ws + WS_SA)))
#define SBb ((unsigned char*)((unsigned char*)(ws + WS_SB)))
#define MG ((bf16_t*)((bf16_t*)(ws + WS_MERGED)))
#define QX ((bf16_t*)((bf16_t*)(ws + WS_QX)))
#define OX ((bf16_t*)((bf16_t*)(ws + WS_OX)))
#define ACT ((bf16_t*)((bf16_t*)(ws + WS_ACT)))
__global__ void __launch_bounds__(NWAVES * 64, 2) mk_fwd(Args args) {
    extern __shared__ __attribute__((aligned(16))) unsigned char lds[];
    LAS unsigned char* ldsl = (LAS unsigned char*)lds;
    const int tid = threadIdx.x, lane = tid & 63, wave = __builtin_amdgcn_readfirstlane(tid >> 6), G = gridDim.x, B = blockIdx.x;
    unsigned char* ws = args.ws;

    for (int u = tid; u < (LDS_BYTES - LDSCTL_OFF) / 4; u += NWAVES * 64) ((LAS unsigned*)(ldsl + LDSCTL_OFF))[u] = 0u;
    __syncthreads();
    volatile LAS unsigned* MISC = (volatile LAS unsigned*)(ldsl + MISC_OFF);
    const XcdBarrier bar = xcd_barrier_post(ctl + CW_BAR, MISC + 8);
#define GRID_BAR() xcd_barrier(bar)
    const int lo = args.ph_lo, hi_ = args.ph_hi;
#define IN(k) (lo <= (k) && (k) < hi_)
#define BOTH(k) (IN(k) && IN((k) + 1))
    const int gw = B * NWAVES + wave, NGW = G * NWAVES;

            constexpr int J_IN = (DM / 64) * (NIN / 256), J_PA = (AW / 64) * (DM / 256), J_PB = J_PA, J_WO = (DM / 64) * (DM / 256), J_XQ = (DM / 64) * (XW / 256), J_XKV = (DM / 64) * (2 * XW / 256),
                          J_XO = (XW / 64) * (DM / 256), J_G = (DM / 64) * (DFF / 256), J_U = J_G, J_D = (DFF / 64) * (DM / 256);
            constexpr int NJ = J_IN + J_PA + J_PB + J_WO + J_XQ + J_XKV + J_XO + J_G + J_U + J_D, J_FFN0 = NJ - J_G - J_U - J_D, J_DN0 = NJ - J_D;
#define TR_DECODE(IT, idx) do { int r = (idx); TrItem& t_ = (IT); \
            if (r < J_IN) { const int n0_ = (r % (NIN / 256)) * 256, k0_ = (r / (NIN / 256)) * 64; \
                if (n0_ < 4096) t_ = TrItem{w_in, (bf16_t*)Win8, g_mix, DM, NIN, k0_, n0_, 5, 0}; else if (n0_ < 6144) t_ = TrItem{w_in, (bf16_t*)Win8, g_mix, DM, NIN, k0_, n0_, 4, 0}; \
                else if (n0_ < 10240) t_ = TrItem{w_in, Win_t, g_mix, DM, NIN, k0_, n0_, 0, -6144}; else t_ = TrItem{w_in, (bf16_t*)Win8, g_mix, DM, NIN, k0_, n0_, 4, -4096}; break; } r -= J_IN; \
            if (r < J_PA) { t_ = TrItem{w_pa, Pcat_t, nullptr, AW, DM, (r / (DM / 256)) * 64, (r % (DM / 256)) * 256, 4, 0}; break; } r -= J_PA;     \
            if (r < J_PB) { t_ = TrItem{w_pb, Pcat_t, nullptr, SW, DM, (r / (DM / 256)) * 64, (r % (DM / 256)) * 256, 0, DM}; break; } r -= J_PB; \
            if (r < J_WO) { t_ = TrItem{w_out, Wout_t, nullptr, DM, DM, (r / (DM / 256)) * 64, (r % (DM / 256)) * 256, 0, 0}; break; } r -= J_WO; \
            if (r < J_XQ) { t_ = TrItem{w_xq, Wxq_t, g_xat, DM, XW, (r / (XW / 256)) * 64, (r % (XW / 256)) * 256, 0, 0}; break; } r -= J_XQ; \
            if (r < J_XKV) { t_ = TrItem{w_xkv, Wxkv_t, nullptr, DM, 2 * XW, (r / (2 * XW / 256)) * 64, (r % (2 * XW / 256)) * 256, 0, 0}; break; } r -= J_XKV; \
            if (r < J_XO) { t_ = TrItem{w_xo, Wxo_t, nullptr, XW, DM, (r / (DM / 256)) * 64, (r % (DM / 256)) * 256, 0, 0}; break; } r -= J_XO; \
            if (r < J_G) { t_ = TrItem{w_gate, Wgu_t, g_ffn, DM, DFF, (r / (DFF / 256)) * 64, (r % (DFF / 256)) * 256, 2, 0}; break; } r -= J_G; \
            if (r < J_U) { t_ = TrItem{w_up, Wgu_t, g_ffn, DM, DFF, (r / (DFF / 256)) * 64, (r % (DFF / 256)) * 256, 3, 0}; break; } r -= J_U; \
            t_ = TrItem{w_down, Wdn_t, nullptr, DFF, DM, (r / (DM / 256)) * 64, (r % (DM / 256)) * 256, 0, 0}; } while (0)
#define TR_LOOP(LO, HI, RANK, NBLK) do { f32x4 v[8]; TrItem cur_, nxt_; int idx = (LO) + (RANK), par = 0; int lane_ = threadIdx.x & 63; asm volatile("" : "+v"(lane_));     \
            if (idx < (HI)) { TR_DECODE(cur_, idx); tr_issue(cur_, v, wave, lane_); } \
            for (; idx < (HI); idx += (NBLK), par ^= 1) { LAS unsigned* T = (LAS unsigned*)(ldsl + par * 34816); \
                tr_stage(cur_, v, T, wave, lane_); \
                const bool more = idx + (NBLK) < (HI); \
                if (more) { TR_DECODE(nxt_, idx + (NBLK)); tr_issue(nxt_, v, wave, lane_); } \
                __syncthreads(); \
                tr_readout(cur_, T, tid); \
                if (more) cur_ = nxt_; } \
            __syncthreads(); } while (0)
    if (IN(0)) { for (int rep_ = 0; rep_ <= ((MK_REP >> 0) & 1) * MK_REPN; ++rep_) { if (rep_) GRID_BAR();
        TR_LOOP(0, J_FFN0, B, G);
        for (int m = gw; m < M; m += NGW) { const float s = row_to_bf16(x_in + (size_t)m * DM, XB + (size_t)m * DM, nullptr, lane, XB8 + (size_t)m * DM); if (lane == 0) ssq1[m] = (ssq_t)(s * SSQ_SCALE + 0.5f); }
        for (int m = gw; m < BATCH * NMEM; m += NGW) (void)row_to_bf16(mem_in + (size_t)m * DM, memn + (size_t)m * DM, g_mem, lane);
        for (int e = B * 512 + tid; e < SEQ * 64; e += G * 512) { float c, s; rope_entry(e >> 6, e & 63, c, s); rope_c[e] = c; rope_s[e] = s; }
        for (int e = B * 512 + tid; e < NGRP * SCH * SCH; e += G * 512) { const int t = (e >> 7) & 127, s = e & 127; wsgu_t[e] = (bf16_t)(s <= t ? f2bf(w_sgu[e]) : 0u); }
        } if (BOTH(0)) GRID_BAR();
    }
    if (IN(1)) { for (int rep_ = 0; rep_ <= ((MK_REP >> 1) & 1) * MK_REPN; ++rep_) { if (rep_) GRID_BAR();
        { pg8::Gemm g{XB, Win_t, M, 4096, DM, DM}; pg8::StaticOrder S; S.init(M, 4096, G, B, 4);
          pg8::EpiIn<0> E{ssq1, rope_c, rope_s, Qb, Kb, Vb, Ub, VSb, SAb, SBb, kmpart, lnstat};
          pg8::gemm_phase<pg8::EpiIn<0>, pg8::StaticOrder, true, true, false>(ldsl, g, S, E); }
        { pg8::Gemm g{(const bf16_t*)XB8, (const bf16_t*)Win8, M, 14336, DM / 2, DM / 2}; pg8::StaticOrder S; S.init(M, 14336, G, B);
          pg8::EpiIn<1> E{ssq1, rope_c, rope_s, Qb, Kb, Vb, Ub, VSb, SAb, SBb, kmpart, lnstat};
          pg8::gemm_phase<pg8::EpiIn<1>, pg8::StaticOrder, true, true, true>(ldsl, g, S, E); }
        } if (BOTH(1)) GRID_BAR();
    }
    if (IN(3)) { for (int rep_ = 0; rep_ <= ((MK_REP >> 3) & 1) * MK_REPN; ++rep_) { if (rep_) GRID_BAR();
        if (B < 64 && G >= 128) {
            pg8::Gemm g{memn, Wxkv_t, BATCH * NMEM, 2 * XW, 512, DM}; pg8::MemKVOrder S{B};
            pg8::EpiPart E{kvpart};
            pg8::gemm_phase<pg8::EpiPart, pg8::MemKVOrder, true, true>(ldsl, g, S, E);
        }
        for (int j = B, rd = 0; j < 512; j += G, ++rd) { const int bh = j >> 4; int cc = j & 15; if (rd & 1) cc = 15 - cc;
            const int s = cc * 512 + tid, cur = __builtin_amdgcn_readfirstlane(s >> 8), b = bh >> 4, h = bh & 15;
            LAS float* kml = (LAS float*)ldsl;
            __syncthreads();
            { const int e8 = tid * 8, n_ = e8 >> 7, d_ = e8 & 127; const float* p0_ = kmpart + ((((size_t)(b * 32 + n_)) * NH + h) * 2) * HD + d_;
              const f32x4 a0 = *(const f32x4*)p0_, a1 = *(const f32x4*)(p0_ + 4), b0 = *(const f32x4*)(p0_ + HD), b1 = *(const f32x4*)(p0_ + HD + 4);
              *(LAS f32x4*)(kml + e8) = (a0 + b0) * (1.f / 256.f); *(LAS f32x4*)(kml + e8 + 4) = (a1 + b1) * (1.f / 256.f); }
            __syncthreads();
            int i0 = 0, i1 = 1, i2 = 2;
            if (cur > 3) {
                f32x4 qf[32]; const bf16_t* qp = Qb + (size_t)(b * SEQ + s) * AW + h * HD;
#pragma unroll
                for (int i = 0; i < 16; ++i) unpack8(*(const u32x4*)(qp + 8 * i), qf[2 * i], qf[2 * i + 1]);
                float v0 = -__builtin_inff(), v1 = v0, v2 = v0;
                for (int n = 0; n < cur; ++n) { const LAS float* kp = kml + n * HD; f32x4 dv = {0.f, 0.f, 0.f, 0.f};
#pragma unroll
                    for (int i = 0; i < 32; ++i) dv += qf[i] * *(const LAS f32x4*)(kp + 4 * i);
                    const float d0 = dv[0] + dv[2], d1 = dv[1] + dv[3];
                    const float gsc = d0 + d1;
                    if (gsc > v2) { if (gsc > v1) { v2 = v1; i2 = i1; if (gsc > v0) { v1 = v0; i1 = i0; v0 = gsc; i0 = n; } else { v1 = gsc; i1 = n; } } else { v2 = gsc; i2 = n; } } }
            }
            const int nv = cur < 3 ? cur : 3;
            LAS int* lc = (LAS int*)(ldsl + 137216); LAS int* gb = lc + 32;
            if (tid < 32) lc[tid] = 0;
            __syncthreads();
            int lp0 = 0, lp1 = 0, lp2 = 0;
            if (nv > 0) lp0 = __hip_atomic_fetch_add(lc + i0, 1, __ATOMIC_RELAXED, __HIP_MEMORY_SCOPE_WORKGROUP);
            if (nv > 1) lp1 = __hip_atomic_fetch_add(lc + i1, 1, __ATOMIC_RELAXED, __HIP_MEMORY_SCOPE_WORKGROUP);
            if (nv > 2) lp2 = __hip_atomic_fetch_add(lc + i2, 1, __ATOMIC_RELAXED, __HIP_MEMORY_SCOPE_WORKGROUP);
            __syncthreads();
            if (tid < 32) { const int c_ = lc[tid]; gb[tid] = c_ > 0 ? (int)atomicAdd((rep_ ? ctl + CW_PCNT2 : lcnt) + bh * 32 + tid, (unsigned)c_) : 0; }
            __syncthreads();
            unsigned short* lists_ = rep_ ? (unsigned short*)(ws + WS_SA + 80 * MiB) : lists;
            if (nv > 0) lists_[(size_t)(bh * 32 + i0) * 8192 + gb[i0] + lp0] = (unsigned short)s;
            if (nv > 1) lists_[(size_t)(bh * 32 + i1) * 8192 + gb[i1] + lp1] = (unsigned short)(s | (1 << 13));
            if (nv > 2) lists_[(size_t)(bh * 32 + i2) * 8192 + gb[i2] + lp2] = (unsigned short)(s | (2 << 13));
            __syncthreads();
        }

        for (int u = B; u < 2 * (M / SCH); u += G) sgu_unit(u, VSb, lnstat, Ub, rep_ ? (bf16_t*)(ws + WS_SB + 64 * MiB) : OB, wsgu_t, ln_g, ln_b, b_sgu, (char*)lds, tid, wave, lane);
        } if (BOTH(3)) GRID_BAR();
    }
    if (IN(4)) { for (int rep_ = 0; rep_ <= ((MK_REP >> 4) & 1) * MK_REPN; ++rep_) { if (rep_) GRID_BAR();
        {
            int* pre = (int*)((char*)lds + 137216); int* wtot = pre + 1028;
            { const int c0_ = (int)((lcnt[2 * tid] + 255u) >> 8), c1_ = (int)((lcnt[2 * tid + 1] + 255u) >> 8), a_ = 4 * c0_ + 3 * (c0_ > 0), b_ = 4 * c1_ + 3 * (c1_ > 0); int v = a_ + b_;
#pragma unroll
              for (int o_ = 1; o_ < 64; o_ <<= 1) { const int t2 = __shfl_up(v, o_); if (lane >= o_) v += t2; }
              if (lane == 63) wtot[wave] = v;
              __syncthreads();
              int off = 0; for (int w_ = 0; w_ < wave; ++w_) off += wtot[w_];
              v += off; pre[2 * tid] = v - a_ - b_; pre[2 * tid + 1] = v - b_; if (tid == 511) pre[1024] = v;
              __syncthreads(); }
            const int T = pre[1024]; const int glo = (int)((long)B * T / G), ghi = (int)((long)(B + 1) * T / G);
            for (int pass_ = 0; pass_ <= ((MK_REP >> 23) & 1); ++pass_) {
            int li = 0;
            for (int g_ = glo; g_ < ghi;) {
                while (pre[li + 1] <= g_) ++li;
                const int nch = (pre[li + 1] - pre[li] - 3) >> 2, rend = pre[li + 1] < ghi ? pre[li + 1] : ghi;
                int c_lo = (g_ - pre[li] - 3 + 3) >> 2; if (g_ - pre[li] - 3 < 0) c_lo = 0; int c_hi = (rend - pre[li] - 3 + 3) >> 2; if (rend - pre[li] - 3 < 0) c_hi = 0; if (c_hi > nch) c_hi = nch;
                g_ = rend;
                if (c_hi <= c_lo) continue;
                const int cntl = (int)lcnt[li], bh = li >> 5, n = li & 31, b = bh >> 4, h = bh & 15; (void)nch;
                __syncthreads();
                att::gather_load_kv(Kb + (size_t)(b * SEQ + n * 256) * AW + h * HD, Vb + (size_t)(b * SEQ + n * 256) * AW + h * HD, (char*)lds);
                __syncthreads();
                att::gather_run(Qb + (size_t)(b * SEQ) * AW + h * HD, lists + (size_t)li * 8192, c_lo, c_hi, cntl, P01, P2, LSE, (size_t)bh * SEQ, (char*)lds);
            } }
        }
        } if (BOTH(4)) GRID_BAR();
    }
    if (IN(5)) { for (int rep_ = 0; rep_ <= ((MK_REP >> 5) & 1) * MK_REPN; ++rep_) { if (rep_) GRID_BAR();
        for (int e = B * 512 + tid; e < BATCH * NMEM * 2 * XW / 4; e += G * 512) { f32x4 a = ((const f32x4*)kvpart)[e];
#pragma unroll
            for (int k = 1; k < 8; ++k) a += ((const f32x4*)kvpart)[e + k * (BATCH * NMEM * 2 * XW / 4)];
            u32x2 o; o.x = cvt_pk_bf16(a[0], a[1]); o.y = cvt_pk_bf16(a[2], a[3]); ((u32x2*)memkv)[e] = o; }
        if (B < BATCH * NH * 32) {
            att::Seam S; int unit = B;
            att::BlockRef cur = own_ref(unit, Qb, Kb, Vb, OA, LSE3); att::prime<AW, AW>(cur, (char*)lds, S);
            for (;;) { const int nunit = unit + G; const bool last = nunit >= BATCH * NH * 32;
                const att::BlockRef nxt = last ? cur : own_ref(nunit, Qb, Kb, Vb, OA, LSE3);
                att::block<AW, AW, HD, true>(cur, nxt, SEQ, (char*)lds, S);
                {
                    const int bh = unit >> 5, cq = unit & 31, nv = cq < 3 ? cq : 3, b = bh >> 4, h = bh & 15;
                    const bf16_t* Ot = (const bf16_t*)((char*)lds + OT_OFF); const float* Ol = (const float*)((char*)lds + OTL_OFF);
                    int tid_c = threadIdx.x; asm volatile("" : "+v"(tid_c));
#pragma unroll 2
                    for (int i = 0; i < 8; ++i) { const int it = tid_c + 512 * i, rr = it >> 4, c = it & 15; const size_t row = (size_t)bh * SEQ + cq * 256 + rr;
                        const float l3 = Ol[rr]; float lj[3]; float lmax = l3;
#pragma unroll
                        for (int j = 0; j < 3; ++j) { lj[j] = j < nv ? LSE[(size_t)j * (BATCH * NH * SEQ) + row] : -__builtin_inff(); lmax = fmaxf(lmax, lj[j]); }
                        const float w3 = __builtin_amdgcn_exp2f(l3 - lmax); float wsum = w3;
                        f32x4 a0, a1; unpack8(*(const u32x4*)(Ot + rr * HD + c * 8), a0, a1); a0 *= w3; a1 *= w3;
#pragma unroll
                        for (int j = 0; j < 3; ++j) if (j < nv) { const float wj = __builtin_amdgcn_exp2f(lj[j] - lmax); wsum += wj;
                            const unsigned char* pp = (const unsigned char*)(j < 2 ? P01 + (size_t)j * ((size_t)BATCH * NH * SEQ * HD) : P2) + row * HD + c * 8;
                            const u32x2 pw = *(const u32x2*)pp; const float wj8 = wj * (1.f / OA8_SCALE); a0 += up4_fp8(pw.x) * wj8; a1 += up4_fp8(pw.y) * wj8; }
                        const float rw = __builtin_amdgcn_rcpf(wsum);
                        a0 *= rw * OA8_SCALE; a1 *= rw * OA8_SCALE; u32x2 w8; w8.x = pk4_fp8(a0[0], a0[1], a0[2], a0[3]); w8.y = pk4_fp8(a1[0], a1[1], a1[2], a1[3]);
                        *(u32x2*)(OA8 + (size_t)(b * SEQ + cq * 256 + rr) * AW + h * HD + c * 8) = w8; }
                }
                if (last) break;
                cur = nxt; unit = nunit; }
        }
        } if (BOTH(5)) GRID_BAR();
    }
    if (IN(7)) { for (int rep_ = 0; rep_ <= ((MK_REP >> 7) & 1) * MK_REPN; ++rep_) { if (rep_) GRID_BAR();
        { pg8::Gemm g{(const bf16_t*)OA8, Pcat_t, M, DM, AW / 2, AW / 2}; pg8::StaticOrder S; S.init(M, DM, G, B, 4);
          pg8::EpiBranch<0> E{SAb, MG};
          pg8::gemm_phase<pg8::EpiBranch<0>, pg8::StaticOrder, true, true, true>(ldsl, g, S, E); }
        { pg8::Gemm g{OB, Pcat_t + (size_t)DM * AW, M, DM, AW, AW}; pg8::StaticOrder S; S.init(M, DM, G, B, 4);
          pg8::EpiBranch<1> E{SBb, MG};
          pg8::gemm_phase<pg8::EpiBranch<1>, pg8::StaticOrder, true, true, false>(ldsl, g, S, E); }
        } if (BOTH(7)) GRID_BAR();
    }
    if (IN(8)) { for (int rep_ = 0; rep_ <= ((MK_REP >> 8) & 1) * MK_REPN; ++rep_) { if (rep_) GRID_BAR();
        pg8::Gemm g{MG, Wout_t, M, DM, DM, DM}; pg8::StaticOrder S; S.init(M, DM, G, B, 4);
        pg8::EpiResid E{nullptr, XB, rep_ ? (bf16_t*)(ws + WS_SB) : XB, rep_ ? (ssq_t*)(ws + 13 * MiB) : ssq2};
        pg8::gemm_phase<pg8::EpiResid, pg8::StaticOrder, true, true>(ldsl, g, S, E);
        } if (BOTH(8)) GRID_BAR();
    }
    if (IN(9)) { for (int rep_ = 0; rep_ <= ((MK_REP >> 9) & 1) * MK_REPN; ++rep_) { if (rep_) GRID_BAR();
        pg8::Gemm g{XB, Wxq_t, M, XW, DM, DM}; pg8::StaticOrder S; S.init(M, XW, G, B);
        pg8::EpiScale E{ssq2, QX, XW};
        pg8::gemm_phase<pg8::EpiScale, pg8::StaticOrder, true, true>(ldsl, g, S, E);
        { pg8::Unit uq;
          if (G == 256 && S.next(0, uq)) {
            att::Seam AS; const int ub = (uq.pm >> 5) * 128 + (uq.pn * 2) * 32 + (uq.pm & 31);
            att::BlockRef cur = xattn_ref(ub, QX, memkv, OX); att::prime<XW, 2 * XW>(cur, (char*)lds, AS);
#pragma nounroll
            for (int k_ = 0; k_ < 2; ++k_) { const att::BlockRef nxt = xattn_ref(ub + 32, QX, memkv, OX);
                att::block<XW, 2 * XW, XW>(cur, nxt, NMEM, (char*)lds, AS); cur = nxt; } } }
        { constexpr int NXQ = (M / 256) * (XW / 256);
          if (G > NXQ) { if (B >= NXQ) TR_LOOP(J_FFN0, J_DN0, B - NXQ, G - NXQ); } else TR_LOOP(J_FFN0, J_DN0, B, G); }
        } if (BOTH(9)) GRID_BAR();
    }
    if (IN(11)) { for (int rep_ = 0; rep_ <= ((MK_REP >> 11) & 1) * MK_REPN; ++rep_) { if (rep_) GRID_BAR();
        pg8::Gemm g{OX, Wxo_t, M, DM, XW, XW}; pg8::StaticOrder S; S.init(M, DM, G, B, 4);
        pg8::EpiResid E{nullptr, XB, rep_ ? (bf16_t*)(ws + WS_SB) : XB, rep_ ? (ssq_t*)(ws + 13 * MiB) : ssq3};
        pg8::gemm_phase<pg8::EpiResid, pg8::StaticOrder, true, true>(ldsl, g, S, E);
        } if (BOTH(11)) GRID_BAR();
    }
    if (IN(12)) { for (int rep_ = 0; rep_ <= ((MK_REP >> 12) & 1) * MK_REPN; ++rep_) { if (rep_) GRID_BAR();
        pg8::Gemm g{XB, Wgu_t, M, 2 * DFF, DM, DM}; pg8::StaticOrder S; S.init(M, 2 * DFF, G, B);
        pg8::EpiGU E{ssq3, ACT};
        pg8::gemm_phase<pg8::EpiGU, pg8::StaticOrder, true, true>(ldsl, g, S, E);
        { const int rem = ((M / 256) * (2 * DFF / 256)) % G;
          if (rem != 0) { if (B >= rem) TR_LOOP(J_DN0, NJ, B - rem, G - rem); } else TR_LOOP(J_DN0, NJ, B, G); }
        } if (BOTH(12)) GRID_BAR();
    }
    if (IN(13)) { for (int rep_ = 0; rep_ <= ((MK_REP >> 13) & 1) * MK_REPN; ++rep_) { if (rep_) GRID_BAR();
        pg8::Gemm g{ACT, Wdn_t, M, DM, DFF, DFF};
        pg8::EpiResid E{nullptr, XB, rep_ ? (bf16_t*)(ws + WS_SB) : XB, rep_ ? (ssq_t*)(ws + 13 * MiB) : ssq4};
        pg8::StaticOrder S; S.init(M, DM, G, B, 4); pg8::gemm_phase<pg8::EpiResid, pg8::StaticOrder, true, true>(ldsl, g, S, E);
        } if (BOTH(13)) GRID_BAR();
    }
    if (IN(14)) { for (int rep_ = 0; rep_ <= ((MK_REP >> 14) & 1) * MK_REPN; ++rep_) { if (rep_) GRID_BAR();
        int lane_ = threadIdx.x & 63; asm volatile("" : "+v"(lane_));
        for (int m = (int)blockIdx.x * NWAVES + (int)(threadIdx.x >> 6); m < M; m += NGW) { const float r = rs_of(ssq4, m); GAS f32x4* p = (GAS f32x4*)(out_f + (size_t)m * DM) + 2 * lane_; const GAS u32x4* xp = (const GAS u32x4*)(XB + (size_t)m * DM) + lane_;
#pragma unroll
            for (int j = 0; j < 8; ++j) { f32x4 a0, a1; unpack8(xp[64 * j], a0, a1); const GAS f32x4* gp = (const GAS f32x4*)g_fin + 2 * lane_ + 128 * j;
                p[128 * j] = a0 * gp[0] * r; p[128 * j + 1] = a1 * gp[1] * r; } }
    } }
#undef IN
#undef BOTH
}

#undef ctl
#undef ssq1
#undef ssq2
#undef ssq3
#undef ssq4
#undef x_in
#undef mem_in
#undef g_mix
#undef w_in
#undef ln_g
#undef ln_b
#undef w_sgu
#undef b_sgu
#undef w_pa
#undef w_pb
#undef w_out
#undef g_xat
#undef g_mem
#undef w_xq
#undef w_xkv
#undef w_xo
#undef g_ffn
#undef w_gate
#undef w_up
#undef w_down
#undef g_fin
#undef out_f
#undef kmpart
#undef LSE3
#undef LSE
#undef lcnt
#undef lists
#undef P01
#undef P2
#undef rope_c
#undef rope_s
#undef kvpart
#undef wsgu_t
#undef memkv
#undef memn
#undef Win_t
#undef Pcat_t
#undef Wout_t
#undef Wxq_t
#undef Wxkv_t
#undef Wxo_t
#undef Wgu_t
#undef Wdn_t
#undef XB
#undef OA
#undef OB
#undef Qb
#undef Ub
#undef Kb
#undef Vb
#undef VSb
#undef SAb
#undef SBb
#undef MG
#undef QX
#undef OX
#undef ACT
extern "C" void kernel_launch(void* const* d_in, const int* in_sizes, int n_in, void* d_out, int out_size, void* d_ws, size_t ws_size, hipStream_t stream) {
    static int grid = 0;
    if (grid == 0) {
        if (n_in != 21 || in_sizes[0] != M * DM || out_size != M * DM || ws_size < WS_END) { fprintf(stderr, "kernel_launch: unexpected shapes / workspace (n_in %d, ws %zu < %zu); nothing launched\n", n_in, ws_size, (size_t)WS_END); grid = -1; return; }
        int dev = 0, cus = 0, per_cu = 0;
        if (hipGetDevice(&dev) != hipSuccess || hipDeviceGetAttribute(&cus, hipDeviceAttributeMultiprocessorCount, dev) != hipSuccess) { grid = -1; return; }
        if (hipFuncSetAttribute((const void*)mk_fwd, hipFuncAttributeMaxDynamicSharedMemorySize, LDS_BYTES) != hipSuccess) { fprintf(stderr, "kernel_launch: hipFuncSetAttribute failed\n"); grid = -1; return; }
        if (hipOccupancyMaxActiveBlocksPerMultiprocessor(&per_cu, (const void*)mk_fwd, NWAVES * 64, LDS_BYTES) != hipSuccess || per_cu < 1) { fprintf(stderr, "kernel_launch: occupancy query reports %d workgroups per CU\n", per_cu); }
        (void)hipGetLastError();
        if (cus < 256) { fprintf(stderr, "kernel_launch: this kernel's phase program is dealt over exactly 256 workgroups, one per CU; the device has %d CUs; nothing launched\n", cus); grid = -1; return; }
        grid = 256;
    }
    if (grid < 0) return;
    (void)hipMemsetAsync((char*)d_ws + WS_CTL, 0, CTL_ZERO_BYTES, stream);
    Args a{};
    for (int i = 0; i < 21; ++i) a.in[i] = (const float*)d_in[i];
    a.out = (float*)d_out; a.ws = (unsigned char*)d_ws;
#if MK_PER_PHASE
    for (int p = 0; p < N_PHASES; ++p) { a.ph_lo = p; a.ph_hi = p + 1; hipLaunchKernelGGL(mk_fwd, dim3(grid), dim3(NWAVES * 64), LDS_BYTES, stream, a); }
#else
    a.ph_lo = 0; a.ph_hi = N_PHASES; hipLaunchKernelGGL(mk_fwd, dim3(grid), dim3(NWAVES * 64), LDS_BYTES, stream, a);
#endif
}
```

```cpp
#include <hip/hip_runtime.h>
#include <cstdio>
#include <cstdint>

#ifndef MK_REP
#define MK_REP 0
#endif
#ifndef MK_REPN
#define MK_REPN 1
#endif
#ifndef MK_PER_PHASE
#define MK_PER_PHASE 0
#endif

#define GAS __attribute__((address_space(1)))
#define LAS __attribute__((address_space(3)))
typedef unsigned short bf16_t;
typedef short bf16x8 __attribute__((ext_vector_type(8)));
typedef short s16x4 __attribute__((ext_vector_type(4)));
typedef float f32x2 __attribute__((ext_vector_type(2)));
typedef float f32x4 __attribute__((ext_vector_type(4)));
typedef float f32x16 __attribute__((ext_vector_type(16)));
typedef unsigned u32x2 __attribute__((ext_vector_type(2)));
typedef unsigned u32x4 __attribute__((ext_vector_type(4)));

constexpr int BATCH = 2, SEQ = 8192, M = BATCH * SEQ, DM = 4096, HD = 128, NH = 16, AW = 2048, SW = 2048, NIN = 18432, DFF = 11008, NMEM = 256, XH = 4, XW = 512;
constexpr int NGRP = 16, SCH = 128;
constexpr float RMS_EPS = 1e-6f, LN_EPS = 1e-5f;

typedef __bf16 bf16x2_t __attribute__((ext_vector_type(2)));
__device__ __forceinline__ unsigned cvt_pk_bf16(float lo, float hi) { f32x2 v = {lo, hi}; bf16x2_t b = __builtin_convertvector(v, bf16x2_t); return __builtin_bit_cast(unsigned, b); }
__device__ __forceinline__ u32x4 pack8f(f32x4 a, f32x4 b) { u32x4 w; w.x = cvt_pk_bf16(a[0], a[1]); w.y = cvt_pk_bf16(a[2], a[3]); w.z = cvt_pk_bf16(b[0], b[1]); w.w = cvt_pk_bf16(b[2], b[3]); return w; }
__device__ __forceinline__ float bflo(unsigned w) { return __builtin_bit_cast(float, w << 16); }
__device__ __forceinline__ float bfhi(unsigned w) { return __builtin_bit_cast(float, w & 0xffff0000u); }
__device__ __forceinline__ void unpack8(u32x4 w, f32x4& a, f32x4& b) { a = (f32x4){bflo(w.x), bfhi(w.x), bflo(w.y), bfhi(w.y)}; b = (f32x4){bflo(w.z), bfhi(w.z), bflo(w.w), bfhi(w.w)}; }
typedef int i32x4v __attribute__((ext_vector_type(4)));
typedef int i32x8v __attribute__((ext_vector_type(8)));
__device__ __forceinline__ f32x4 up4_fp8(unsigned w) { const auto lo = __builtin_amdgcn_cvt_pk_f32_fp8(w, false), hi = __builtin_amdgcn_cvt_pk_f32_fp8(w, true); return (f32x4){lo[0], lo[1], hi[0], hi[1]}; }
__device__ __forceinline__ unsigned pk4_fp8(float a, float b, float c, float d) { unsigned w = 0; w = __builtin_amdgcn_cvt_pk_fp8_f32(a, b, w, false); w = __builtin_amdgcn_cvt_pk_fp8_f32(c, d, w, true); return w; }
constexpr float X8_SCALE = 16.f, W8_SCALE = 1024.f, ACC8_SCALE = 1.f / (16.f * 1024.f), OA8_SCALE = 32.f, ACCA_SCALE = 1.f / (32.f * 1024.f);
typedef unsigned long long ssq_t;
constexpr float SSQ_SCALE = 16777216.f;
__device__ __forceinline__ float rs_of(const ssq_t* p, int row) { return __builtin_amdgcn_rsqf((float)p[row] * (1.f / (SSQ_SCALE * 4096.f)) + 1e-6f); }
__device__ __forceinline__ float sigmoidf_(float v) { return __builtin_amdgcn_rcpf(1.f + __builtin_amdgcn_exp2f(-1.4426950408889634f * v)); }
__device__ __forceinline__ float gelu_tanh(float v) { const float y = 0.7978845608028654f * (v + 0.044715f * v * v * v); return v * __builtin_amdgcn_rcpf(1.f + __builtin_amdgcn_exp2f(-2.8853900817779268f * y)); }
__device__ __forceinline__ f32x4 gelu4(f32x4 v) { return (f32x4){gelu_tanh(v[0]), gelu_tanh(v[1]), gelu_tanh(v[2]), gelu_tanh(v[3])}; }
__device__ __forceinline__ f32x4 sigm4(f32x4 v) { return (f32x4){sigmoidf_(v[0]), sigmoidf_(v[1]), sigmoidf_(v[2]), sigmoidf_(v[3])}; }

namespace pg8 {
constexpr int BM = 256, BK = 64, HALF = 128, HTB = HALF * BK * 2, STAGE_BYTES = 8 * HTB, NXCD = 8, WGM = 8;
__host__ __device__ __forceinline__ int lds_byte(int r, int c) { const int st = (r >> 4) * 2 + (c >> 5), rr = r & 15, cc = c & 31, ob = rr * 64 + cc * 2; return st * 1024 + (ob ^ (((ob >> 9) & 1) << 5)); }
__host__ __device__ __forceinline__ void stage_rc(int b, int& R, int& C) { const int st = b / 1024, sb = b % 1024, swz = sb ^ (((sb >> 9) & 1) << 5); R = (st >> 1) * 16 + swz / 64; C = (st & 1) * 32 + (swz % 64) / 2; }
__host__ __device__ __forceinline__ int perm32(int rho) { const int n = rho >> 4, i = rho & 15; return 8 * (i >> 2) + 4 * n + (i & 3); }
struct Unit { int pm, pn, ko; };
struct Gemm { const bf16_t* A; const bf16_t* Bt; int M, N, K, ld; };
struct StaticOrder {
    int nM, nN, nwg, G, c, wgm;
    __host__ __device__ void init(int M_, int N_, int G_, int c_, int wgm_ = WGM) { nM = M_ / BM; nN = N_ / BM; nwg = nM * nN; G = G_; c = c_; wgm = wgm_; }
    __host__ __device__ __forceinline__ bool next(int i, Unit& u) const {
        const long L = (long)i * G + c; if (L >= nwg) return false;
        int wgid = (int)L; { const int q = nwg / NXCD, r = nwg % NXCD, xcd = wgid % NXCD, off = wgid / NXCD; wgid = (xcd < r ? xcd * (q + 1) : r * (q + 1) + (xcd - r) * q) + off; }
        const int nig = wgm * nN, gid = wgid / nig, fm = gid * wgm, gsz = (nM - fm) < wgm ? (nM - fm) : wgm;
        u.pm = fm + ((wgid % nig) % gsz); u.pn = (wgid % nig) / gsz; u.ko = 0; return true;
    }
    __device__ __forceinline__ void a_ready(const Unit&) const {}
    __device__ __forceinline__ void done(const Unit&) const {}
};

struct MemKVOrder {
    int c;
    __device__ bool next(int i, Unit& u) const { if (i > 0 || c >= 64) return false; u.pm = c & 1; u.pn = (c >> 1) & 3; u.ko = (c >> 3) * 512; return true; }
    __device__ __forceinline__ void a_ready(const Unit&) const {}
    __device__ __forceinline__ void done(const Unit&) const {}
};

template <int MODE> struct EpiIn {
    static constexpr bool PERM = true, AFTER_DRAIN = false;
    const ssq_t* ssq; const float* rc; const float* rsn; bf16_t *Q, *K, *V, *U, *VS; unsigned char *SA, *SB; float* kmpart; unsigned long long* lnstat;
    __device__ __forceinline__ bool keep(const Unit&) const { return false; }
    __device__ __forceinline__ void operator()(f32x4 (&acc)[2][2][4][2], const Unit& un, int wr, int wc, int fr, int fq) const {
        asm volatile("" : "+v"(fr), "+v"(fq));
        const int rowb = un.pm * BM + wr * 64 + fr, pn = MODE ? (un.pn < 24 ? un.pn : un.pn + 16) : un.pn + 24;
        float rsc[2][4];
#pragma unroll
        for (int ai = 0; ai < 2; ++ai)
#pragma unroll
            for (int m = 0; m < 4; ++m) rsc[ai][m] = rs_of(ssq, rowb + ai * HALF + m * 16) * (MODE ? ACC8_SCALE : 1.f);
        if (MODE == 1 && pn < 16) {
            bf16_t* dst = pn < 8 ? Q : K; const int head = (pn & 7) * 2 + (wc >> 1), dd0 = 32 * (wc & 1) + 8 * fq;
            f32x4 cs[4] = {};
            f32x4 tc[2][2][2], ts[2][2][2];
#pragma unroll
            for (int mm = 0; mm < 2; ++mm) { const int pos = (rowb + mm * 16) & (SEQ - 1);
                tc[0][mm][0] = *(const f32x4*)(rc + pos * 64 + dd0); tc[0][mm][1] = *(const f32x4*)(rc + pos * 64 + dd0 + 4); ts[0][mm][0] = *(const f32x4*)(rsn + pos * 64 + dd0); ts[0][mm][1] = *(const f32x4*)(rsn + pos * 64 + dd0 + 4); }
#pragma unroll
            for (int am = 0; am < 4; ++am) {
                const int ai = am >> 1, m0 = (am & 1) * 2, bf = am & 1;
                u32x4 ow[2][2];
#pragma unroll
                for (int mm = 0; mm < 2; ++mm) { const int m = m0 + mm; const float r = rsc[ai][m];
                    const f32x4 c0 = tc[bf][mm][0], c1 = tc[bf][mm][1], s0 = ts[bf][mm][0], s1 = ts[bf][mm][1];
                    const f32x4 x1a = acc[ai][0][m][0] * r, x1b = acc[ai][0][m][1] * r, x2a = acc[ai][1][m][0] * r, x2b = acc[ai][1][m][1] * r;
                    const f32x4 o1a = x1a * c0 - x2a * s0, o1b = x1b * c1 - x2b * s1, o2a = x2a * c0 + x1a * s0, o2b = x2b * c1 + x1b * s1;
                    cs[0] += o1a; cs[1] += o1b; cs[2] += o2a; cs[3] += o2b;
                    ow[mm][0] = pack8f(o1a, o1b); ow[mm][1] = pack8f(o2a, o2b); }
                if (am < 3) { const int an = am + 1, ai2 = an >> 1, m2 = (an & 1) * 2;
#pragma unroll
                    for (int mm = 0; mm < 2; ++mm) { const int pos = (rowb + ai2 * HALF + (m2 + mm) * 16) & (SEQ - 1);
                        tc[bf ^ 1][mm][0] = *(const f32x4*)(rc + pos * 64 + dd0); tc[bf ^ 1][mm][1] = *(const f32x4*)(rc + pos * 64 + dd0 + 4); ts[bf ^ 1][mm][0] = *(const f32x4*)(rsn + pos * 64 + dd0); ts[bf ^ 1][mm][1] = *(const f32x4*)(rsn + pos * 64 + dd0 + 4); } }
#pragma unroll
                for (int mm = 0; mm < 2; ++mm) { const int row = rowb + ai * HALF + (m0 + mm) * 16;
                    bf16_t* p = dst + (size_t)row * AW + head * HD + dd0;
                    *(u32x4*)p = ow[mm][0];
                    *(u32x4*)(p + 64) = ow[mm][1]; } }
            if (pn >= 8) {
#pragma unroll
                for (int q = 0; q < 4; ++q)
#pragma unroll
                    for (int j = 0; j < 4; ++j) { float v = cs[q][j]; v += __shfl_xor(v, 1); v += __shfl_xor(v, 2); v += __shfl_xor(v, 4); v += __shfl_xor(v, 8); cs[q][j] = v; }
                if (fr == 0) { float* kp = kmpart + (((size_t)un.pm * NH + head) * 2 + wr) * HD + dd0;
                    *(f32x4*)kp = cs[0]; *(f32x4*)(kp + 4) = cs[1]; *(f32x4*)(kp + 64) = cs[2]; *(f32x4*)(kp + 68) = cs[3]; } }
        } else if (MODE == 1 && pn < 24) {
            const int col0 = (pn - 16) * BM + wc * 32 + 8 * fq;
#pragma unroll
            for (int ai = 0; ai < 2; ++ai)
#pragma unroll
                for (int m = 0; m < 4; ++m) { const int row = rowb + ai * HALF + m * 16; const float r = rsc[ai][m];
#pragma unroll
                    for (int bj = 0; bj < 2; ++bj) *(u32x4*)(V + (size_t)row * AW + col0 + bj * HALF) = pack8f(acc[ai][bj][m][0] * r, acc[ai][bj][m][1] * r); }
        } else if (MODE == 0 && pn < 40) {
            bf16_t* dst = pn < 32 ? U : VS; const int col0 = ((pn - 24) & 7) * BM + wc * 32 + 8 * fq;
#pragma unroll
            for (int ai = 0; ai < 2; ++ai)
#pragma unroll
                for (int m = 0; m < 4; ++m) { const int row = rowb + ai * HALF + m * 16; const float r = rsc[ai][m];
                    float s1 = 0.f, s2 = 0.f;
#pragma unroll
                    for (int bj = 0; bj < 2; ++bj) { const f32x4 g0 = gelu4(acc[ai][bj][m][0] * r), g1 = gelu4(acc[ai][bj][m][1] * r);
                        *(u32x4*)(dst + (size_t)row * SW + col0 + bj * HALF) = pack8f(g0, g1);
                        s1 += (g0[0] + g0[1]) + (g0[2] + g0[3]) + (g1[0] + g1[1]) + (g1[2] + g1[3]);
                        s2 += (g0[0] * g0[0] + g0[1] * g0[1]) + (g0[2] * g0[2] + g0[3] * g0[3]) + (g1[0] * g1[0] + g1[1] * g1[1]) + (g1[2] * g1[2] + g1[3] * g1[3]); }
                    if (pn >= 32) {
                        s1 += __shfl_xor(s1, 16); s1 += __shfl_xor(s1, 32); s2 += __shfl_xor(s2, 16); s2 += __shfl_xor(s2, 32);
                        if (fq == 0) { atomicAdd(lnstat + 2 * row, (unsigned long long)(long long)__builtin_rintf(s1 * SSQ_SCALE)); atomicAdd(lnstat + 2 * row + 1, (unsigned long long)(long long)__builtin_rintf(s2 * SSQ_SCALE)); } } }
        } else if (MODE == 1) {
            unsigned char* dst = (pn < 56 ? SA : SB) + ((size_t)(un.pm * 16 + ((pn - 40) & 15)) * 8) * 8192 + (size_t)(wr * 4 + wc) * 1024 + (fq * 16 + fr) * 16;
#pragma unroll
            for (int ai = 0; ai < 2; ++ai)
#pragma unroll
                for (int m = 0; m < 4; ++m) { const float r = rsc[ai][m]; u32x4 w;
#pragma unroll
                    for (int bj = 0; bj < 2; ++bj) { const f32x4 s0 = sigm4(acc[ai][bj][m][0] * r) * 255.f + 0.5f, s1 = sigm4(acc[ai][bj][m][1] * r) * 255.f + 0.5f;
                        const unsigned lo = (unsigned)s0[0] | ((unsigned)s0[1] << 8) | ((unsigned)s0[2] << 16) | ((unsigned)s0[3] << 24), hi_ = (unsigned)s1[0] | ((unsigned)s1[1] << 8) | ((unsigned)s1[2] << 16) | ((unsigned)s1[3] << 24);
                        if (bj == 0) { w.x = lo; w.y = hi_; } else { w.z = lo; w.w = hi_; } }
                    *(u32x4*)(dst + (size_t)(ai * 4 + m) * 8192) = w; }
        }
    }
};
struct EpiPart {
    static constexpr bool PERM = true, AFTER_DRAIN = false;
    float* P;
    __device__ __forceinline__ bool keep(const Unit&) const { return false; }
    __device__ __forceinline__ void operator()(f32x4 (&acc)[2][2][4][2], const Unit& un, int wr, int wc, int fr, int fq) const {
        const int rowb = un.pm * BM + wr * 64 + fr, col0 = un.pn * BM + wc * 32 + 8 * fq; float* base = P + (size_t)(un.ko >> 9) * (BATCH * NMEM * 2 * XW);
#pragma unroll
        for (int ai = 0; ai < 2; ++ai)
#pragma unroll
            for (int m = 0; m < 4; ++m)
#pragma unroll
                for (int bj = 0; bj < 2; ++bj) { float* p = base + (size_t)(rowb + ai * HALF + m * 16) * (2 * XW) + col0 + bj * HALF; *(f32x4*)p = acc[ai][bj][m][0]; *(f32x4*)(p + 4) = acc[ai][bj][m][1]; }
    }
};
struct EpiScale {
    static constexpr bool PERM = true, AFTER_DRAIN = false;
    const ssq_t* ssq; bf16_t* O; int ldc;
    __device__ __forceinline__ bool keep(const Unit&) const { return false; }
    __device__ __forceinline__ void operator()(f32x4 (&acc)[2][2][4][2], const Unit& un, int wr, int wc, int fr, int fq) const {
        const int rowb = un.pm * BM + wr * 64 + fr, col0 = un.pn * BM + wc * 32 + 8 * fq;
        float rsc[2][4];
#pragma unroll
        for (int ai = 0; ai < 2; ++ai)
#pragma unroll
            for (int m = 0; m < 4; ++m) rsc[ai][m] = ssq ? rs_of(ssq, rowb + ai * HALF + m * 16) : 1.f;
#pragma unroll
        for (int ai = 0; ai < 2; ++ai)
#pragma unroll
            for (int m = 0; m < 4; ++m) { const int row = rowb + ai * HALF + m * 16; const float r = rsc[ai][m];
#pragma unroll
                for (int bj = 0; bj < 2; ++bj) *(u32x4*)(O + (size_t)row * ldc + col0 + bj * HALF) = pack8f(acc[ai][bj][m][0] * r, acc[ai][bj][m][1] * r); }
    }
};
template <int BR> struct EpiBranch {
    static constexpr bool PERM = true, AFTER_DRAIN = false;
    const unsigned char* S8; bf16_t* O; unsigned char* P8;
    static constexpr float PB_SCALE = 64.f;
    __device__ __forceinline__ bool keep(const Unit&) const { return false; }
    static __device__ __forceinline__ f32x4 ub4(unsigned w) { return (f32x4){(float)(w & 255u), (float)((w >> 8) & 255u), (float)((w >> 16) & 255u), (float)(w >> 24)}; }
    static __device__ __forceinline__ unsigned pk4v(f32x4 v) { return pk4_fp8(v[0], v[1], v[2], v[3]); }
    __device__ __forceinline__ void operator()(f32x4 (&acc)[2][2][4][2], const Unit& un, int wr, int wc, int fr, int fq) const {
        asm volatile("" : "+v"(fr), "+v"(fq));
        const int rowb = un.pm * BM + wr * 64 + fr, col0 = un.pn * BM + wc * 32 + 8 * fq;
        const size_t goff = ((size_t)(un.pm * 16 + un.pn) * 8) * 8192 + (size_t)(wr * 4 + wc) * 1024 + (fq * 16 + fr) * 16;
        if constexpr (BR == 0) {
            constexpr float SC = ACCA_SCALE * (1.f / 255.f) * PB_SCALE;
            u32x4 wgs[2][4];
#pragma unroll
            for (int ai = 0; ai < 2; ++ai)
#pragma unroll
                for (int m = 0; m < 4; ++m) wgs[ai][m] = *(const u32x4*)(S8 + goff + (size_t)(ai * 4 + m) * 8192);
#pragma unroll
            for (int ai = 0; ai < 2; ++ai)
#pragma unroll
                for (int m = 0; m < 4; ++m) { const u32x4 wg = wgs[ai][m]; u32x4 w;
                    w.x = pk4v(ub4(wg.x) * SC * acc[ai][0][m][0]); w.y = pk4v(ub4(wg.y) * SC * acc[ai][0][m][1]); w.z = pk4v(ub4(wg.z) * SC * acc[ai][1][m][0]); w.w = pk4v(ub4(wg.w) * SC * acc[ai][1][m][1]);
                    *(u32x4*)(P8 + goff + (size_t)(ai * 4 + m) * 8192) = w; }
        } else {
            constexpr float SC = 1.f / 255.f, PI = 1.f / PB_SCALE;
            u32x4 wgs[2][4], pp[2][4];
#pragma unroll
            for (int m = 0; m < 4; ++m) { wgs[0][m] = *(const u32x4*)(S8 + goff + (size_t)m * 8192); pp[0][m] = *(const u32x4*)(P8 + goff + (size_t)m * 8192); }
#pragma unroll
            for (int ai = 0; ai < 2; ++ai) {
                u32x4 ow[4][2];
#pragma unroll
                for (int m = 0; m < 4; ++m) { const u32x4 wg = wgs[ai][m], pq = pp[ai][m];
#pragma unroll
                    for (int bj = 0; bj < 2; ++bj) { const f32x4 v0 = ub4(bj ? wg.z : wg.x) * SC * acc[ai][bj][m][0] + up4_fp8(bj ? pq.z : pq.x) * PI, v1 = ub4(bj ? wg.w : wg.y) * SC * acc[ai][bj][m][1] + up4_fp8(bj ? pq.w : pq.y) * PI;
                        ow[m][bj] = pack8f(v0, v1); } }
                if (ai == 0) {
#pragma unroll
                    for (int m = 0; m < 4; ++m) { wgs[1][m] = *(const u32x4*)(S8 + goff + (size_t)(4 + m) * 8192); pp[1][m] = *(const u32x4*)(P8 + goff + (size_t)(4 + m) * 8192); } }
#pragma unroll
                for (int m = 0; m < 4; ++m) { const size_t off = (size_t)(rowb + ai * HALF + m * 16) * DM + col0;
#pragma unroll
                    for (int bj = 0; bj < 2; ++bj) *(u32x4*)(O + off + bj * HALF) = ow[m][bj]; } }
        }
    }
};
struct EpiResid {
    static constexpr bool PERM = true, AFTER_DRAIN = false;
    const float* basef; const bf16_t* baseb; bf16_t* xb; ssq_t* ssq;
    __device__ __forceinline__ bool keep(const Unit&) const { return false; }
    __device__ __forceinline__ void operator()(f32x4 (&acc)[2][2][4][2], const Unit& un, int wr, int wc, int fr, int fq) const {
        const int rowb = un.pm * BM + wr * 64 + fr, col0 = un.pn * BM + wc * 32 + 8 * fq;
        u32x4 bw[2][4][2];
#pragma unroll
        for (int m = 0; m < 4; ++m)
#pragma unroll
            for (int bj = 0; bj < 2; ++bj) bw[0][m][bj] = *(const u32x4*)(baseb + (size_t)(rowb + m * 16) * DM + col0 + bj * HALF);
#pragma unroll
        for (int ai = 0; ai < 2; ++ai) {
            u32x4 ow[4][2]; float ssv[4];
#pragma unroll
            for (int m = 0; m < 4; ++m) { float ss = 0.f;
#pragma unroll
                for (int bj = 0; bj < 2; ++bj) { f32x4 b0, b1; unpack8(bw[ai][m][bj], b0, b1);
                    const f32x4 v0 = acc[ai][bj][m][0] + b0, v1 = acc[ai][bj][m][1] + b1;
                    ow[m][bj] = pack8f(v0, v1);
                    ss += (v0[0] * v0[0] + v0[1] * v0[1]) + (v0[2] * v0[2] + v0[3] * v0[3]) + (v1[0] * v1[0] + v1[1] * v1[1]) + (v1[2] * v1[2] + v1[3] * v1[3]); }
                ss += __shfl_xor(ss, 16); ss += __shfl_xor(ss, 32); ssv[m] = ss; }
            if (ai == 0) {
#pragma unroll
                for (int m = 0; m < 4; ++m)
#pragma unroll
                    for (int bj = 0; bj < 2; ++bj) bw[1][m][bj] = *(const u32x4*)(baseb + (size_t)(rowb + HALF + m * 16) * DM + col0 + bj * HALF); }
#pragma unroll
            for (int m = 0; m < 4; ++m) { const int row = rowb + ai * HALF + m * 16; const size_t off = (size_t)row * DM + col0;
#pragma unroll
                for (int bj = 0; bj < 2; ++bj) *(u32x4*)(xb + off + bj * HALF) = ow[m][bj];
                if (fq == 0) atomicAdd(ssq + row, (ssq_t)(ssv[m] * SSQ_SCALE + 0.5f)); } }
    }
};
struct EpiGU {
    static constexpr bool PERM = true, AFTER_DRAIN = false;
    const ssq_t* ssq; bf16_t* O;
    __device__ __forceinline__ bool keep(const Unit&) const { return false; }
    __device__ __forceinline__ void operator()(f32x4 (&acc)[2][2][4][2], const Unit& un, int wr, int wc, int fr, int fq) const {
        const int rowb = un.pm * BM + wr * 64 + fr, col0 = un.pn * HALF + wc * 32 + 8 * fq;
        float rsc[2][4];
#pragma unroll
        for (int ai = 0; ai < 2; ++ai)
#pragma unroll
            for (int m = 0; m < 4; ++m) rsc[ai][m] = rs_of(ssq, rowb + ai * HALF + m * 16);
#pragma unroll
        for (int ai = 0; ai < 2; ++ai)
#pragma unroll
            for (int m = 0; m < 4; ++m) { const int row = rowb + ai * HALF + m * 16; const float r = rsc[ai][m];
                f32x4 o[2];
#pragma unroll
                for (int n = 0; n < 2; ++n) { const f32x4 g = acc[ai][0][m][n] * r, u = acc[ai][1][m][n] * r;
#pragma unroll
                    for (int j = 0; j < 4; ++j) o[n][j] = g[j] * sigmoidf_(g[j]) * u[j]; }
                *(u32x4*)(O + (size_t)row * DFF + col0) = pack8f(o[0], o[1]); }
    }
};

template <bool F8> struct Frag { bf16x8 k[2]; };
template <> struct Frag<true> { i32x8v v; };
template <class Epi, class Sched, bool ALIGN_EPI = false, bool SP2 = false, bool F8 = false>
__device__ __forceinline__ void gemm_phase(LAS unsigned char* lds, const Gemm g, const Sched& S, const Epi& E) {
    int tid = threadIdx.x; asm volatile("" : "+v"(tid));
    const int wid = __builtin_amdgcn_readfirstlane(tid >> 6), lane = tid & 63, wr = wid >> 2, wc = wid & 3, fr = lane & 15, fq = lane >> 4;
    const int K = g.K, nt = K / BK, ld = g.ld;
    unsigned voffA[2], voffB[2];
#pragma unroll
    for (int i = 0; i < 2; ++i) { int R, C; stage_rc(tid * 16 + i * 8192, R, C); const int Rb = Epi::PERM ? ((R & ~31) + perm32(R & 31)) : R;
        voffA[i] = (unsigned)(R * ld + C) * 2u; voffB[i] = (unsigned)(Rb * ld + C) * 2u; }
    const size_t kstep = (size_t)(BK * 2);
    const size_t hstep = (size_t)HALF * ld * 2;
    const size_t tstep = 2 * hstep;
    const unsigned ldsw = (unsigned)wid * 1024u;
    const int aoff = lds_byte(wr * 64 + fr, fq * 8), boff = lds_byte(wc * 32 + fr, fq * 8);
#define PG8_SA(b, h) (((b) * 2 + (h)) * HTB)
#define PG8_SB(b, h) ((4 + (b) * 2 + (h)) * HTB)
#define PG8_STAGE(bufoff, gbase, voff) do { _Pragma("unroll") for (int _i = 0; _i < 2; ++_i) \
        __builtin_amdgcn_global_load_lds((const unsigned*)((const char*)(gbase) + (voff)[_i]), (LAS unsigned*)(lds + (bufoff) + ldsw + _i * 8192), 16, 0, 0); } while (0)
#define PG8_LDF(dst, addr) do { if constexpr (F8) { dst.v.lo = *(const LAS i32x4v*)(addr); dst.v.hi = *(const LAS i32x4v*)((addr) + 1024); } else { dst.k[0] = *(const LAS bf16x8*)(addr); dst.k[1] = *(const LAS bf16x8*)((addr) + 1024); } } while (0)
#define PG8_LDA(dst, b, h) do { _Pragma("unroll") for (int m = 0; m < 4; ++m) PG8_LDF(dst[m], lds + PG8_SA(b, h) + aoff + m * 2048); } while (0)
#define PG8_LDB(dst, b, h) do { _Pragma("unroll") for (int n = 0; n < 2; ++n) PG8_LDF(dst[n], lds + PG8_SB(b, h) + boff + n * 2048); } while (0)
#define PG8_MMA(ai, bj, At, Bt) do { __builtin_amdgcn_s_setprio(1); _Pragma("unroll") for (int m = 0; m < 4; ++m) _Pragma("unroll") for (int n = 0; n < 2; ++n) { \
        if constexpr (F8) asm volatile("v_mfma_f32_16x16x128_f8f6f4 %0, %1, %2, %0" : "+v"(acc[ai][bj][m][n]) : "v"(Bt[n].v), "v"(At[m].v));     \
        else { _Pragma("unroll") for (int k = 0; k < 2; ++k) acc[ai][bj][m][n] = __builtin_amdgcn_mfma_f32_16x16x32_bf16(Bt[n].k[k], At[m].k[k], acc[ai][bj][m][n], 0, 0, 0); } } \
        __builtin_amdgcn_s_setprio(0); } while (0)
#define PG8_WAIT_V(n) asm volatile("s_waitcnt vmcnt(" #n ")" ::: "memory")
#define PG8_WAIT_L(n) asm volatile("s_waitcnt lgkmcnt(" #n ")" ::: "memory")
#define PG8_BAR __builtin_amdgcn_s_barrier()
#define PG8_SCHED __builtin_amdgcn_sched_barrier(0)
    Unit cur, nxt; int ui = 0;
    if (!S.next(0, cur)) return;
    f32x4 acc[2][2][4][2];
#pragma unroll
    for (int a = 0; a < 2; ++a)
#pragma unroll
        for (int b = 0; b < 2; ++b)
#pragma unroll
            for (int m = 0; m < 4; ++m)
#pragma unroll
                for (int n = 0; n < 2; ++n) acc[a][b][m][n] = (f32x4){0.f, 0.f, 0.f, 0.f};
    Frag<F8> At[4], B0[2], B1[2];
    const char* cA = (const char*)g.A + (size_t)cur.pm * tstep + (size_t)cur.ko * 2; const char* cB = (const char*)g.Bt + (size_t)cur.pn * tstep + (size_t)cur.ko * 2;
    S.a_ready(cur);
    if constexpr (SP2) {
        PG8_STAGE(PG8_SB(0, 0), cB, voffB); PG8_STAGE(PG8_SB(0, 1), cB + hstep, voffB); PG8_STAGE(PG8_SA(0, 0), cA, voffA); PG8_STAGE(PG8_SA(0, 1), cA + hstep, voffA);
        if (wr == 1) PG8_BAR;
        PG8_WAIT_V(2); PG8_BAR;
        PG8_STAGE(PG8_SB(1, 0), cB + kstep, voffB); PG8_STAGE(PG8_SA(1, 0), cA + kstep, voffA); PG8_STAGE(PG8_SB(1, 1), cB + hstep + kstep, voffB);
        PG8_WAIT_V(6); PG8_BAR;
    } else {
        PG8_STAGE(PG8_SB(0, 0), cB, voffB); PG8_STAGE(PG8_SA(0, 0), cA, voffA); PG8_STAGE(PG8_SB(0, 1), cB + hstep, voffB); PG8_STAGE(PG8_SA(0, 1), cA + hstep, voffA);
        if (wr == 1) PG8_BAR;
        PG8_WAIT_V(4); PG8_BAR;
        PG8_STAGE(PG8_SB(1, 0), cB + kstep, voffB); PG8_STAGE(PG8_SA(1, 0), cA + kstep, voffA); PG8_STAGE(PG8_SB(1, 1), cB + hstep + kstep, voffB);
        PG8_WAIT_V(6); PG8_BAR;
    }
    for (;;) {
        const bool has_next = S.next(ui + 1, nxt);
        const char* nA = has_next ? (const char*)g.A + (size_t)nxt.pm * tstep + (size_t)nxt.ko * 2 : cA; const char* nB = has_next ? (const char*)g.Bt + (size_t)nxt.pn * tstep + (size_t)nxt.ko * 2 : cB;
        for (int t = 0; t < nt; t += 2) {
            const bool last = (t == nt - 2);
            const char* a1 = cA + (size_t)(t + 1) * kstep;
            const char* a2 = last ? nA : cA + (size_t)(t + 2) * kstep; const char* b2 = last ? nB : cB + (size_t)(t + 2) * kstep;
            const char* a3 = a2 + kstep; const char* b3 = b2 + kstep;
            if (last && has_next) S.a_ready(nxt);
            if constexpr (SP2) {
            PG8_LDB(B0, 0, 0); PG8_LDB(B1, 0, 1); PG8_SCHED; PG8_LDA(At, 0, 0); PG8_STAGE(PG8_SA(1, 1), a1 + hstep, voffA);
            PG8_WAIT_V(8); PG8_WAIT_L(0); PG8_BAR; PG8_MMA(0, 0, At, B0); PG8_MMA(0, 1, At, B1); PG8_BAR; PG8_SCHED;
            PG8_LDA(At, 0, 1); PG8_STAGE(PG8_SB(0, 0), b2, voffB); PG8_STAGE(PG8_SB(0, 1), b2 + hstep, voffB); PG8_STAGE(PG8_SA(0, 0), a2, voffA);
            PG8_WAIT_V(8); PG8_WAIT_L(0); PG8_BAR; PG8_MMA(1, 0, At, B0); PG8_MMA(1, 1, At, B1); PG8_BAR; PG8_SCHED;
            PG8_LDB(B0, 1, 0); PG8_LDB(B1, 1, 1); PG8_SCHED; PG8_LDA(At, 1, 0); PG8_STAGE(PG8_SA(0, 1), a2 + hstep, voffA);
            PG8_WAIT_V(8); PG8_WAIT_L(0); PG8_BAR; PG8_MMA(0, 0, At, B0); PG8_MMA(0, 1, At, B1); PG8_BAR; PG8_SCHED;
            PG8_LDA(At, 1, 1); PG8_STAGE(PG8_SB(1, 0), b3, voffB); PG8_STAGE(PG8_SB(1, 1), b3 + hstep, voffB); PG8_STAGE(PG8_SA(1, 0), a3, voffA);
            PG8_WAIT_V(8); PG8_WAIT_L(0); PG8_BAR; PG8_MMA(1, 0, At, B0); PG8_MMA(1, 1, At, B1); PG8_BAR; PG8_SCHED;
            } else {
            PG8_LDB(B0, 0, 0); PG8_SCHED; PG8_LDA(At, 0, 0); PG8_STAGE(PG8_SA(1, 1), a1 + hstep, voffA);
            PG8_WAIT_L(8); PG8_BAR; PG8_WAIT_L(0); PG8_MMA(0, 0, At, B0); PG8_BAR; PG8_SCHED;
            PG8_LDB(B1, 0, 1); PG8_STAGE(PG8_SB(0, 0), b2, voffB);
            PG8_BAR; PG8_WAIT_L(0); PG8_MMA(0, 1, At, B1); PG8_BAR;
            PG8_LDA(At, 0, 1); PG8_STAGE(PG8_SA(0, 0), a2, voffA);
            PG8_BAR; PG8_WAIT_L(0); PG8_MMA(1, 0, At, B0); PG8_BAR; PG8_SCHED;
            PG8_STAGE(PG8_SB(0, 1), b2 + hstep, voffB);
            PG8_WAIT_V(6); PG8_BAR; PG8_MMA(1, 1, At, B1); PG8_BAR;
            PG8_LDB(B0, 1, 0); PG8_SCHED; PG8_LDA(At, 1, 0); PG8_STAGE(PG8_SA(0, 1), a2 + hstep, voffA);
            PG8_WAIT_L(8); PG8_BAR; PG8_WAIT_L(0); PG8_MMA(0, 0, At, B0); PG8_BAR; PG8_SCHED;
            PG8_LDB(B1, 1, 1); PG8_STAGE(PG8_SB(1, 0), b3, voffB);
            PG8_BAR; PG8_WAIT_L(0); PG8_MMA(0, 1, At, B1); PG8_BAR;
            PG8_LDA(At, 1, 1); PG8_STAGE(PG8_SA(1, 0), a3, voffA);
            PG8_BAR; PG8_WAIT_L(0); PG8_MMA(1, 0, At, B0); PG8_BAR; PG8_SCHED;
            PG8_STAGE(PG8_SB(1, 1), b3 + hstep, voffB);
            PG8_WAIT_V(6); PG8_BAR; PG8_MMA(1, 1, At, B1); PG8_BAR;
            }
        }
        if constexpr (ALIGN_EPI) { if (wr == 0) PG8_BAR; }
        if constexpr (F8) asm volatile("s_nop 15\n\ts_nop 15" ::: "memory");
        E(acc, cur, wr, wc, fr, fq); S.done(cur);
        if (!has_next) break;
        if (!E.keep(cur)) {
#pragma unroll
        for (int a = 0; a < 2; ++a)
#pragma unroll
            for (int b = 0; b < 2; ++b)
#pragma unroll
                for (int m = 0; m < 4; ++m)
#pragma unroll
                    for (int n = 0; n < 2; ++n) acc[a][b][m][n] = (f32x4){0.f, 0.f, 0.f, 0.f};
        }
        cur = nxt; cA = nA; cB = nB; ++ui;
        if constexpr (ALIGN_EPI) { if (wr == 1) PG8_BAR; }
    }
    PG8_WAIT_V(0);
    if constexpr (!ALIGN_EPI) { if (wr == 0) PG8_BAR; }
    PG8_BAR;
#undef PG8_SA
#undef PG8_SB
#undef PG8_STAGE
#undef PG8_LDA
#undef PG8_LDB
#undef PG8_MMA
#undef PG8_WAIT_V
#undef PG8_WAIT_L
#undef PG8_BAR
#undef PG8_SCHED
}
}

namespace att {
constexpr int D = 128, NW = 8, QBLK = 32, KVBLK = 64, QB = NW * QBLK;
constexpr int SHM_V = KVBLK * D * 2, SHM_K = KVBLK * D * 2;
constexpr int LDS_BYTES = 2 * SHM_V + 2 * SHM_K + NW * 64 * 4;
constexpr float SCALE = 0.08838834764831845f, THR = 8.f;
#define KSWZ(row, colB) ((row) * 256 + ((colB) ^ (((row) & 7) << 4)))
#define SBAR() __builtin_amdgcn_sched_barrier(0)
__device__ __forceinline__ int v_st(int k, int c) { const int kk = (k & ~0xC) | ((k & 4) << 1) | ((k & 8) >> 1); return ((kk >> 3) * 4 + (c >> 5)) * 512 + ((kk & 7) * 32 + (c & 31)) * 2; }
__device__ __forceinline__ int v_rd_base(int lane) { return ((lane & 3) << 3) | (((lane >> 2) & 3) << 6) | (((lane >> 4) & 1) << 5) | (((lane >> 5) & 1) << 8); }
constexpr int v_rd_off(int d0, int ks, int half) { return d0 * 512 + ks * 4096 + half * 2048; }
__device__ __forceinline__ int crow(int r, int hi) { return (r & 3) + 8 * (r >> 2) + 4 * hi; }
__device__ __forceinline__ unsigned cvtpk(float lo, float hi) { return cvt_pk_bf16(lo, hi); }
__device__ __forceinline__ bf16x8 load8(const bf16_t* p) { return *reinterpret_cast<const bf16x8*>(p); }
__device__ __forceinline__ void mask_tile(f32x16& p0, f32x16& p1, int dq) {
    const float NEG = -__builtin_inff();
#pragma unroll
    for (int r = 0; r < 16; ++r) {
        const int c = (r & 3) + 8 * (r >> 2);
        if (dq - c < 0) p0[r] = NEG;
        if (dq - c - 32 < 0) p1[r] = NEG;
    }
}
__device__ __forceinline__ void partialSM(f32x16& p0, f32x16& p1, float& m_reg, float& mn, float& alpha, bool ract) {
    float pmax = p0[0];
#pragma unroll
    for (int r = 1; r < 16; ++r) pmax = fmaxf(pmax, p0[r]);
#pragma unroll
    for (int r = 0; r < 16; ++r) pmax = fmaxf(pmax, p1[r]);
    { auto rr = __builtin_amdgcn_permlane32_swap(__float_as_uint(pmax), __float_as_uint(pmax), false, false);
      pmax = fmaxf(__uint_as_float(rr[0]), __uint_as_float(rr[1])); }
    pmax = ract ? pmax : -__builtin_inff();
    constexpr float C2 = 1.4426950408889634f * SCALE;
    if (__builtin_expect(__all((pmax - m_reg) * SCALE <= THR), 1)) { mn = m_reg; alpha = 1.f; }
    else { mn = fmaxf(m_reg, pmax); alpha = __builtin_amdgcn_exp2f((m_reg - mn) * C2); m_reg = mn; }
    const float mnL = ract ? -mn * C2 : -__builtin_inff();
#pragma unroll
    for (int r = 0; r < 16; ++r) p0[r] = fmaf(p0[r], C2, mnL);
#pragma unroll
    for (int r = 0; r < 16; ++r) p1[r] = fmaf(p1[r], C2, mnL);
#pragma unroll
    for (int r = 0; r < 16; ++r) p0[r] = __builtin_amdgcn_exp2f(p0[r]);
}
__device__ __forceinline__ void finishSM(f32x16& p0, f32x16& p1, float alpha, float& l_reg, bf16x8& pa0, bf16x8& pa1, bf16x8& pa2, bf16x8& pa3) {
#pragma unroll
    for (int r = 0; r < 16; ++r) p1[r] = __builtin_amdgcn_exp2f(p1[r]);
    float ps = 0;
#pragma unroll
    for (int r = 0; r < 16; ++r) ps += p0[r];
#pragma unroll
    for (int r = 0; r < 16; ++r) ps += p1[r];
    { auto rr = __builtin_amdgcn_permlane32_swap(__float_as_uint(ps), __float_as_uint(ps), false, false);
      ps = __uint_as_float(rr[0]) + __uint_as_float(rr[1]); }
    l_reg = l_reg * alpha + ps;
#define PK4(P, B_, OUT) do { unsigned a0 = cvtpk(P[B_+0], P[B_+1]), a1 = cvtpk(P[B_+2], P[B_+3]);                          \
        unsigned b0 = cvtpk(P[B_+4], P[B_+5]), b1 = cvtpk(P[B_+6], P[B_+7]);                                             \
        auto r0 = __builtin_amdgcn_permlane32_swap(a0, b0, false, false); auto r1 = __builtin_amdgcn_permlane32_swap(a1, b1, false, false); \
        u32x4 w = {r0[0], r1[0], r0[1], r1[1]}; OUT = *reinterpret_cast<bf16x8*>(&w); } while (0)
    PK4(p0, 0, pa0); PK4(p0, 8, pa1); PK4(p1, 0, pa2); PK4(p1, 8, pa3);
#undef PK4
}
template <int KB>
__device__ __forceinline__ void qkt(f32x16& p0, f32x16& p1, const char* K_lds, int r32, int hi, const bf16x8* qr) {
    p0 = f32x16{}; p1 = f32x16{};
    const char* kb[4];
#pragma unroll
    for (int dd = 0; dd < 4; ++dd) kb[dd] = K_lds + KB * SHM_K + KSWZ(r32, (dd * 16 + hi * 8) * 2);
#pragma unroll
    for (int d0 = 0; d0 < 8; ++d0) { const char* a = kb[d0 & 3] + (d0 >> 2) * 128;
        bf16x8 b0 = *reinterpret_cast<const bf16x8*>(a);
        bf16x8 b1 = *reinterpret_cast<const bf16x8*>(a + 32 * 256);
        p0 = __builtin_amdgcn_mfma_f32_32x32x16_bf16(b0, qr[d0], p0, 0, 0, 0);
        p1 = __builtin_amdgcn_mfma_f32_32x32x16_bf16(b1, qr[d0], p1, 0, 0, 0); }
}
template <int VOFF>
__device__ __forceinline__ void pv_tile(f32x16* o, int vb0, bf16x8 pa0, bf16x8 pa1, bf16x8 pa2, bf16x8 pa3) {
#define TRRD(dst, off) asm volatile("ds_read_b64_tr_b16 %0, %1 offset:%2" : "=&v"(dst) : "v"(vb0), "i"(off) : "memory")
#define PV_D0(d0) do { s16x4 l0, l1, l2, l3, h0, h1, h2, h3; constexpr int b_ = VOFF + v_rd_off(d0, 0, 0); \
        TRRD(l0, b_); TRRD(h0, b_ + 2048); TRRD(l1, b_ + 4096); TRRD(h1, b_ + 6144); TRRD(l2, b_ + 8192); TRRD(h2, b_ + 10240); TRRD(l3, b_ + 12288); TRRD(h3, b_ + 14336); \
        asm volatile("s_waitcnt lgkmcnt(0)" ::: "memory"); SBAR();   \
        o[d0] = __builtin_amdgcn_mfma_f32_32x32x16_bf16(pa0, (bf16x8){l0[0], l0[1], l0[2], l0[3], h0[0], h0[1], h0[2], h0[3]}, o[d0], 0, 0, 0);   \
        o[d0] = __builtin_amdgcn_mfma_f32_32x32x16_bf16(pa1, (bf16x8){l1[0], l1[1], l1[2], l1[3], h1[0], h1[1], h1[2], h1[3]}, o[d0], 0, 0, 0);   \
        o[d0] = __builtin_amdgcn_mfma_f32_32x32x16_bf16(pa2, (bf16x8){l2[0], l2[1], l2[2], l2[3], h2[0], h2[1], h2[2], h2[3]}, o[d0], 0, 0, 0);   \
        o[d0] = __builtin_amdgcn_mfma_f32_32x32x16_bf16(pa3, (bf16x8){l3[0], l3[1], l3[2], l3[3], h3[0], h3[1], h3[2], h3[3]}, o[d0], 0, 0, 0); } while (0)
    PV_D0(0); PV_D0(1); PV_D0(2); PV_D0(3);
#undef PV_D0
#undef TRRD
}
template <int VOFF>
__device__ __forceinline__ void pv_tile_T(f32x16* o, int vb0, bf16x8 pa0, bf16x8 pa1, bf16x8 pa2, bf16x8 pa3) {
#define TRRD(dst, off) asm volatile("ds_read_b64_tr_b16 %0, %1 offset:%2" : "=&v"(dst) : "v"(vb0), "i"(off) : "memory")
#define PV_D0(d0) do { s16x4 l0, l1, l2, l3, h0, h1, h2, h3; constexpr int b_ = VOFF + v_rd_off(d0, 0, 0); \
        TRRD(l0, b_); TRRD(h0, b_ + 2048); TRRD(l1, b_ + 4096); TRRD(h1, b_ + 6144); TRRD(l2, b_ + 8192); TRRD(h2, b_ + 10240); TRRD(l3, b_ + 12288); TRRD(h3, b_ + 14336); \
        asm volatile("s_waitcnt lgkmcnt(0)" ::: "memory"); SBAR();   \
        o[d0] = __builtin_amdgcn_mfma_f32_32x32x16_bf16((bf16x8){l0[0], l0[1], l0[2], l0[3], h0[0], h0[1], h0[2], h0[3]}, pa0, o[d0], 0, 0, 0);   \
        o[d0] = __builtin_amdgcn_mfma_f32_32x32x16_bf16((bf16x8){l1[0], l1[1], l1[2], l1[3], h1[0], h1[1], h1[2], h1[3]}, pa1, o[d0], 0, 0, 0);   \
        o[d0] = __builtin_amdgcn_mfma_f32_32x32x16_bf16((bf16x8){l2[0], l2[1], l2[2], l2[3], h2[0], h2[1], h2[2], h2[3]}, pa2, o[d0], 0, 0, 0);   \
        o[d0] = __builtin_amdgcn_mfma_f32_32x32x16_bf16((bf16x8){l3[0], l3[1], l3[2], l3[3], h3[0], h3[1], h3[2], h3[3]}, pa3, o[d0], 0, 0, 0); } while (0)
    PV_D0(0); PV_D0(1); PV_D0(2); PV_D0(3);
#undef PV_D0
#undef TRRD
}
struct BlockRef { const bf16_t* Q; const bf16_t* K; const bf16_t* V; bf16_t* O; int P0; int jlo; const unsigned* sel; float* lse; };
struct Seam { bf16x8 qr[8]; bf16x8 st_v0, st_v1, st_k0, st_k1; };
#define ROW(p, k0, rr) ((p) + (size_t)((k0) + (rr)) * KP + sc)
#define VMW() asm volatile("s_waitcnt vmcnt(0)" ::: "memory")
#define VMWN(n) asm volatile("s_waitcnt vmcnt(%0)" :: "i"(n) : "memory")
#define SLOAD_H(Kp, Vp, k0) do { S.st_v0 = load8(ROW(Vp, k0, sr)); S.st_v1 = load8(ROW(Vp, k0, 32 + sr));              \
                         S.st_k0 = load8(ROW(Kp, k0, sr)); S.st_k1 = load8(ROW(Kp, k0, 32 + sr)); } while (0)
#define SWRITE_HK(bf) do { *(bf16x8*)(K_lds + (bf) * SHM_K + kws) = S.st_k0; *(bf16x8*)(K_lds + (bf) * SHM_K + kws + 32 * 256) = S.st_k1; } while (0)
#define SWRITE_HV(bf) do { *(bf16x8*)(V_lds + (bf) * SHM_V + vst0) = S.st_v0; *(bf16x8*)(V_lds + (bf) * SHM_V + vst1) = S.st_v1; } while (0)
#define SWRITE_H(bf) do { SWRITE_HV(bf); SWRITE_HK(bf); } while (0)
template <int QP, int KP>
__device__ __forceinline__ void prime(const BlockRef& cur, char* lds, Seam& S) {
    int tid = threadIdx.x; asm volatile("" : "+v"(tid)); const int wid = __builtin_amdgcn_readfirstlane(tid >> 6), lane = tid & 63, r32 = lane & 31, hi = lane >> 5;
    const int sr = tid >> 4, sc = (tid & 15) * 8, kws = KSWZ(sr, sc * 2); char* K_lds = lds + 2 * SHM_V;
#pragma unroll
    for (int d0 = 0; d0 < 8; ++d0) S.qr[d0] = load8(cur.Q + (size_t)(wid * QBLK + r32) * QP + d0 * 16 + hi * 8);
    SLOAD_H(cur.K, cur.V, cur.jlo * KVBLK); VMW(); SWRITE_HK(0);
    __syncthreads();
}
template <int QP, int KP, int OP, bool OLDS = false>
__device__ __forceinline__ void block(const BlockRef& cur, const BlockRef& nxt, int skv, char* lds, Seam& S) {
    int tid = threadIdx.x; asm volatile("" : "+v"(tid)); const int wid = __builtin_amdgcn_readfirstlane(tid >> 6), lane = tid & 63, r32 = lane & 31, hi = lane >> 5;
    int j_hi = (cur.P0 + QB - 1) / KVBLK + 1; if (j_hi > skv / KVBLK) j_hi = skv / KVBLK;
    const int j_lo = cur.jlo, NT = j_hi - j_lo;
    const int qlo = cur.P0 + wid * QBLK, qm = qlo + r32 - 4 * hi;
    char* V_lds = lds; char* K_lds = lds + 2 * SHM_V;
    float* ws = (float*)(lds + 2 * SHM_V + 2 * SHM_K) + wid * 64; float* li_l = ws, * al_l = ws + 32;
    float m_reg = -1e30f, l_reg = 0; f32x16 o[4] = {};
    const int sr = tid >> 4, sc = (tid & 15) * 8, vst0 = v_st(sr, sc), vst1 = v_st(32 + sr, sc), kws = KSWZ(sr, sc * 2);
    const int vb0 = (int)(uintptr_t)V_lds + v_rd_base(lane);
    const bf16_t* Kh = cur.K; const bf16_t* Vh = cur.V;
    const unsigned selw = cur.sel ? cur.sel[qlo + r32] : 0xffffffffu;
#define RESC(a) do { if (__any((a) < 1.f)) { if (hi == 0) al_l[r32] = (a); asm volatile("s_waitcnt lgkmcnt(0)" ::: "memory");              \
                     for (int d_ = 0; d_ < 4; ++d_) for (int r = 0; r < 16; ++r) o[d_][r] *= al_l[crow(r, hi)]; } } while (0)
#define KBASE(t) ((j_lo + (t)) * KVBLK)
#define RACT(t) (((selw >> ((KBASE(t) >> 8) & 31)) & 1u) != 0u)
#define MASKT(P0_, P1_, t) do { const int kb_ = KBASE(t); if (kb_ + KVBLK - 1 > qlo) mask_tile(P0_, P1_, qm - kb_); } while (0)
    constexpr int NQL = 8;
#define SEAM_K0() do { VMWN(NQL); SWRITE_HK(0); SBAR(); } while (0)
    f32x16 pA0, pA1, pB0, pB1; float mnA, mnB, alA, alB; bf16x8 pa0, pa1, pa2, pa3;
    SWRITE_HV(0); SBAR();
    if (NT > 1) { SLOAD_H(Kh, Vh, KBASE(1)); }
    SBAR(); qkt<0>(pA0, pA1, K_lds, r32, hi, S.qr);
    MASKT(pA0, pA1, 0); partialSM(pA0, pA1, m_reg, mnA, alA, RACT(0));
    if (NT > 1) { VMW(); SWRITE_H(1); }
    __syncthreads();
#define HALF_STEP(PX0, PX1, mnX, alX, PY0, PY1, alY, t, KB, VB, SB) do {                                                      \
        SBAR(); qkt<KB>(PX0, PX1, K_lds, r32, hi, S.qr);                                             \
        finishSM(PY0, PY1, alY, l_reg, pa0, pa1, pa2, pa3); SBAR();                                                           \
        if ((t) + 1 < NT) { SLOAD_H(Kh, Vh, KBASE((t) + 1)); SBAR(); }                                               \
        pv_tile<VB * SHM_V>(o, vb0, pa0, pa1, pa2, pa3); MASKT(PX0, PX1, (t)); partialSM(PX0, PX1, m_reg, mnX, alX, RACT(t));                                        \
        __syncthreads();                                                                                                      \
        if ((t) + 1 < NT) { VMW(); SWRITE_H(SB); }                                                                          \
        RESC(alX); __syncthreads(); } while (0)
    for (int t = 1; t + 1 < NT; t += 2) {
        HALF_STEP(pB0, pB1, mnB, alB, pA0, pA1, alA, t, 1, 0, 0);
        HALF_STEP(pA0, pA1, mnA, alA, pB0, pB1, alB, t + 1, 0, 1, 1);
    }
    const bool even = (NT & 1) == 0;
    if (even) { SBAR(); qkt<1>(pB0, pB1, K_lds, r32, hi, S.qr); SBAR(); }
    SLOAD_H(nxt.K, nxt.V, nxt.jlo * KVBLK); SBAR();
#pragma unroll
    for (int d0 = 0; d0 < 8; ++d0) S.qr[d0] = load8(nxt.Q + (size_t)(wid * QBLK + r32) * QP + d0 * 16 + hi * 8);
    SBAR();
    finishSM(pA0, pA1, alA, l_reg, pa0, pa1, pa2, pa3); SBAR();
    pv_tile<0>(o, vb0, pa0, pa1, pa2, pa3);
    if (even) { MASKT(pB0, pB1, NT - 1); partialSM(pB0, pB1, m_reg, mnB, alB, RACT(NT - 1)); __syncthreads(); RESC(alB);
        finishSM(pB0, pB1, alB, l_reg, pa0, pa1, pa2, pa3); SBAR(); pv_tile<SHM_V>(o, vb0, pa0, pa1, pa2, pa3); }
    SBAR(); SEAM_K0();
    if (hi == 0) li_l[r32] = l_reg; asm volatile("s_waitcnt lgkmcnt(0)" ::: "memory");
    if constexpr (OLDS) { int lo_ = (threadIdx.x >> 6) * QBLK + (threadIdx.x & 31); asm volatile("" : "+v"(lo_));
        if (hi == 0) ((float*)(lds + 133120))[lo_] = m_reg * (1.4426950408889634f * SCALE) + __builtin_amdgcn_logf(l_reg); }
    else { if (cur.lse && hi == 0) cur.lse[wid * QBLK + r32] = m_reg * (1.4426950408889634f * SCALE) + __builtin_amdgcn_logf(l_reg); }
    float rli[16];
#pragma unroll
    for (int r = 0; r < 16; ++r) rli[r] = __builtin_amdgcn_rcpf(li_l[crow(r, hi)]);
    int wq_ = (threadIdx.x >> 6) * QBLK; if constexpr (OLDS) asm volatile("" : "+v"(wq_));
    bf16_t* Ow = OLDS ? (bf16_t*)(lds + 67584) + (size_t)wq_ * OP : cur.O + (size_t)(wid * QBLK) * OP;
#pragma unroll
    for (int r = 0; r < 16; ++r) { const int orow = crow(r, hi);
#pragma unroll
        for (int d0 = 0; d0 < 4; ++d0) { const float v = o[d0][r] * rli[r];
            const float vn = __shfl_xor(v, 1);
            if ((r32 & 1) == 0) *(unsigned*)(Ow + (size_t)orow * OP + d0 * 32 + r32) = cvtpk(v, vn); } }
    __syncthreads();
#undef RESC
#undef KBASE
#undef RACT
#undef MASKT
#undef SEAM_K0
#undef HALF_STEP
}
__device__ __forceinline__ void gather_load_kv(const bf16_t* Kn, const bf16_t* Vn, char* lds) {
    int tid = threadIdx.x; asm volatile("" : "+v"(tid)); const int sr = tid >> 4, sc = (tid & 15) * 8; char* V_lds = lds; char* K_lds = lds + 4 * SHM_V;
    bf16x8 kk[8], vv[8];
#pragma unroll
    for (int i = 0; i < 8; ++i) { kk[i] = load8(Kn + (size_t)(sr + 32 * i) * AW + sc); vv[i] = load8(Vn + (size_t)(sr + 32 * i) * AW + sc); }
#pragma unroll
    for (int i = 0; i < 8; ++i) { const int t = i >> 1, rr = sr + 32 * (i & 1);
        *(bf16x8*)(K_lds + t * SHM_K + KSWZ(rr, sc * 2)) = kk[i]; *(bf16x8*)(V_lds + t * SHM_V + v_st(rr, sc)) = vv[i]; }
}
__device__ __forceinline__ void gather_run(const bf16_t* Qh, const unsigned short* list, int c_lo, int c_hi, int cnt, bf16_t* P01, bf16_t* P2, float* LSE, size_t rowbase, char* lds) {
    int tid = threadIdx.x; asm volatile("" : "+v"(tid)); const int wid = __builtin_amdgcn_readfirstlane(tid >> 6), lane = tid & 63, r32 = lane & 31, hi = lane >> 5;
    char* V_lds = lds; char* K_lds = lds + 4 * SHM_V;
    const int vb0 = (int)(uintptr_t)V_lds + v_rd_base(lane);
    bf16x8 qr[8], qn[8]; unsigned ent = 0xFFFFu, entn = 0xFFFFu; bool has = false, hasn = false;
#define GLOAD(C_, ENT, QR, HAS) do { const int ew_ = (C_) * 256 + wid * 32; HAS = ew_ < cnt; if (HAS) { const int e_ = ew_ + r32; const bool v_ = e_ < cnt; \
        ENT = v_ ? (unsigned)list[e_] : 0xFFFFu; const int sq_ = v_ ? (int)(ENT & 8191u) : (int)((unsigned)list[ew_] & 8191u); \
        _Pragma("unroll") for (int d0 = 0; d0 < 8; ++d0) QR[d0] = load8(Qh + (size_t)sq_ * AW + d0 * 16 + hi * 8); } } while (0)
    GLOAD(c_lo, ent, qr, has);
    for (int c = c_lo; c < c_hi; ++c) {
        hasn = false; if (c + 1 < c_hi) GLOAD(c + 1, entn, qn, hasn);
        if (has) {
            float m_reg = -1e30f, l_reg = 0; f32x16 o[4] = {};
            f32x16 pA0, pA1, pB0, pB1; float mnA, mnB, alA, alB; bf16x8 pa0, pa1, pa2, pa3;
#define GRESC(a) do { if (__any((a) < 1.f)) { _Pragma("unroll") for (int d_ = 0; d_ < 4; ++d_) o[d_] *= (a); } } while (0)
            SBAR(); qkt<0>(pA0, pA1, K_lds, r32, hi, qr); partialSM(pA0, pA1, m_reg, mnA, alA, true);
            SBAR(); qkt<1>(pB0, pB1, K_lds, r32, hi, qr); finishSM(pA0, pA1, alA, l_reg, pa0, pa1, pa2, pa3); SBAR(); pv_tile_T<0 * SHM_V>(o, vb0, pa0, pa1, pa2, pa3); partialSM(pB0, pB1, m_reg, mnB, alB, true); GRESC(alB);
            SBAR(); qkt<2>(pA0, pA1, K_lds, r32, hi, qr); finishSM(pB0, pB1, alB, l_reg, pa0, pa1, pa2, pa3); SBAR(); pv_tile_T<1 * SHM_V>(o, vb0, pa0, pa1, pa2, pa3); partialSM(pA0, pA1, m_reg, mnA, alA, true); GRESC(alA);
            SBAR(); qkt<3>(pB0, pB1, K_lds, r32, hi, qr); finishSM(pA0, pA1, alA, l_reg, pa0, pa1, pa2, pa3); SBAR(); pv_tile_T<2 * SHM_V>(o, vb0, pa0, pa1, pa2, pa3); partialSM(pB0, pB1, m_reg, mnB, alB, true); GRESC(alB);
            SBAR(); finishSM(pB0, pB1, alB, l_reg, pa0, pa1, pa2, pa3); SBAR(); pv_tile_T<3 * SHM_V>(o, vb0, pa0, pa1, pa2, pa3);
#undef GRESC
            if (ent != 0xFFFFu) { const unsigned sl = ent >> 13; const size_t row = rowbase + (ent & 8191u);
                if (hi == 0) LSE[(size_t)sl * (BATCH * NH * SEQ) + row] = m_reg * (1.4426950408889634f * SCALE) + __builtin_amdgcn_logf(l_reg);
                const float rl = __builtin_amdgcn_rcpf(l_reg);
                unsigned char* dst = (unsigned char*)(sl < 2u ? P01 + (size_t)sl * ((size_t)BATCH * NH * SEQ * D) : P2) + row * D + 16 * hi; const float rs = rl * OA8_SCALE;
#pragma unroll
                for (int d0 = 0; d0 < 4; ++d0) {
                    const unsigned q0 = pk4_fp8(o[d0][0] * rs, o[d0][1] * rs, o[d0][2] * rs, o[d0][3] * rs), q1 = pk4_fp8(o[d0][4] * rs, o[d0][5] * rs, o[d0][6] * rs, o[d0][7] * rs);
                    const unsigned q2 = pk4_fp8(o[d0][8] * rs, o[d0][9] * rs, o[d0][10] * rs, o[d0][11] * rs), q3 = pk4_fp8(o[d0][12] * rs, o[d0][13] * rs, o[d0][14] * rs, o[d0][15] * rs);
                    auto r0 = __builtin_amdgcn_permlane32_swap(q0, q2, false, false); auto r1 = __builtin_amdgcn_permlane32_swap(q1, q3, false, false);
                    u32x4 w; w.x = r0[0]; w.y = r0[1]; w.z = r1[0]; w.w = r1[1];
                    *(u32x4*)(dst + d0 * 32) = w; } }
        }
        has = hasn; ent = entn;
#pragma unroll
        for (int d0 = 0; d0 < 8; ++d0) qr[d0] = qn[d0];
    }
#undef GLOAD
}
#undef ROW
#undef VMW
#undef VMWN
#undef SLOAD_H
#undef SWRITE_HK
#undef SWRITE_HV
#undef SWRITE_H
}

constexpr int NWAVES = 8;
constexpr int N_PHASES = 15;
constexpr size_t MiB = 1u << 20;
constexpr size_t WS_CTL = 0, CTL_ZERO_BYTES = 1 * MiB;
constexpr size_t WS_KM = 1 * MiB, WS_SEL = 2 * MiB, WS_ROPE_C = 3 * MiB, WS_ROPE_S = 5 * MiB, WS_WSGU = 7 * MiB, WS_MEMKV = 8 * MiB, WS_MEMN = 9 * MiB;
constexpr size_t WS_WIN = 16 * MiB, WS_PCAT = 160 * MiB, WS_WOUT = 192 * MiB, WS_WXQ = 224 * MiB, WS_WXKV = 228 * MiB, WS_WXO = 236 * MiB, WS_WGU = 240 * MiB, WS_WDN = 412 * MiB;
constexpr size_t WS_XB = 498 * MiB;
constexpr size_t WS_Q = 626 * MiB, WS_U = 690 * MiB, WS_K = 754 * MiB, WS_V = 818 * MiB, WS_VS = 882 * MiB, WS_SA = 946 * MiB, WS_SB = 1074 * MiB, WS_END = 1202 * MiB;
constexpr size_t WS_MERGED = WS_K;
constexpr size_t WS_QX = WS_VS, WS_OX = WS_VS + 16 * MiB;
constexpr size_t WS_ACT = WS_Q;
static_assert(WS_WDN + (size_t)DM * DFF * 2 <= WS_XB && WS_WGU + (size_t)2 * DFF * DM * 2 <= WS_WDN && WS_ACT + (size_t)M * DFF * 2 <= WS_SB, "ws map");
constexpr int CW_TMO = 0;
constexpr int CW_BAR = 4096;
constexpr int CW_LCNT = 16384, CW_PCNT2 = 24576;
constexpr size_t CTL_SSQ = 256 * 1024;
constexpr int RING_BYTES = 131072, LDS_BYTES = 147456, LDSCTL_OFF = LDS_BYTES - 1024, MISC_OFF = LDSCTL_OFF + 320;
constexpr int OT_OFF = 67584, OTL_OFF = OT_OFF + 65536;

#define RLX_AGENT __ATOMIC_RELAXED, __HIP_MEMORY_SCOPE_AGENT
#define LDS_WAIT() asm volatile("s_waitcnt lgkmcnt(0)" ::: "memory")
#define VM_WAIT() asm volatile("s_waitcnt vmcnt(0)" ::: "memory")
__device__ __forceinline__ unsigned f2bf(float f) { unsigned u = __builtin_bit_cast(unsigned, f); return (u + 0x7fffu + ((u >> 16) & 1u)) >> 16; }
__device__ __forceinline__ unsigned pk2(float lo, float hi) { return f2bf(lo) | (f2bf(hi) << 16); }

#define XB_TMO      128
#define XB_XCNT(j)  (256  + 64 * (j))
#define XB_XSUB(j)  (1280 + 64 * (j))
#define XB_XGEN(j)  (2304 + 64 * (j))
#define XB_TOP      3328
#define XB_TOPGEN   3392
#define XCD_BAR_WORDS 3456
#define XB_SPIN_CAP (1u << 18)
__device__ __forceinline__ unsigned xb_ld(unsigned* p)              { return __hip_atomic_load(p, __ATOMIC_RELAXED, __HIP_MEMORY_SCOPE_AGENT); }
__device__ __forceinline__ unsigned xb_add(unsigned* p, unsigned v) { return __hip_atomic_fetch_add(p, v, __ATOMIC_RELAXED, __HIP_MEMORY_SCOPE_AGENT); }
__device__ __forceinline__ unsigned xb_xcc_id() { return (unsigned)__builtin_amdgcn_s_getreg((3 << 11) | 20) & 0xFu; }
#define XB_SPIN(cond, bar) do { unsigned _sp = 0; while (cond) { __builtin_amdgcn_s_sleep(1); \
    if ((++_sp & 255u) == 0u) { if (xb_ld(&(bar)[XB_TMO])) break; if (_sp > XB_SPIN_CAP) { atomicAdd(&(bar)[XB_TMO], 1u); break; } } } } while (0)
struct XcdBarrier { unsigned* bar; unsigned x; volatile LAS unsigned* st; };
__device__ __forceinline__ XcdBarrier xcd_barrier_post(unsigned* bar, volatile LAS unsigned* st) {
    XcdBarrier b; b.bar = bar; b.x = xb_xcc_id(); b.st = st;
    if (threadIdx.x == 0) (void)xb_add(&bar[XB_XCNT(b.x)], 1u);
    return b;
}
__device__ __forceinline__ void xcd_barrier_complete(unsigned* bar, unsigned x, unsigned& nloc, unsigned& nx) {
    const unsigned G = gridDim.x * gridDim.y * gridDim.z;
    unsigned sum, cnt, mine, sp = 0u;
    for (;;) {
        sum = 0u; cnt = 0u; mine = 0u;
#pragma unroll
        for (unsigned j = 0; j < 16; ++j) { const unsigned c = xb_ld(&bar[XB_XCNT(j)]); sum += c; cnt += (c > 0u) ? 1u : 0u; mine = (j == x) ? c : mine; }
        if (sum == G) break;
        __builtin_amdgcn_s_sleep(1);
        if ((++sp & 255u) == 0u) { if (xb_ld(&bar[XB_TMO])) break; if (sp > XB_SPIN_CAP) { atomicAdd(&bar[XB_TMO], 1u); break; } }
    }
    nloc = mine > 0u ? mine : 1u; nx = cnt > 0u ? cnt : 1u;
}
__device__ __forceinline__ void xcd_barrier(const XcdBarrier& b) {
    asm volatile("s_waitcnt vmcnt(0)" ::: "memory");
    __syncthreads();
    if (threadIdx.x == 0) {
        unsigned* bar = b.bar;
        __builtin_amdgcn_s_waitcnt(0);
        unsigned nloc = b.st[0], nx = b.st[1];
        if (nloc == 0u) { xcd_barrier_complete(bar, b.x, nloc, nx); b.st[0] = nloc; b.st[1] = nx; }
        const unsigned old = xb_add(&bar[XB_XSUB(b.x)], 1u);
        const unsigned gen = old / nloc;
        if (old + 1u == (gen + 1u) * nloc) {
            __builtin_amdgcn_fence(__ATOMIC_RELEASE, "agent");
            asm volatile("s_waitcnt vmcnt(0)" ::: "memory");
            const unsigned og = xb_add(&bar[XB_TOP], 1u);
            const unsigned tg = og / nx;
            if (og + 1u == (tg + 1u) * nx) xb_add(&bar[XB_TOPGEN], 1u);
            else XB_SPIN(xb_ld(&bar[XB_TOPGEN]) == tg, bar);
            __builtin_amdgcn_fence(__ATOMIC_ACQUIRE, "agent");
            xb_add(&bar[XB_XGEN(b.x)], 1u);
            asm volatile("s_waitcnt vmcnt(0)" ::: "memory");
        } else {
            XB_SPIN(xb_ld(&bar[XB_XGEN(b.x)]) == gen, bar);
            __builtin_amdgcn_fence(__ATOMIC_ACQUIRE, "agent");
            asm volatile("s_waitcnt vmcnt(0)" ::: "memory");
        }
    }
    __syncthreads();
}

__device__ __forceinline__ float wave_sum(float v) {
#pragma unroll
    for (int o = 1; o < 64; o <<= 1) v += __shfl_xor(v, o);
    return v;
}
__device__ __forceinline__ void tr_item64(const float* __restrict__ W, int K, int N, int k0, int n0, bf16_t* WT, int drow0, const float* __restrict__ gain, LAS unsigned* scr, int lane) {
    const float* src = W + (size_t)k0 * N + n0 + lane;
    float v[64];
#pragma unroll
    for (int r = 0; r < 64; ++r) v[r] = src[(size_t)r * N];
    if (gain) {
#pragma unroll
        for (int r = 0; r < 64; ++r) v[r] *= gain[k0 + r]; }
#pragma unroll
    for (int i = 0; i < 32; ++i) scr[i * 65 + lane] = cvt_pk_bf16(v[2 * i], v[2 * i + 1]);
    LDS_WAIT(); asm volatile("" ::: "memory");
    const int c = lane & 7;
#pragma unroll
    for (int jj = 0; jj < 8; ++jj) { const int n = (lane >> 3) + 8 * jj; const LAS unsigned* sp = scr + (4 * c) * 65 + n;
        u32x4 o; o.x = sp[0]; o.y = sp[65]; o.z = sp[130]; o.w = sp[195];
        *(GAS u32x4*)(WT + (size_t)(drow0 + n) * K + k0 + 8 * c) = o; }
    LDS_WAIT(); asm volatile("" ::: "memory");
}
struct TrItem { const float* W; bf16_t* WT; const float* gain; int K, N, k0, n0, kind, rowbase; };
__device__ __forceinline__ void tr_issue(const TrItem& it, f32x4 (&v)[8], int wave, int lane) {
    const float* src = it.W + (size_t)(it.k0 + 8 * wave) * it.N + it.n0 + 4 * lane;
#pragma unroll
    for (int r = 0; r < 8; ++r) v[r] = __builtin_nontemporal_load((const f32x4*)(src + (size_t)r * it.N));
}
__device__ __forceinline__ void tr_stage(const TrItem& it, const f32x4 (&v)[8], LAS unsigned* T, int wave, int lane) {
    if (it.kind >= 4) {
        float g[8];
#pragma unroll
        for (int r = 0; r < 8; ++r) g[r] = (it.gain ? it.gain[it.k0 + 8 * wave + r] : 1.f) * W8_SCALE;
#pragma unroll
        for (int j = 0; j < 4; ++j) { T[(4 * lane + j) * 17 + 2 * wave] = pk4_fp8(v[0][j] * g[0], v[1][j] * g[1], v[2][j] * g[2], v[3][j] * g[3]);
            T[(4 * lane + j) * 17 + 2 * wave + 1] = pk4_fp8(v[4][j] * g[4], v[5][j] * g[5], v[6][j] * g[6], v[7][j] * g[7]); }
        return; }
#pragma unroll
    for (int rp = 0; rp < 4; ++rp) { float g0 = 1.f, g1 = 1.f; if (it.gain) { g0 = it.gain[it.k0 + 8 * wave + 2 * rp]; g1 = it.gain[it.k0 + 8 * wave + 2 * rp + 1]; }
#pragma unroll
        for (int j = 0; j < 4; ++j) T[(4 * lane + j) * 33 + 4 * wave + rp] = cvt_pk_bf16(v[2 * rp][j] * g0, v[2 * rp + 1][j] * g1); }
}
__device__ __forceinline__ void tr_readout(const TrItem& it, const LAS unsigned* T, int tid) {
    if (it.kind >= 4) {
#pragma unroll
        for (int i = 0; i < 2; ++i) { const int q = tid + 512 * i, nl = q >> 2, c = q & 3, n = it.n0 + nl; int drow = it.rowbase + n;
            if (it.kind == 5) { const int t = n >> 8, l8 = n & 255; drow = t * 256 + 128 * ((l8 >> 6) & 1) + 64 * (l8 >> 7) + (l8 & 63); }
            const LAS unsigned* sp = T + nl * 17 + 4 * c; u32x4 o; o.x = sp[0]; o.y = sp[1]; o.z = sp[2]; o.w = sp[3];
            *(GAS u32x4*)((unsigned char*)it.WT + (size_t)drow * it.K + it.k0 + 16 * c) = o; }
        return; }
#pragma unroll
    for (int i = 0; i < 4; ++i) { const int q = tid + 512 * i, nl = q >> 3, c = q & 7, n = it.n0 + nl; int drow = it.rowbase + n;
        if (it.kind == 1) { if (n < 4096) { const int t = n >> 8, l8 = n & 255; drow = t * 256 + 128 * ((l8 >> 6) & 1) + 64 * (l8 >> 7) + (l8 & 63); } }
        else if (it.kind >= 2) drow = (n >> 7) * 256 + (it.kind == 3 ? 128 : 0) + (n & 127);
        const LAS unsigned* sp = T + nl * 33 + 4 * c; u32x4 o; o.x = sp[0]; o.y = sp[1]; o.z = sp[2]; o.w = sp[3];
        *(GAS u32x4*)(it.WT + (size_t)drow * it.K + it.k0 + 8 * c) = o; }
}
__device__ __forceinline__ float row_to_bf16(const float* xrow, bf16_t* orow, const float* gain, int lane, unsigned char* o8 = nullptr) {
    const GAS f32x4* xr = (const GAS f32x4*)xrow + lane;
    f32x4 v[16]; float s = 0.f;
#pragma unroll
    for (int j = 0; j < 16; ++j) { v[j] = __builtin_nontemporal_load(xr + 64 * j); s += (v[j].x * v[j].x + v[j].y * v[j].y) + (v[j].z * v[j].z + v[j].w * v[j].w); }
    s = wave_sum(s);
    const float r = gain ? __builtin_amdgcn_rsqf(s * (1.f / DM) + RMS_EPS) : 1.f;
    GAS u32x2* o8b = (GAS u32x2*)orow + lane;
#pragma unroll
    for (int j = 0; j < 16; ++j) { f32x4 g = gain ? ((const GAS f32x4*)gain)[lane + 64 * j] * r : (f32x4){1.f, 1.f, 1.f, 1.f}; f32x4 w = v[j] * g;
        u32x2 o; o.x = cvt_pk_bf16(w.x, w.y); o.y = cvt_pk_bf16(w.z, w.w); o8b[64 * j] = o;
        if (o8) ((GAS unsigned*)o8)[lane + 64 * j] = pk4_fp8(w.x * X8_SCALE, w.y * X8_SCALE, w.z * X8_SCALE, w.w * X8_SCALE); }
    return s;
}
__device__ const float INV_FREQ[64] = {1.f, 0.865964353f, 0.749894261f, 0.649381638f, 0.562341332f, 0.486967534f, 0.421696514f, 0.365174115f, 0.316227764f, 0.273841977f, 0.237137377f, 0.2053525f, 0.177827939f, 0.153992653f, 0.133352131f, 0.115478203f, 0.100000001f, 0.0865964293f, 0.0749894157f, 0.0649381652f, 0.0562341325f, 0.0486967526f, 0.0421696529f, 0.0365174115f, 0.0316227749f, 0.0273841973f, 0.0237137377f, 0.0205352511f, 0.0177827943f, 0.0153992651f, 0.0133352149f, 0.0115478206f, 0.00999999978f, 0.00865964312f, 0.00749894185f, 0.00649381615f, 0.00562341325f, 0.00486967526f, 0.00421696482f, 0.00365174119f, 0.00316227763f, 0.00273841969f, 0.00237137359f, 0.00205352483f, 0.00177827943f, 0.00153992651f, 0.00133352145f, 0.0011547819f, 0.00100000005f, 0.000865964335f, 0.000749894243f, 0.000649381662f, 0.000562341302f, 0.000486967532f, 0.000421696517f, 0.000365174143f, 0.000316227757f, 0.000273841957f, 0.00023713737f, 0.00020535251f, 0.00017782794f, 0.000153992645f, 0.00013335215f, 0.0001154782f};
__device__ __forceinline__ void rope_entry(int pos, int i, float& c, float& s) {
    const float af = (float)pos * INV_FREQ[i];
    const double x = (double)af, k = __builtin_rint(x * 0.63661977236758134308);
    double r = __builtin_fma(-k, 1.57079632673412561417e+00, x); r = __builtin_fma(-k, 6.07710050650619224932e-11, r);
    const double z = r * r;
    double sp = 1.0 / 1307674368000.0; sp = sp * z - 1.0 / 6227020800.0; sp = sp * z + 1.0 / 39916800.0; sp = sp * z - 1.0 / 362880.0; sp = sp * z + 1.0 / 5040.0; sp = sp * z - 1.0 / 120.0; sp = sp * z + 1.0 / 6.0;
    const double sn = r - r * z * sp;
    double cp = 1.0 / 20922789888000.0; cp = cp * z - 1.0 / 87178291200.0; cp = cp * z + 1.0 / 479001600.0; cp = cp * z - 1.0 / 3628800.0; cp = cp * z + 1.0 / 40320.0; cp = cp * z - 1.0 / 720.0; cp = cp * z + 1.0 / 24.0;
    const double cs = 1.0 - 0.5 * z + z * z * cp;
    const int q = (int)k & 3;
    const double so = (q & 1) ? cs : sn, co = (q & 1) ? sn : cs;
    s = (float)((q & 2) ? -so : so); c = (float)(((q + 1) & 2) ? -co : co);
}

__device__ __forceinline__ void sgu_unit(int unit, const bf16_t* __restrict__ VS, const unsigned long long* __restrict__ LNS, const bf16_t* U, bf16_t* OB, const bf16_t* __restrict__ Wt, const float* __restrict__ lng, const float* __restrict__ lnb,
                                         const float* __restrict__ bs, char* lds, int tid, int wid, int lane) {
    const int half = unit & 1, bc = unit >> 1, t0 = bc * SCH, r32 = lane & 31, hi = lane >> 5;
    float* stats = (float*)(lds + 65536);
    if (tid < SCH) { const float m1 = (float)(long long)LNS[2 * (t0 + tid)] * (1.f / (SSQ_SCALE * SW)), m2 = (float)(long long)LNS[2 * (t0 + tid) + 1] * (1.f / (SSQ_SCALE * SW));
        stats[2 * tid] = m1; stats[2 * tid + 1] = __builtin_amdgcn_rsqf(fmaxf(m2 - m1 * m1, 0.f) + LN_EPS); }
    __syncthreads();
    for (int gp = 0; gp < 4; ++gp) {
        const int g0 = half * 8 + gp * 2;
        { const int dc = tid & 15, s0 = tid >> 4; u32x4 vr[8];
#pragma unroll
            for (int i = 0; i < 8; ++i) vr[i] = *(const u32x4*)(VS + (size_t)(t0 + s0 + 32 * (i & 3)) * SW + (g0 + (i >> 2)) * 128 + dc * 8);
#pragma unroll
            for (int gi = 0; gi < 2; ++gi) { const int col = (g0 + gi) * 128 + dc * 8;
                const f32x4 ga = *(const f32x4*)(lng + col), gb = *(const f32x4*)(lng + col + 4), ba = *(const f32x4*)(lnb + col), bb = *(const f32x4*)(lnb + col + 4);
#pragma unroll
                for (int k = 0; k < 4; ++k) { const int s = s0 + 32 * k; f32x4 x0, x1; unpack8(vr[gi * 4 + k], x0, x1);
                    const float mean = stats[2 * s], rstd = stats[2 * s + 1];
                    x0 = (x0 - mean) * rstd * ga + ba; x1 = (x1 - mean) * rstd * gb + bb;
                    *(u32x4*)(lds + gi * 32768 + (s >> 6) * 16384 + att::v_st(s & 63, dc * 8)) = pack8f(x0, x1); } } }
        __syncthreads();
        const int grp = wid >> 2, tt = wid & 3, g = g0 + grp;
        f32x16 o[4] = {};
        const int vb0 = (int)(uintptr_t)lds + grp * 32768 + att::v_rd_base(lane);
        const bf16_t* wp = Wt + ((size_t)g * SCH + tt * 32 + r32) * SCH + hi * 8;
        { const bf16x8 pa0 = att::load8(wp), pa1 = att::load8(wp + 16), pa2 = att::load8(wp + 32), pa3 = att::load8(wp + 48); att::pv_tile<0>(o, vb0, pa0, pa1, pa2, pa3); }
        if (tt >= 2) { const bf16x8 pa0 = att::load8(wp + 64), pa1 = att::load8(wp + 80), pa2 = att::load8(wp + 96), pa3 = att::load8(wp + 112); att::pv_tile<16384>(o, vb0, pa0, pa1, pa2, pa3); }
#pragma unroll
        for (int rh = 0; rh < 2; ++rh) {
            unsigned short up[8][4]; float bias[8];
#pragma unroll
            for (int r = 0; r < 8; ++r) { const int t = tt * 32 + att::crow(rh * 8 + r, hi); bias[r] = bs[g * SCH + t];
#pragma unroll
                for (int d0 = 0; d0 < 4; ++d0) up[r][d0] = U[(size_t)(t0 + t) * SW + g * 128 + d0 * 32 + r32]; }
#pragma unroll
            for (int r = 0; r < 8; ++r) { const int t = tt * 32 + att::crow(rh * 8 + r, hi);
#pragma unroll
                for (int d0 = 0; d0 < 4; ++d0) { const size_t idx = (size_t)(t0 + t) * SW + g * 128 + d0 * 32 + r32;
                    const float uv = __builtin_bit_cast(float, (unsigned)up[r][d0] << 16), v = uv * (o[d0][rh * 8 + r] + bias[r]), vn = __shfl_xor(v, 1);
                    if ((r32 & 1) == 0) *(unsigned*)(OB + idx) = att::cvtpk(v, vn); } } }
        __syncthreads();
    }
}
__device__ __forceinline__ att::BlockRef own_ref(int unit, const bf16_t* Qb, const bf16_t* Kb, const bf16_t* Vb, bf16_t* Ob, float* lse3) {
    const int bh = unit >> 5, cur = unit & 31, b = bh >> 4, h = bh & 15;
    att::BlockRef r; r.Q = Qb + ((size_t)(b * SEQ + cur * 256)) * AW + h * HD; r.O = Ob + ((size_t)(b * SEQ + cur * 256)) * AW + h * HD; r.K = Kb + (size_t)(b * SEQ) * AW + h * HD; r.V = Vb + (size_t)(b * SEQ) * AW + h * HD;
    r.P0 = cur * 256; r.jlo = 4 * cur; r.sel = nullptr; r.lse = lse3 + (size_t)bh * SEQ + cur * 256; return r;
}
__device__ __forceinline__ att::BlockRef xattn_ref(int unit, const bf16_t* QX, const bf16_t* KV, bf16_t* OX) {
    const int b = unit >> 7, hx = (unit >> 5) & 3, qb = unit & 31;
    att::BlockRef r; r.Q = QX + ((size_t)(b * SEQ + qb * 256)) * XW + hx * HD; r.O = OX + ((size_t)(b * SEQ + qb * 256)) * XW + hx * HD;
    r.K = KV + (size_t)(b * NMEM) * (2 * XW) + hx * HD; r.V = r.K + XW; r.P0 = 256; r.jlo = 0; r.sel = nullptr; r.lse = nullptr; return r;
}

struct Args { const float* in[21]; float* out; unsigned char* ws; int ph_lo, ph_hi; };
#define ctl ((unsigned*)((unsigned*)(ws + WS_CTL)))
#define ssq1 ((ssq_t*)((ssq_t*)(ws + CTL_SSQ)))
#define ssq2 ((ssq_t*)(ssq1 + M))
#define ssq3 ((ssq_t*)(ssq2 + M))
#define ssq4 ((ssq_t*)(ssq3 + M))
#define x_in ((const float*)(args.in[0]))
#define mem_in ((const float*)(args.in[1]))
#define g_mix ((const float*)(args.in[2]))
#define w_in ((const float*)(args.in[3]))
#define ln_g ((const float*)(args.in[4]))
#define ln_b ((const float*)(args.in[5]))
#define w_sgu ((const float*)(args.in[6]))
#define b_sgu ((const float*)(args.in[7]))
#define w_pa ((const float*)(args.in[8]))
#define w_pb ((const float*)(args.in[9]))
#define w_out ((const float*)(args.in[10]))
#define g_xat ((const float*)(args.in[11]))
#define g_mem ((const float*)(args.in[12]))
#define w_xq ((const float*)(args.in[13]))
#define w_xkv ((const float*)(args.in[14]))
#define w_xo ((const float*)(args.in[15]))
#define g_ffn ((const float*)(args.in[16]))
#define w_gate ((const float*)(args.in[17]))
#define w_up ((const float*)(args.in[18]))
#define w_down ((const float*)(args.in[19]))
#define g_fin ((const float*)(args.in[20]))
#define out_f ((float*)(args.out))
#define kmpart ((float*)((float*)(ws + WS_KM)))
#define LSE3 ((float*)((float*)(ws + WS_SEL)))
#define LSE ((float*)((float*)(ws + 13 * MiB)))
#define lcnt ((unsigned*)(ctl + CW_LCNT))
#define lists ((unsigned short*)((unsigned short*)(ws + WS_WIN + 128 * MiB)))
#define P01 ((bf16_t*)((bf16_t*)(ws + WS_WIN)))
#define P2 ((bf16_t*)((bf16_t*)(ws + WS_VS)))
#define rope_c ((float*)((float*)(ws + WS_ROPE_C)))
#define rope_s ((float*)((float*)(ws + WS_ROPE_S)))
#define kvpart ((float*)((float*)(ws + WS_SA + 64 * MiB)))
#define wsgu_t ((bf16_t*)((bf16_t*)(ws + WS_WSGU)))
#define memkv ((bf16_t*)((bf16_t*)(ws + WS_MEMKV)))
#define memn ((bf16_t*)((bf16_t*)(ws + WS_MEMN)))
#define Win_t ((bf16_t*)((bf16_t*)(ws + WS_WIN)))
#define Win8 ((unsigned char*)(ws + WS_WIN + 64 * MiB))
#define lnstat ((unsigned long long*)(ws + 768 * 1024))
#define XB8 ((unsigned char*)(ws + WS_SB + 64 * MiB))
#define OA8 ((unsigned char*)(ws + WS_SB + 64 * MiB))
#define Pcat_t ((bf16_t*)((bf16_t*)(ws + WS_PCAT)))
#define Wout_t ((bf16_t*)((bf16_t*)(ws + WS_WOUT)))
#define Wxq_t ((bf16_t*)((bf16_t*)(ws + WS_WXQ)))
#define Wxkv_t ((bf16_t*)((bf16_t*)(ws + WS_WXKV)))
#define Wxo_t ((bf16_t*)((bf16_t*)(ws + WS_WXO)))
#define Wgu_t ((bf16_t*)((bf16_t*)(ws + WS_WGU)))
#define Wdn_t ((bf16_t*)((bf16_t*)(ws + WS_WDN)))
#define XB ((bf16_t*)((bf16_t*)(ws + WS_XB)))
#define OA ((bf16_t*)((bf16_t*)(ws + WS_Q)))
#define OB ((bf16_t*)((bf16_t*)(ws + WS_U)))
#define Qb ((bf16_t*)((bf16_t*)(ws + WS_Q)))
#define Ub ((bf16_t*)((bf16_t*)(ws + WS_U)))
#define Kb ((bf16_t*)((bf16_t*)(ws + WS_K)))
#define Vb ((bf16_t*)((bf16_t*)(ws + WS_V)))
#define VSb ((bf16_t*)((bf16_t*)(ws + WS_VS)))
#define SAb ((unsigned char*)((unsigned char*)(ws + WS_SA)))
#define SBb ((unsigned char*)((unsigned char*)(ws + WS_SB)))
#define MG ((bf16_t*)((bf16_t*)(ws + WS_MERGED)))
#define QX ((bf16_t*)((bf16_t*)(ws + WS_QX)))
#define OX ((bf16_t*)((bf16_t*)(ws + WS_OX)))
#define ACT ((bf16_t*)((bf16_t*)(ws + WS_ACT)))
__global__ void __launch_bounds__(NWAVES * 64, 2) mk_fwd(Args args) {
    extern __shared__ __attribute__((aligned(16))) unsigned char lds[];
    LAS unsigned char* ldsl = (LAS unsigned char*)lds;
    const int tid = threadIdx.x, lane = tid & 63, wave = __builtin_amdgcn_readfirstlane(tid >> 6), G = gridDim.x, B = blockIdx.x;
    unsigned char* ws = args.ws;

    for (int u = tid; u < (LDS_BYTES - LDSCTL_OFF) / 4; u += NWAVES * 64) ((LAS unsigned*)(ldsl + LDSCTL_OFF))[u] = 0u;
    __syncthreads();
    volatile LAS unsigned* MISC = (volatile LAS unsigned*)(ldsl + MISC_OFF);
    const XcdBarrier bar = xcd_barrier_post(ctl + CW_BAR, MISC + 8);
#define GRID_BAR() xcd_barrier(bar)
    const int lo = args.ph_lo, hi_ = args.ph_hi;
#define IN(k) (lo <= (k) && (k) < hi_)
#define BOTH(k) (IN(k) && IN((k) + 1))
    const int gw = B * NWAVES + wave, NGW = G * NWAVES;

            constexpr int J_IN = (DM / 64) * (NIN / 256), J_PA = (AW / 64) * (DM / 256), J_PB = J_PA, J_WO = (DM / 64) * (DM / 256), J_XQ = (DM / 64) * (XW / 256), J_XKV = (DM / 64) * (2 * XW / 256),
                          J_XO = (XW / 64) * (DM / 256), J_G = (DM / 64) * (DFF / 256), J_U = J_G, J_D = (DFF / 64) * (DM / 256);
            constexpr int NJ = J_IN + J_PA + J_PB + J_WO + J_XQ + J_XKV + J_XO + J_G + J_U + J_D, J_FFN0 = NJ - J_G - J_U - J_D, J_DN0 = NJ - J_D;
#define TR_DECODE(IT, idx) do { int r = (idx); TrItem& t_ = (IT); \
            if (r < J_IN) { const int n0_ = (r % (NIN / 256)) * 256, k0_ = (r / (NIN / 256)) * 64; \
                if (n0_ < 4096) t_ = TrItem{w_in, (bf16_t*)Win8, g_mix, DM, NIN, k0_, n0_, 5, 0}; else if (n0_ < 6144) t_ = TrItem{w_in, (bf16_t*)Win8, g_mix, DM, NIN, k0_, n0_, 4, 0}; \
                else if (n0_ < 10240) t_ = TrItem{w_in, Win_t, g_mix, DM, NIN, k0_, n0_, 0, -6144}; else t_ = TrItem{w_in, (bf16_t*)Win8, g_mix, DM, NIN, k0_, n0_, 4, -4096}; break; } r -= J_IN; \
            if (r < J_PA) { t_ = TrItem{w_pa, Pcat_t, nullptr, AW, DM, (r / (DM / 256)) * 64, (r % (DM / 256)) * 256, 4, 0}; break; } r -= J_PA;     \
            if (r < J_PB) { t_ = TrItem{w_pb, Pcat_t, nullptr, SW, DM, (r / (DM / 256)) * 64, (r % (DM / 256)) * 256, 0, DM}; break; } r -= J_PB; \
            if (r < J_WO) { t_ = TrItem{w_out, Wout_t, nullptr, DM, DM, (r / (DM / 256)) * 64, (r % (DM / 256)) * 256, 0, 0}; break; } r -= J_WO; \
            if (r < J_XQ) { t_ = TrItem{w_xq, Wxq_t, g_xat, DM, XW, (r / (XW / 256)) * 64, (r % (XW / 256)) * 256, 0, 0}; break; } r -= J_XQ; \
            if (r < J_XKV) { t_ = TrItem{w_xkv, Wxkv_t, nullptr, DM, 2 * XW, (r / (2 * XW / 256)) * 64, (r % (2 * XW / 256)) * 256, 0, 0}; break; } r -= J_XKV; \
            if (r < J_XO) { t_ = TrItem{w_xo, Wxo_t, nullptr, XW, DM, (r / (DM / 256)) * 64, (r % (DM / 256)) * 256, 0, 0}; break; } r -= J_XO; \
            if (r < J_G) { t_ = TrItem{w_gate, Wgu_t, g_ffn, DM, DFF, (r / (DFF / 256)) * 64, (r % (DFF / 256)) * 256, 2, 0}; break; } r -= J_G; \
            if (r < J_U) { t_ = TrItem{w_up, Wgu_t, g_ffn, DM, DFF, (r / (DFF / 256)) * 64, (r % (DFF / 256)) * 256, 3, 0}; break; } r -= J_U; \
            t_ = TrItem{w_down, Wdn_t, nullptr, DFF, DM, (r / (DM / 256)) * 64, (r % (DM / 256)) * 256, 0, 0}; } while (0)
#define TR_LOOP(LO, HI, RANK, NBLK) do { f32x4 v[8]; TrItem cur_, nxt_; int idx = (LO) + (RANK), par = 0; int lane_ = threadIdx.x & 63; asm volatile("" : "+v"(lane_));     \
            if (idx < (HI)) { TR_DECODE(cur_, idx); tr_issue(cur_, v, wave, lane_); } \
            for (; idx < (HI); idx += (NBLK), par ^= 1) { LAS unsigned* T = (LAS unsigned*)(ldsl + par * 34816); \
                tr_stage(cur_, v, T, wave, lane_); \
                const bool more = idx + (NBLK) < (HI); \
                if (more) { TR_DECODE(nxt_, idx + (NBLK)); tr_issue(nxt_, v, wave, lane_); } \
                __syncthreads(); \
                tr_readout(cur_, T, tid); \
                if (more) cur_ = nxt_; } \
            __syncthreads(); } while (0)
    if (IN(0)) { for (int rep_ = 0; rep_ <= ((MK_REP >> 0) & 1) * MK_REPN; ++rep_) { if (rep_) GRID_BAR();
        TR_LOOP(0, J_FFN0, B, G);
        for (int m = gw; m < M; m += NGW) { const float s = row_to_bf16(x_in + (size_t)m * DM, XB + (size_t)m * DM, nullptr, lane, XB8 + (size_t)m * DM); if (lane == 0) ssq1[m] = (ssq_t)(s * SSQ_SCALE + 0.5f); }
        for (int m = gw; m < BATCH * NMEM; m += NGW) (void)row_to_bf16(mem_in + (size_t)m * DM, memn + (size_t)m * DM, g_mem, lane);
        for (int e = B * 512 + tid; e < SEQ * 64; e += G * 512) { float c, s; rope_entry(e >> 6, e & 63, c, s); rope_c[e] = c; rope_s[e] = s; }
        for (int e = B * 512 + tid; e < NGRP * SCH * SCH; e += G * 512) { const int t = (e >> 7) & 127, s = e & 127; wsgu_t[e] = (bf16_t)(s <= t ? f2bf(w_sgu[e]) : 0u); }
        } if (BOTH(0)) GRID_BAR();
    }
    if (IN(1)) { for (int rep_ = 0; rep_ <= ((MK_REP >> 1) & 1) * MK_REPN; ++rep_) { if (rep_) GRID_BAR();
        { pg8::Gemm g{XB, Win_t, M, 4096, DM, DM}; pg8::StaticOrder S; S.init(M, 4096, G, B, 4);
          pg8::EpiIn<0> E{ssq1, rope_c, rope_s, Qb, Kb, Vb, Ub, VSb, SAb, SBb, kmpart, lnstat};
          pg8::gemm_phase<pg8::EpiIn<0>, pg8::StaticOrder, true, true, false>(ldsl, g, S, E); }
        { pg8::Gemm g{(const bf16_t*)XB8, (const bf16_t*)Win8, M, 14336, DM / 2, DM / 2}; pg8::StaticOrder S; S.init(M, 14336, G, B);
          pg8::EpiIn<1> E{ssq1, rope_c, rope_s, Qb, Kb, Vb, Ub, VSb, SAb, SBb, kmpart, lnstat};
          pg8::gemm_phase<pg8::EpiIn<1>, pg8::StaticOrder, true, true, true>(ldsl, g, S, E); }
        } if (BOTH(1)) GRID_BAR();
    }
    if (IN(3)) { for (int rep_ = 0; rep_ <= ((MK_REP >> 3) & 1) * MK_REPN; ++rep_) { if (rep_) GRID_BAR();
        if (B < 64 && G >= 128) {
            pg8::Gemm g{memn, Wxkv_t, BATCH * NMEM, 2 * XW, 512, DM}; pg8::MemKVOrder S{B};
            pg8::EpiPart E{kvpart};
            pg8::gemm_phase<pg8::EpiPart, pg8::MemKVOrder, true, true>(ldsl, g, S, E);
        }
        for (int j = B, rd = 0; j < 512; j += G, ++rd) { const int bh = j >> 4; int cc = j & 15; if (rd & 1) cc = 15 - cc;
            const int s = cc * 512 + tid, cur = __builtin_amdgcn_readfirstlane(s >> 8), b = bh >> 4, h = bh & 15;
            LAS float* kml = (LAS float*)ldsl;
            __syncthreads();
            { const int e8 = tid * 8, n_ = e8 >> 7, d_ = e8 & 127; const float* p0_ = kmpart + ((((size_t)(b * 32 + n_)) * NH + h) * 2) * HD + d_;
              const f32x4 a0 = *(const f32x4*)p0_, a1 = *(const f32x4*)(p0_ + 4), b0 = *(const f32x4*)(p0_ + HD), b1 = *(const f32x4*)(p0_ + HD + 4);
              *(LAS f32x4*)(kml + e8) = (a0 + b0) * (1.f / 256.f); *(LAS f32x4*)(kml + e8 + 4) = (a1 + b1) * (1.f / 256.f); }
            __syncthreads();
            int i0 = 0, i1 = 1, i2 = 2;
            if (cur > 3) {
                f32x4 qf[32]; const bf16_t* qp = Qb + (size_t)(b * SEQ + s) * AW + h * HD;
#pragma unroll
                for (int i = 0; i < 16; ++i) unpack8(*(const u32x4*)(qp + 8 * i), qf[2 * i], qf[2 * i + 1]);
                float v0 = -__builtin_inff(), v1 = v0, v2 = v0;
                for (int n = 0; n < cur; ++n) { const LAS float* kp = kml + n * HD; f32x4 dv = {0.f, 0.f, 0.f, 0.f};
#pragma unroll
                    for (int i = 0; i < 32; ++i) dv += qf[i] * *(const LAS f32x4*)(kp + 4 * i);
                    const float d0 = dv[0] + dv[2], d1 = dv[1] + dv[3];
                    const float gsc = d0 + d1;
                    if (gsc > v2) { if (gsc > v1) { v2 = v1; i2 = i1; if (gsc > v0) { v1 = v0; i1 = i0; v0 = gsc; i0 = n; } else { v1 = gsc; i1 = n; } } else { v2 = gsc; i2 = n; } } }
            }
            const int nv = cur < 3 ? cur : 3;
            LAS int* lc = (LAS int*)(ldsl + 137216); LAS int* gb = lc + 32;
            if (tid < 32) lc[tid] = 0;
            __syncthreads();
            int lp0 = 0, lp1 = 0, lp2 = 0;
            if (nv > 0) lp0 = __hip_atomic_fetch_add(lc + i0, 1, __ATOMIC_RELAXED, __HIP_MEMORY_SCOPE_WORKGROUP);
            if (nv > 1) lp1 = __hip_atomic_fetch_add(lc + i1, 1, __ATOMIC_RELAXED, __HIP_MEMORY_SCOPE_WORKGROUP);
            if (nv > 2) lp2 = __hip_atomic_fetch_add(lc + i2, 1, __ATOMIC_RELAXED, __HIP_MEMORY_SCOPE_WORKGROUP);
            __syncthreads();
            if (tid < 32) { const int c_ = lc[tid]; gb[tid] = c_ > 0 ? (int)atomicAdd((rep_ ? ctl + CW_PCNT2 : lcnt) + bh * 32 + tid, (unsigned)c_) : 0; }
            __syncthreads();
            unsigned short* lists_ = rep_ ? (unsigned short*)(ws + WS_SA + 80 * MiB) : lists;
            if (nv > 0) lists_[(size_t)(bh * 32 + i0) * 8192 + gb[i0] + lp0] = (unsigned short)s;
            if (nv > 1) lists_[(size_t)(bh * 32 + i1) * 8192 + gb[i1] + lp1] = (unsigned short)(s | (1 << 13));
            if (nv > 2) lists_[(size_t)(bh * 32 + i2) * 8192 + gb[i2] + lp2] = (unsigned short)(s | (2 << 13));
            __syncthreads();
        }

        for (int u = B; u < 2 * (M / SCH); u += G) sgu_unit(u, VSb, lnstat, Ub, rep_ ? (bf16_t*)(ws + WS_SB + 64 * MiB) : OB, wsgu_t, ln_g, ln_b, b_sgu, (char*)lds, tid, wave, lane);
        } if (BOTH(3)) GRID_BAR();
    }
    if (IN(4)) { for (int rep_ = 0; rep_ <= ((MK_REP >> 4) & 1) * MK_REPN; ++rep_) { if (rep_) GRID_BAR();
        {
            int* pre = (int*)((char*)lds + 137216); int* wtot = pre + 1028;
            { const int c0_ = (int)((lcnt[2 * tid] + 255u) >> 8), c1_ = (int)((lcnt[2 * tid + 1] + 255u) >> 8), a_ = 4 * c0_ + 3 * (c0_ > 0), b_ = 4 * c1_ + 3 * (c1_ > 0); int v = a_ + b_;
#pragma unroll
              for (int o_ = 1; o_ < 64; o_ <<= 1) { const int t2 = __shfl_up(v, o_); if (lane >= o_) v += t2; }
              if (lane == 63) wtot[wave] = v;
              __syncthreads();
              int off = 0; for (int w_ = 0; w_ < wave; ++w_) off += wtot[w_];
              v += off; pre[2 * tid] = v - a_ - b_; pre[2 * tid + 1] = v - b_; if (tid == 511) pre[1024] = v;
              __syncthreads(); }
            const int T = pre[1024]; const int glo = (int)((long)B * T / G), ghi = (int)((long)(B + 1) * T / G);
            for (int pass_ = 0; pass_ <= ((MK_REP >> 23) & 1); ++pass_) {
            int li = 0;
            for (int g_ = glo; g_ < ghi;) {
                while (pre[li + 1] <= g_) ++li;
                const int nch = (pre[li + 1] - pre[li] - 3) >> 2, rend = pre[li + 1] < ghi ? pre[li + 1] : ghi;
                int c_lo = (g_ - pre[li] - 3 + 3) >> 2; if (g_ - pre[li] - 3 < 0) c_lo = 0; int c_hi = (rend - pre[li] - 3 + 3) >> 2; if (rend - pre[li] - 3 < 0) c_hi = 0; if (c_hi > nch) c_hi = nch;
                g_ = rend;
                if (c_hi <= c_lo) continue;
                const int cntl = (int)lcnt[li], bh = li >> 5, n = li & 31, b = bh >> 4, h = bh & 15; (void)nch;
                __syncthreads();
                att::gather_load_kv(Kb + (size_t)(b * SEQ + n * 256) * AW + h * HD, Vb + (size_t)(b * SEQ + n * 256) * AW + h * HD, (char*)lds);
                __syncthreads();
                att::gather_run(Qb + (size_t)(b * SEQ) * AW + h * HD, lists + (size_t)li * 8192, c_lo, c_hi, cntl, P01, P2, LSE, (size_t)bh * SEQ, (char*)lds);
            } }
        }
        } if (BOTH(4)) GRID_BAR();
    }
    if (IN(5)) { for (int rep_ = 0; rep_ <= ((MK_REP >> 5) & 1) * MK_REPN; ++rep_) { if (rep_) GRID_BAR();
        for (int e = B * 512 + tid; e < BATCH * NMEM * 2 * XW / 4; e += G * 512) { f32x4 a = ((const f32x4*)kvpart)[e];
#pragma unroll
            for (int k = 1; k < 8; ++k) a += ((const f32x4*)kvpart)[e + k * (BATCH * NMEM * 2 * XW / 4)];
            u32x2 o; o.x = cvt_pk_bf16(a[0], a[1]); o.y = cvt_pk_bf16(a[2], a[3]); ((u32x2*)memkv)[e] = o; }
        if (B < BATCH * NH * 32) {
            att::Seam S; int unit = B;
            att::BlockRef cur = own_ref(unit, Qb, Kb, Vb, OA, LSE3); att::prime<AW, AW>(cur, (char*)lds, S);
            for (;;) { const int nunit = unit + G; const bool last = nunit >= BATCH * NH * 32;
                const att::BlockRef nxt = last ? cur : own_ref(nunit, Qb, Kb, Vb, OA, LSE3);
                att::block<AW, AW, HD, true>(cur, nxt, SEQ, (char*)lds, S);
                {
                    const int bh = unit >> 5, cq = unit & 31, nv = cq < 3 ? cq : 3, b = bh >> 4, h = bh & 15;
                    const bf16_t* Ot = (const bf16_t*)((char*)lds + OT_OFF); const float* Ol = (const float*)((char*)lds + OTL_OFF);
                    int tid_c = threadIdx.x; asm volatile("" : "+v"(tid_c));
#pragma unroll 2
                    for (int i = 0; i < 8; ++i) { const int it = tid_c + 512 * i, rr = it >> 4, c = it & 15; const size_t row = (size_t)bh * SEQ + cq * 256 + rr;
                        const float l3 = Ol[rr]; float lj[3]; float lmax = l3;
#pragma unroll
                        for (int j = 0; j < 3; ++j) { lj[j] = j < nv ? LSE[(size_t)j * (BATCH * NH * SEQ) + row] : -__builtin_inff(); lmax = fmaxf(lmax, lj[j]); }
                        const float w3 = __builtin_amdgcn_exp2f(l3 - lmax); float wsum = w3;
                        f32x4 a0, a1; unpack8(*(const u32x4*)(Ot + rr * HD + c * 8), a0, a1); a0 *= w3; a1 *= w3;
#pragma unroll
                        for (int j = 0; j < 3; ++j) if (j < nv) { const float wj = __builtin_amdgcn_exp2f(lj[j] - lmax); wsum += wj;
                            const unsigned char* pp = (const unsigned char*)(j < 2 ? P01 + (size_t)j * ((size_t)BATCH * NH * SEQ * HD) : P2) + row * HD + c * 8;
                            const u32x2 pw = *(const u32x2*)pp; const float wj8 = wj * (1.f / OA8_SCALE); a0 += up4_fp8(pw.x) * wj8; a1 += up4_fp8(pw.y) * wj8; }
                        const float rw = __builtin_amdgcn_rcpf(wsum);
                        a0 *= rw * OA8_SCALE; a1 *= rw * OA8_SCALE; u32x2 w8; w8.x = pk4_fp8(a0[0], a0[1], a0[2], a0[3]); w8.y = pk4_fp8(a1[0], a1[1], a1[2], a1[3]);
                        *(u32x2*)(OA8 + (size_t)(b * SEQ + cq * 256 + rr) * AW + h * HD + c * 8) = w8; }
                }
                if (last) break;
                cur = nxt; unit = nunit; }
        }
        } if (BOTH(5)) GRID_BAR();
    }
    if (IN(7)) { for (int rep_ = 0; rep_ <= ((MK_REP >> 7) & 1) * MK_REPN; ++rep_) { if (rep_) GRID_BAR();
        { pg8::Gemm g{(const bf16_t*)OA8, Pcat_t, M, DM, AW / 2, AW / 2}; pg8::StaticOrder S; S.init(M, DM, G, B, 4);
          pg8::EpiBranch<0> E{SAb, MG, (unsigned char*)(ws + WS_Q)};
          pg8::gemm_phase<pg8::EpiBranch<0>, pg8::StaticOrder, true, true, true>(ldsl, g, S, E); }
        { pg8::Gemm g{OB, Pcat_t + (size_t)DM * AW, M, DM, AW, AW}; pg8::StaticOrder S; S.init(M, DM, G, B, 4);
          pg8::EpiBranch<1> E{SBb, MG, (unsigned char*)(ws + WS_Q)};
          pg8::gemm_phase<pg8::EpiBranch<1>, pg8::StaticOrder, true, true, false>(ldsl, g, S, E); }
        } if (BOTH(7)) GRID_BAR();
    }
    if (IN(8)) { for (int rep_ = 0; rep_ <= ((MK_REP >> 8) & 1) * MK_REPN; ++rep_) { if (rep_) GRID_BAR();
        pg8::Gemm g{MG, Wout_t, M, DM, DM, DM}; pg8::StaticOrder S; S.init(M, DM, G, B, 4);
        pg8::EpiResid E{nullptr, XB, rep_ ? (bf16_t*)(ws + WS_SB) : XB, rep_ ? (ssq_t*)(ws + 13 * MiB) : ssq2};
        pg8::gemm_phase<pg8::EpiResid, pg8::StaticOrder, true, true>(ldsl, g, S, E);
        } if (BOTH(8)) GRID_BAR();
    }
    if (IN(9)) { for (int rep_ = 0; rep_ <= ((MK_REP >> 9) & 1) * MK_REPN; ++rep_) { if (rep_) GRID_BAR();
        pg8::Gemm g{XB, Wxq_t, M, XW, DM, DM}; pg8::StaticOrder S; S.init(M, XW, G, B);
        pg8::EpiScale E{ssq2, QX, XW};
        pg8::gemm_phase<pg8::EpiScale, pg8::StaticOrder, true, true>(ldsl, g, S, E);
        { pg8::Unit uq;
          if (G == 256 && S.next(0, uq)) {
            att::Seam AS; const int ub = (uq.pm >> 5) * 128 + (uq.pn * 2) * 32 + (uq.pm & 31);
            att::BlockRef cur = xattn_ref(ub, QX, memkv, OX); att::prime<XW, 2 * XW>(cur, (char*)lds, AS);
#pragma nounroll
            for (int k_ = 0; k_ < 2; ++k_) { const att::BlockRef nxt = xattn_ref(ub + 32, QX, memkv, OX);
                att::block<XW, 2 * XW, XW>(cur, nxt, NMEM, (char*)lds, AS); cur = nxt; } } }
        { constexpr int NXQ = (M / 256) * (XW / 256);
          if (G > NXQ) { if (B >= NXQ) TR_LOOP(J_FFN0, J_DN0, B - NXQ, G - NXQ); } else TR_LOOP(J_FFN0, J_DN0, B, G); }
        } if (BOTH(9)) GRID_BAR();
    }
    if (IN(11)) { for (int rep_ = 0; rep_ <= ((MK_REP >> 11) & 1) * MK_REPN; ++rep_) { if (rep_) GRID_BAR();
        pg8::Gemm g{OX, Wxo_t, M, DM, XW, XW}; pg8::StaticOrder S; S.init(M, DM, G, B, 4);
        pg8::EpiResid E{nullptr, XB, rep_ ? (bf16_t*)(ws + WS_SB) : XB, rep_ ? (ssq_t*)(ws + 13 * MiB) : ssq3};
        pg8::gemm_phase<pg8::EpiResid, pg8::StaticOrder, true, true>(ldsl, g, S, E);
        } if (BOTH(11)) GRID_BAR();
    }
    if (IN(12)) { for (int rep_ = 0; rep_ <= ((MK_REP >> 12) & 1) * MK_REPN; ++rep_) { if (rep_) GRID_BAR();
        pg8::Gemm g{XB, Wgu_t, M, 2 * DFF, DM, DM}; pg8::StaticOrder S; S.init(M, 2 * DFF, G, B);
        pg8::EpiGU E{ssq3, ACT};
        pg8::gemm_phase<pg8::EpiGU, pg8::StaticOrder, true, true>(ldsl, g, S, E);
        { const int rem = ((M / 256) * (2 * DFF / 256)) % G;
          if (rem != 0) { if (B >= rem) TR_LOOP(J_DN0, NJ, B - rem, G - rem); } else TR_LOOP(J_DN0, NJ, B, G); }
        } if (BOTH(12)) GRID_BAR();
    }
    if (IN(13)) { for (int rep_ = 0; rep_ <= ((MK_REP >> 13) & 1) * MK_REPN; ++rep_) { if (rep_) GRID_BAR();
        pg8::Gemm g{ACT, Wdn_t, M, DM, DFF, DFF};
        pg8::EpiResid E{nullptr, XB, rep_ ? (bf16_t*)(ws + WS_SB) : XB, rep_ ? (ssq_t*)(ws + 13 * MiB) : ssq4};
        pg8::StaticOrder S; S.init(M, DM, G, B, 4); pg8::gemm_phase<pg8::EpiResid, pg8::StaticOrder, true, true>(ldsl, g, S, E);
        } if (BOTH(13)) GRID_BAR();
    }
    if (IN(14)) { for (int rep_ = 0; rep_ <= ((MK_REP >> 14) & 1) * MK_REPN; ++rep_) { if (rep_) GRID_BAR();
        int lane_ = threadIdx.x & 63; asm volatile("" : "+v"(lane_));
        for (int m = (int)blockIdx.x * NWAVES + (int)(threadIdx.x >> 6); m < M; m += NGW) { const float r = rs_of(ssq4, m); GAS f32x4* p = (GAS f32x4*)(out_f + (size_t)m * DM) + 2 * lane_; const GAS u32x4* xp = (const GAS u32x4*)(XB + (size_t)m * DM) + lane_;
#pragma unroll
            for (int j = 0; j < 8; ++j) { f32x4 a0, a1; unpack8(xp[64 * j], a0, a1); const GAS f32x4* gp = (const GAS f32x4*)g_fin + 2 * lane_ + 128 * j;
                p[128 * j] = a0 * gp[0] * r; p[128 * j + 1] = a1 * gp[1] * r; } }
    } }
#undef IN
#undef BOTH
}

#undef ctl
#undef ssq1
#undef ssq2
#undef ssq3
#undef ssq4
#undef x_in
#undef mem_in
#undef g_mix
#undef w_in
#undef ln_g
#undef ln_b
#undef w_sgu
#undef b_sgu
#undef w_pa
#undef w_pb
#undef w_out
#undef g_xat
#undef g_mem
#undef w_xq
#undef w_xkv
#undef w_xo
#undef g_ffn
#undef w_gate
#undef w_up
#undef w_down
#undef g_fin
#undef out_f
#undef kmpart
#undef LSE3
#undef LSE
#undef lcnt
#undef lists
#undef P01
#undef P2
#undef rope_c
#undef rope_s
#undef kvpart
#undef wsgu_t
#undef memkv
#undef memn
#undef Win_t
#undef Pcat_t
#undef Wout_t
#undef Wxq_t
#undef Wxkv_t
#undef Wxo_t
#undef Wgu_t
#undef Wdn_t
#undef XB
#undef OA
#undef OB
#undef Qb
#undef Ub
#undef Kb
#undef Vb
#undef VSb
#undef SAb
#undef SBb
#undef MG
#undef QX
#undef OX
#undef ACT
extern "C" void kernel_launch(void* const* d_in, const int* in_sizes, int n_in, void* d_out, int out_size, void* d_ws, size_t ws_size, hipStream_t stream) {
    static int grid = 0;
    if (grid == 0) {
        if (n_in != 21 || in_sizes[0] != M * DM || out_size != M * DM || ws_size < WS_END) { fprintf(stderr, "kernel_launch: unexpected shapes / workspace (n_in %d, ws %zu < %zu); nothing launched\n", n_in, ws_size, (size_t)WS_END); grid = -1; return; }
        int dev = 0, cus = 0, per_cu = 0;
        if (hipGetDevice(&dev) != hipSuccess || hipDeviceGetAttribute(&cus, hipDeviceAttributeMultiprocessorCount, dev) != hipSuccess) { grid = -1; return; }
        if (hipFuncSetAttribute((const void*)mk_fwd, hipFuncAttributeMaxDynamicSharedMemorySize, LDS_BYTES) != hipSuccess) { fprintf(stderr, "kernel_launch: hipFuncSetAttribute failed\n"); grid = -1; return; }
        if (hipOccupancyMaxActiveBlocksPerMultiprocessor(&per_cu, (const void*)mk_fwd, NWAVES * 64, LDS_BYTES) != hipSuccess || per_cu < 1) { fprintf(stderr, "kernel_launch: occupancy query reports %d workgroups per CU\n", per_cu); }
        (void)hipGetLastError();
        if (cus < 256) { fprintf(stderr, "kernel_launch: this kernel's phase program is dealt over exactly 256 workgroups, one per CU; the device has %d CUs; nothing launched\n", cus); grid = -1; return; }
        grid = 256;
    }
    if (grid < 0) return;
    (void)hipMemsetAsync((char*)d_ws + WS_CTL, 0, CTL_ZERO_BYTES, stream);
    Args a{};
    for (int i = 0; i < 21; ++i) a.in[i] = (const float*)d_in[i];
    a.out = (float*)d_out; a.ws = (unsigned char*)d_ws;
#if MK_PER_PHASE
    for (int p = 0; p < N_PHASES; ++p) { a.ph_lo = p; a.ph_hi = p + 1; hipLaunchKernelGGL(mk_fwd, dim3(grid), dim3(NWAVES * 64), LDS_BYTES, stream, a); }
#else
    a.ph_lo = 0; a.ph_hi = N_PHASES; hipLaunchKernelGGL(mk_fwd, dim3(grid), dim3(NWAVES * 64), LDS_BYTES, stream, a);
#endif
}
```
